# Optimizing an MI355X kernel written in HIP

```python
import math
import jax, jax.numpy as jnp
from jax import lax
import numpy as np

D_MODEL = 1024
BATCH = 8
SEQ = 2048
DEPTH = 2

GRID_W = 64
CTX_LEN = 256
HEAD_DIM = 64
ROPE_THETA = 10000.0
Q_BLOCK = 128

MLA_HEADS = 8
MLA_Q_RANK = 256
MLA_KV_RANK = 128
MLA_NOPE = 64
MLA_ROPE = 32
MLA_V = 64
SWA_HEADS = 8
SWA_KV_HEADS = 2
SWA_GROUP = SWA_HEADS // SWA_KV_HEADS
WINDOW = 128
DIFF_HEADS = D_MODEL // (2 * HEAD_DIM)
D_FF = 2816

ALPHA = (2 * DEPTH) ** 0.25
BETA = (8 * DEPTH) ** -0.25
LN_EPS = 1e-5
RMS_EPS = 1e-6
NEG_INF = -1e30
N_EVEN = (DEPTH + 1) // 2
N_ODD = DEPTH // 2

EVEN_Q_SIZES = (MLA_Q_RANK, SWA_HEADS * HEAD_DIM)
EVEN_KV_SIZES = (MLA_KV_RANK, MLA_ROPE, SWA_KV_HEADS * HEAD_DIM, SWA_KV_HEADS * HEAD_DIM)
EVEN_Q_COLS = sum(EVEN_Q_SIZES)
EVEN_IN = EVEN_Q_COLS + sum(EVEN_KV_SIZES)
EVEN_OUT = MLA_HEADS * MLA_V + SWA_HEADS * HEAD_DIM
DIFF_QK_COLS = DIFF_HEADS * 2 * HEAD_DIM
ODD_IN = 3 * DIFF_QK_COLS
ODD_OUT = DIFF_HEADS * 2 * HEAD_DIM

kernel_name = "hybrid_mla_swa_diffattn_dit_block"


def layer_norm(x, g, b):
    xf = x.astype(jnp.float32)
    mu = jnp.mean(xf, -1, keepdims=True)
    var = jnp.mean(jnp.square(xf - mu), -1, keepdims=True)
    return ((xf - mu) * lax.rsqrt(var + LN_EPS) * g + b).astype(x.dtype)


def rms_norm(x, g):
    xf = x.astype(jnp.float32)
    return (xf * lax.rsqrt(jnp.mean(jnp.square(xf), -1, keepdims=True) + RMS_EPS) * g).astype(x.dtype)


def split_cols(t, sizes):
    idx = np.cumsum(np.array(sizes))[:-1].tolist()
    return jnp.split(t, idx, axis=-1)


def axial_rope_tables(rows, dim):
    row = jnp.repeat(jnp.arange(rows), GRID_W).astype(jnp.float32)
    col = jnp.tile(jnp.arange(GRID_W), rows).astype(jnp.float32)
    quarter = dim // 4
    freqs = ROPE_THETA ** (-jnp.arange(quarter, dtype=jnp.float32) / quarter)
    ar = row[:, None] * freqs
    ac = col[:, None] * freqs
    cos = jnp.concatenate([jnp.cos(ar), jnp.cos(ar), jnp.cos(ac), jnp.cos(ac)], -1)
    sin = jnp.concatenate([jnp.sin(ar), jnp.sin(ar), jnp.sin(ac), jnp.sin(ac)], -1)
    return cos, sin


def apply_rope(x, cos, sin):
    shape = (cos.shape[0],) + (1,) * (x.ndim - 3) + (cos.shape[1],)
    cos = cos.reshape(shape)
    sin = sin.reshape(shape)
    a, b, c_, d = jnp.split(x, 4, axis=-1)
    rot = jnp.concatenate([-b, a, -d, c_], -1)
    return (x * cos + rot * sin).astype(x.dtype)


def sweep_query_blocks(fn, q):
    B, S = q.shape[:2]
    nb = S // Q_BLOCK
    blocks = jnp.moveaxis(q.reshape((B, nb, Q_BLOCK) + q.shape[2:]), 1, 0)
    out = jnp.moveaxis(lax.map(fn, blocks), 0, 1)
    return out.reshape((B, S) + out.shape[3:])


def softmax_attend(q, k, v, scale):
    s = jnp.einsum('bqhd,bkhd->bhqk', q, k).astype(jnp.float32) * scale
    p = jax.nn.softmax(s, axis=-1).astype(v.dtype)
    return jnp.einsum('bhqk,bkhd->bqhd', p, v)


def mla_queries(q_a, q_norm, w_qb, cos, sin):
    B, T = q_a.shape[:2]
    q = (rms_norm(q_a, q_norm) @ w_qb).reshape(B, T, MLA_HEADS, MLA_NOPE + MLA_ROPE)
    if cos is None:
        return q
    return jnp.concatenate([q[..., :MLA_NOPE], apply_rope(q[..., MLA_NOPE:], cos, sin)], -1)


def mla_keys_values(kv_a, k_rope, kv_norm, w_kvb, cos, sin):
    B, T = kv_a.shape[:2]
    kv = (rms_norm(kv_a, kv_norm) @ w_kvb).reshape(B, T, MLA_HEADS, MLA_NOPE + MLA_V)
    if cos is not None:
        k_rope = apply_rope(k_rope, cos, sin)
    k_rope = jnp.broadcast_to(k_rope[:, :, None, :], (B, T, MLA_HEADS, MLA_ROPE))
    return jnp.concatenate([kv[..., :MLA_NOPE], k_rope], -1), kv[..., MLA_NOPE:]


def window_attend(q, k, v, k_ctx, v_ctx, sink):
    B, S = q.shape[:2]
    L = k_ctx.shape[1]
    nb = S // WINDOW
    qb = q.reshape(B, nb, WINDOW, SWA_KV_HEADS, SWA_GROUP, HEAD_DIM)

    def band(t):
        tb = t.reshape(B, nb, WINDOW, SWA_KV_HEADS, HEAD_DIM)
        tp = jnp.pad(tb, ((0, 0), (1, 1), (0, 0), (0, 0), (0, 0)))
        return jnp.concatenate([tp[:, :-2], tp[:, 1:-1], tp[:, 2:]], axis=2)

    kb, vb = band(k), band(v)
    qpos = jnp.arange(nb)[:, None] * WINDOW + jnp.arange(WINDOW)[None, :]
    kpos = (jnp.arange(nb)[:, None] - 1) * WINDOW + jnp.arange(3 * WINDOW)[None, :]
    valid = ((jnp.abs(qpos[:, :, None] - kpos[:, None, :]) <= WINDOW)
             & (kpos[:, None, :] >= 0) & (kpos[:, None, :] < S))
    scale = HEAD_DIM ** -0.5
    s_band = jnp.einsum('bnqhgd,bnkhd->bnhgqk', qb, kb).astype(jnp.float32) * scale
    s_band = jnp.where(valid[None, :, None, None], s_band, NEG_INF)
    s_ctx = jnp.einsum('bnqhgd,bchd->bnhgqc', qb, k_ctx).astype(jnp.float32) * scale
    sink_col = jnp.broadcast_to(sink.reshape(SWA_KV_HEADS, SWA_GROUP, 1, 1).astype(jnp.float32),
                                s_ctx.shape[:-1] + (1,))
    p = jax.nn.softmax(jnp.concatenate([s_ctx, s_band, sink_col], -1), axis=-1)
    p_ctx = p[..., :L].astype(v.dtype)
    p_band = p[..., L:L + 3 * WINDOW].astype(v.dtype)
    o = (jnp.einsum('bnhgqc,bchd->bnqhgd', p_ctx, v_ctx)
         + jnp.einsum('bnhgqk,bnkhd->bnqhgd', p_band, vb))
    return o.reshape(B, S, SWA_HEADS * HEAD_DIM)


def sink_attend(q, k, v, sink):
    B, T = q.shape[:2]
    qg = q.reshape(B, T, SWA_KV_HEADS, SWA_GROUP, HEAD_DIM)
    s = jnp.einsum('bqhgd,bkhd->bhgqk', qg, k).astype(jnp.float32) * HEAD_DIM ** -0.5
    sink_col = jnp.broadcast_to(sink.reshape(SWA_KV_HEADS, SWA_GROUP, 1, 1).astype(jnp.float32),
                                s.shape[:-1] + (1,))
    p = jax.nn.softmax(jnp.concatenate([s, sink_col], -1), axis=-1)[..., :-1].astype(v.dtype)
    return jnp.einsum('bhgqk,bkhd->bqhgd', p, v).reshape(B, T, SWA_HEADS * HEAD_DIM)


def even_mixer(h_lat, h_ctx, w_in, q_norm, w_qb, kv_norm, w_kvb, sink, w_out, rope32, rope64, need_ctx):
    B, S = h_lat.shape[:2]
    L = h_ctx.shape[1]
    cos32, sin32 = rope32
    cos64, sin64 = rope64
    qa_l, qs_l, kva_l, kr_l, ks_l, vs_l = split_cols(h_lat @ w_in, EVEN_Q_SIZES + EVEN_KV_SIZES)
    kva_c, kr_c, ks_c, vs_c = split_cols(h_ctx @ w_in[:, EVEN_Q_COLS:], EVEN_KV_SIZES)
    mla_scale = (MLA_NOPE + MLA_ROPE) ** -0.5
    q_mla = mla_queries(qa_l, q_norm, w_qb, cos32, sin32)
    k_mla_l, v_mla_l = mla_keys_values(kva_l, kr_l, kv_norm, w_kvb, cos32, sin32)
    k_mla_c, v_mla_c = mla_keys_values(kva_c, kr_c, kv_norm, w_kvb, None, None)
    k_all = jnp.concatenate([k_mla_c, k_mla_l], axis=1)
    v_all = jnp.concatenate([v_mla_c, v_mla_l], axis=1)
    o_mla = sweep_query_blocks(lambda qb: softmax_attend(qb, k_all, v_all, mla_scale), q_mla)
    o_mla = o_mla.reshape(B, S, MLA_HEADS * MLA_V)
    q_swa = apply_rope(qs_l.reshape(B, S, SWA_HEADS, HEAD_DIM), cos64, sin64)
    k_swa = apply_rope(ks_l.reshape(B, S, SWA_KV_HEADS, HEAD_DIM), cos64, sin64)
    v_swa = vs_l.reshape(B, S, SWA_KV_HEADS, HEAD_DIM)
    k_swa_c = ks_c.reshape(B, L, SWA_KV_HEADS, HEAD_DIM)
    v_swa_c = vs_c.reshape(B, L, SWA_KV_HEADS, HEAD_DIM)
    o_swa = window_attend(q_swa, k_swa, v_swa, k_swa_c, v_swa_c, sink)
    out_l = jnp.concatenate([o_mla, o_swa], -1) @ w_out
    if not need_ctx:
        return out_l, None
    qa_c, qs_c = split_cols(h_ctx @ w_in[:, :EVEN_Q_COLS], EVEN_Q_SIZES)
    q_mla_c = mla_queries(qa_c, q_norm, w_qb, None, None)
    o_mla_c = softmax_attend(q_mla_c, k_mla_c, v_mla_c, mla_scale).reshape(B, L, MLA_HEADS * MLA_V)
    o_swa_c = sink_attend(qs_c.reshape(B, L, SWA_HEADS, HEAD_DIM), k_swa_c, v_swa_c, sink)
    out_c = jnp.concatenate([o_mla_c, o_swa_c], -1) @ w_out
    return out_l, out_c


def diff_attend(q, k, v, lam, lambda_init, subln_g):
    s = jnp.einsum('bqhtd,bkhtd->bthqk', q, k).astype(jnp.float32) * HEAD_DIM ** -0.5
    p = jax.nn.softmax(s, axis=-1)
    a = (p[:, 0] - lam * p[:, 1]).astype(v.dtype)
    o = jnp.einsum('bhqk,bkhe->bqhe', a, v)
    o = rms_norm(o, subln_g) * (1.0 - lambda_init)
    return o.reshape(o.shape[0], o.shape[1], DIFF_HEADS * 2 * HEAD_DIM)


def odd_mixer(h_lat, h_ctx, w_in, lam_q1, lam_k1, lam_q2, lam_k2, subln_g, w_out, rope64,
              lambda_init, need_ctx):
    B, S = h_lat.shape[:2]
    L = h_ctx.shape[1]
    cos, sin = rope64
    q_l, k_l, v_l = jnp.split(h_lat @ w_in, 3, axis=-1)
    q_l = apply_rope(q_l.reshape(B, S, DIFF_HEADS, 2, HEAD_DIM), cos, sin)
    k_l = apply_rope(k_l.reshape(B, S, DIFF_HEADS, 2, HEAD_DIM), cos, sin)
    v_l = v_l.reshape(B, S, DIFF_HEADS, 2 * HEAD_DIM)
    k_c, v_c = jnp.split(h_ctx @ w_in[:, DIFF_QK_COLS:], 2, axis=-1)
    k_c = k_c.reshape(B, L, DIFF_HEADS, 2, HEAD_DIM)
    v_c = v_c.reshape(B, L, DIFF_HEADS, 2 * HEAD_DIM)
    lam = (jnp.exp(jnp.sum(lam_q1 * lam_k1).astype(jnp.float32))
           - jnp.exp(jnp.sum(lam_q2 * lam_k2).astype(jnp.float32)) + lambda_init)
    k_all = jnp.concatenate([k_c, k_l], axis=1)
    v_all = jnp.concatenate([v_c, v_l], axis=1)
    o_l = sweep_query_blocks(lambda qb: diff_attend(qb, k_all, v_all, lam, lambda_init, subln_g), q_l)
    out_l = o_l @ w_out
    if not need_ctx:
        return out_l, None
    q_c = (h_ctx @ w_in[:, :DIFF_QK_COLS]).reshape(B, L, DIFF_HEADS, 2, HEAD_DIM)
    out_c = diff_attend(q_c, k_c, v_c, lam, lambda_init, subln_g) @ w_out
    return out_l, out_c


def conv_ffn(h, w_gate, w_up, conv_w, conv_b, w_down):
    g = h @ w_gate
    gp = jnp.pad(g, ((0, 0), (1, 1), (0, 0)))
    g = gp[:, :-2] * conv_w[0] + gp[:, 1:-1] * conv_w[1] + gp[:, 2:] * conv_w[2] + conv_b
    return (jax.nn.silu(g) * (h @ w_up)) @ w_down


def modulation(cond, w_mod, b_mod):
    return jnp.split(jax.nn.silu(cond) @ w_mod + b_mod, 6, axis=-1)


def setup_inputs(seed: int = 0) -> dict:
    key = jax.random.key(seed)
    ks = iter(jax.random.split(key, 40))

    def nrm(shape, scale):
        return jax.random.normal(next(ks), shape, jnp.float32) * scale

    def gain(shape):
        return 1.0 + nrm(shape, 0.01)

    D, F = D_MODEL, D_FF
    return {
        "x": nrm((BATCH, SEQ, D), 1.0),
        "c": nrm((BATCH, D), 1.0),
        "ctx": nrm((BATCH, CTX_LEN, D), 1.0),
        "c_ctx": nrm((D,), 1.0),
        "w_mod": nrm((DEPTH, D, 6 * D), 0.5 * D ** -0.5),
        "b_mod": nrm((DEPTH, 6 * D), 0.01),
        "ln1_g": gain((DEPTH, D)),
        "ln1_b": nrm((DEPTH, D), 0.01),
        "ln2_g": gain((DEPTH, D)),
        "ln2_b": nrm((DEPTH, D), 0.01),
        "ffn_w_gate": nrm((DEPTH, D, F), D ** -0.5),
        "ffn_w_up": nrm((DEPTH, D, F), D ** -0.5),
        "ffn_conv_w": nrm((DEPTH, 3, F), 3 ** -0.5),
        "ffn_conv_b": nrm((DEPTH, F), 0.01),
        "ffn_w_down": nrm((DEPTH, F, D), BETA * F ** -0.5),
        "ab_w_in": nrm((N_EVEN, D, EVEN_IN), D ** -0.5),
        "mla_q_norm": gain((N_EVEN, MLA_Q_RANK)),
        "mla_w_qb": nrm((N_EVEN, MLA_Q_RANK, MLA_HEADS * (MLA_NOPE + MLA_ROPE)), MLA_Q_RANK ** -0.5),
        "mla_kv_norm": gain((N_EVEN, MLA_KV_RANK)),
        "mla_w_kvb": nrm((N_EVEN, MLA_KV_RANK, MLA_HEADS * (MLA_NOPE + MLA_V)), MLA_KV_RANK ** -0.5),
        "swa_sink": nrm((N_EVEN, SWA_HEADS), 0.5),
        "ab_w_out": nrm((N_EVEN, EVEN_OUT, D), BETA * EVEN_OUT ** -0.5),
        "diff_w_in": nrm((N_ODD, D, ODD_IN), D ** -0.5),
        "diff_lam_q1": nrm((N_ODD, HEAD_DIM), 0.1),
        "diff_lam_k1": nrm((N_ODD, HEAD_DIM), 0.1),
        "diff_lam_q2": nrm((N_ODD, HEAD_DIM), 0.1),
        "diff_lam_k2": nrm((N_ODD, HEAD_DIM), 0.1),
        "diff_subln_g": gain((N_ODD, 2 * HEAD_DIM)),
        "diff_w_out": nrm((N_ODD, ODD_OUT, D), BETA * ODD_OUT ** -0.5),
    }


def reference(x, c, ctx, c_ctx, w_mod, b_mod, ln1_g, ln1_b, ln2_g, ln2_b,
              ffn_w_gate, ffn_w_up, ffn_conv_w, ffn_conv_b, ffn_w_down,
              ab_w_in, mla_q_norm, mla_w_qb, mla_kv_norm, mla_w_kvb, swa_sink, ab_w_out,
              diff_w_in, diff_lam_q1, diff_lam_k1, diff_lam_q2, diff_lam_k2, diff_subln_g, diff_w_out):
    S = x.shape[1]
    ROWS = S // GRID_W
    rope32 = axial_rope_tables(ROWS, MLA_ROPE)
    rope64 = axial_rope_tables(ROWS, HEAD_DIM)
    xl, xc = x, ctx
    for i in range(DEPTH):
        need_ctx = i < DEPTH - 1
        j = i // 2
        sh1_l, sc1_l, gt1_l, sh2_l, sc2_l, gt2_l = [t[:, None, :] for t in modulation(c, w_mod[i], b_mod[i])]
        sh1_c, sc1_c, gt1_c, sh2_c, sc2_c, gt2_c = modulation(c_ctx, w_mod[i], b_mod[i])
        h_l = xl * (1.0 + sc1_l) + sh1_l
        h_c = xc * (1.0 + sc1_c) + sh1_c
        if i % 2 == 0:
            o_l, o_c = even_mixer(h_l, h_c, ab_w_in[j], mla_q_norm[j], mla_w_qb[j], mla_kv_norm[j],
                                  mla_w_kvb[j], swa_sink[j], ab_w_out[j], rope32, rope64, need_ctx)
        else:
            lambda_init = 0.8 - 0.6 * math.exp(-0.3 * i)
            o_l, o_c = odd_mixer(h_l, h_c, diff_w_in[j], diff_lam_q1[j], diff_lam_k1[j], diff_lam_q2[j],
                                 diff_lam_k2[j], diff_subln_g[j], diff_w_out[j], rope64, lambda_init, need_ctx)
        xl = layer_norm(ALPHA * xl + gt1_l * o_l, ln1_g[i], ln1_b[i])
        h_l = xl * (1.0 + sc2_l) + sh2_l
        f_l = conv_ffn(h_l, ffn_w_gate[i], ffn_w_up[i], ffn_conv_w[i], ffn_conv_b[i], ffn_w_down[i])
        xl = layer_norm(ALPHA * xl + gt2_l * f_l, ln2_g[i], ln2_b[i])
        if need_ctx:
            xc = layer_norm(ALPHA * xc + gt1_c * o_c, ln1_g[i], ln1_b[i])
            h_c = xc * (1.0 + sc2_c) + sh2_c
            f_c = conv_ffn(h_c, ffn_w_gate[i], ffn_w_up[i], ffn_conv_w[i], ffn_conv_b[i], ffn_w_down[i])
            xc = layer_norm(ALPHA * xc + gt2_c * f_c, ln2_g[i], ln2_b[i])
    return xl
```

```cpp
#include <hip/hip_runtime.h>
#include <hip/hip_cooperative_groups.h>
#include <cstdio>
#include <cstdint>
namespace cg = cooperative_groups;

#ifndef EXTRA_PHASE
#define EXTRA_PHASE -1
#endif
#ifndef EXTRA_SYNCS
#define EXTRA_SYNCS 0
#endif
#ifndef MULTI_LAUNCH
#define MULTI_LAUNCH 0
#endif

typedef unsigned short bf16_t;
typedef short bf16x8 __attribute__((ext_vector_type(8)));
typedef float f32x4 __attribute__((ext_vector_type(4)));
typedef unsigned u32x4 __attribute__((ext_vector_type(4)));
typedef unsigned u32x2 __attribute__((ext_vector_type(2)));

constexpr int NBATCH = 8, SEQ = 2048, CTXL = 256, TOK = 2304, ROWS = NBATCH * TOK, DM = 1024, DFF = 2816;
constexpr int NTHREADS = 512, NWAVES = 8;
constexpr int LDC = 132;
constexpr int CT_FLOATS = 128 * 132;
constexpr int SMEM_BYTES = 139264;
constexpr float ALPHA_RES = 1.41421356237f;
constexpr float LOG2E = 1.44269504089f;
constexpr float LAMBDA_INIT = 0.35550907f;

struct Params {
    const float *x, *c, *ctx, *c_ctx, *w_mod, *b_mod, *ln1_g, *ln1_b, *ln2_g, *ln2_b;
    const float *w_gate, *w_up, *conv_w, *conv_b, *w_down;
    const float *ab_w_in, *q_norm, *w_qb, *kv_norm, *w_kvb, *sink, *ab_w_out;
    const float *d_w_in, *lq1, *lk1, *lq2, *lk2, *subln, *d_w_out;
    float* out;
    bf16_t *wt_in0, *wt_qb, *wt_kvb, *wt_out0, *wt_din, *wt_dout, *wt_gate, *wt_up, *wt_down;
    float *mod, *misc, *xc;
    unsigned* bar;
    bf16_t *h, *o, *big;
};

constexpr size_t SZ_WT_IN0 = 1280ull * 1024 * 2, SZ_WT_QB = 768ull * 256 * 2, SZ_WT_KVB = 1024ull * 128 * 2, SZ_WT_SQ = 1024ull * 1024 * 2,
                 SZ_WT_DIN = 3072ull * 1024 * 2, SZ_WT_FF = 2ull * 2816 * 1024 * 2;
constexpr size_t OFF_WT_IN0 = 0, OFF_WT_QB = OFF_WT_IN0 + SZ_WT_IN0, OFF_WT_KVB = OFF_WT_QB + SZ_WT_QB, OFF_WT_OUT0 = OFF_WT_KVB + SZ_WT_KVB,
                 OFF_WT_DIN = OFF_WT_OUT0 + SZ_WT_SQ, OFF_WT_DOUT = OFF_WT_DIN + SZ_WT_DIN, OFF_WT_GATE = OFF_WT_DOUT + SZ_WT_SQ,
                 OFF_WT_UP = OFF_WT_GATE + SZ_WT_FF, OFF_WT_DOWN = OFF_WT_UP + SZ_WT_FF, OFF_MOD = OFF_WT_DOWN + SZ_WT_FF,
                 OFF_MISC = OFF_MOD + 2ull * 9 * 6144 * 4, OFF_BAR = OFF_MISC + 65536, OFF_XC = OFF_BAR + 16384, OFF_H = OFF_XC + 2048ull * 1024 * 4,
                 OFF_O = OFF_H + (size_t)ROWS * 1024 * 2, OFF_BIG = OFF_O + (size_t)ROWS * 1024 * 2;
constexpr size_t BE_PROJ0 = 0, BE_VT_SWA = BE_PROJ0 + (size_t)ROWS * 1024, BE_Q_MLA = BE_VT_SWA + 8ull * 2 * 64 * TOK,
                 BE_K_MLA = BE_Q_MLA + (size_t)ROWS * 768, BE_VT_MLA = BE_K_MLA + (size_t)ROWS * 768, BE_END0 = BE_VT_MLA + 8ull * 8 * 64 * TOK;
constexpr size_t BE_QD = 0, BE_KD = BE_QD + (size_t)ROWS * 1024, BE_VT_D = BE_KD + (size_t)ROWS * 1024, BE_END1 = BE_VT_D + 8ull * 8 * 128 * TOK;
constexpr size_t BE_HID = 0, BE_END2 = (size_t)ROWS * DFF;
constexpr size_t BIG_ELEMS = BE_END0 > BE_END1 ? (BE_END0 > BE_END2 ? BE_END0 : BE_END2) : (BE_END1 > BE_END2 ? BE_END1 : BE_END2);
constexpr size_t WS_END = OFF_BIG + BIG_ELEMS * 2;
constexpr int MISC_ROPE64 = 0, MISC_ROPE32 = 2048, MISC_LAM = 3072;

__device__ __forceinline__ unsigned cvt_pk_bf16(float lo, float hi) { unsigned r; asm("v_cvt_pk_bf16_f32 %0, %1, %2" : "=v"(r) : "v"(lo), "v"(hi)); return r; }
__device__ __forceinline__ float bf2f(unsigned short v) { return __uint_as_float((unsigned)v << 16); }
__device__ __forceinline__ float bflo(unsigned v) { return __uint_as_float(v << 16); }
__device__ __forceinline__ float bfhi(unsigned v) { return __uint_as_float(v & 0xffff0000u); }
__device__ __forceinline__ void store8(bf16_t* dst, const float (&v)[8]) {
    u32x4 w; w.x = cvt_pk_bf16(v[0], v[1]); w.y = cvt_pk_bf16(v[2], v[3]); w.z = cvt_pk_bf16(v[4], v[5]); w.w = cvt_pk_bf16(v[6], v[7]);
    *(u32x4*)dst = w;
}
__device__ __forceinline__ float wave_sum(float v) {
#pragma unroll
    for (int o = 1; o < 64; o <<= 1) v += __shfl_xor(v, o);
    return v;
}
__device__ __forceinline__ float fast_exp2(float x) { return __builtin_amdgcn_exp2f(x); }


#define XB_TMO      128
#define XB_XCNT(j)  (256  + 64 * (j))
#define XB_XSUB(j)  (1280 + 64 * (j))
#define XB_XGEN(j)  (2304 + 64 * (j))
#define XB_TOP      3328
#define XB_TOPGEN   3392
#define XCD_BAR_WORDS 3456
#define XB_SPIN_CAP (1u << 18)
#define LAS __attribute__((address_space(3)))
__device__ __forceinline__ unsigned xb_ld(unsigned* p)              { return __hip_atomic_load(p, __ATOMIC_RELAXED, __HIP_MEMORY_SCOPE_AGENT); }
__device__ __forceinline__ unsigned xb_add(unsigned* p, unsigned v) { return __hip_atomic_fetch_add(p, v, __ATOMIC_RELAXED, __HIP_MEMORY_SCOPE_AGENT); }
__device__ __forceinline__ unsigned xb_xcc_id() { return (unsigned)__builtin_amdgcn_s_getreg((3 << 11) | 20) & 0xFu; }
#define XB_SPIN(cond, bar) do { unsigned _sp = 0; while (cond) { __builtin_amdgcn_s_sleep(1); \
    if ((++_sp & 255u) == 0u) { if (xb_ld(&(bar)[XB_TMO])) break; if (_sp > XB_SPIN_CAP) { atomicAdd(&(bar)[XB_TMO], 1u); break; } } } } while (0)
struct XcdBarrier { unsigned* bar; unsigned x; volatile LAS unsigned* st; };
__device__ __forceinline__ XcdBarrier xcd_barrier_post(unsigned* bar, volatile LAS unsigned* st) {
    XcdBarrier b; b.bar = bar; b.x = xb_xcc_id(); b.st = st;
    if (threadIdx.x == 0) (void)xb_add(&bar[XB_XCNT(b.x)], 1u);
    return b;
}
__device__ __forceinline__ void xcd_barrier_complete(unsigned* bar, unsigned x, unsigned& nloc, unsigned& nx) {
    const unsigned G = gridDim.x * gridDim.y * gridDim.z;
    unsigned sum, cnt, mine, sp = 0u;
    for (;;) {
        sum = 0u; cnt = 0u; mine = 0u;
#pragma unroll
        for (unsigned j = 0; j < 16; ++j) { const unsigned c = xb_ld(&bar[XB_XCNT(j)]); sum += c; cnt += (c > 0u) ? 1u : 0u; mine = (j == x) ? c : mine; }
        if (sum == G) break;
        __builtin_amdgcn_s_sleep(1);
        if ((++sp & 255u) == 0u) { if (xb_ld(&bar[XB_TMO])) break; if (sp > XB_SPIN_CAP) { atomicAdd(&bar[XB_TMO], 1u); break; } }
    }
    nloc = mine > 0u ? mine : 1u; nx = cnt > 0u ? cnt : 1u;
}
__device__ __forceinline__ void xcd_barrier(const XcdBarrier& b) {
    asm volatile("s_waitcnt vmcnt(0)" ::: "memory");
    __syncthreads();
    if (threadIdx.x == 0) {
        unsigned* bar = b.bar;
        __builtin_amdgcn_s_waitcnt(0);
        unsigned nloc = b.st[0], nx = b.st[1];
        if (nloc == 0u) { xcd_barrier_complete(bar, b.x, nloc, nx); b.st[0] = nloc; b.st[1] = nx; }
        const unsigned old = xb_add(&bar[XB_XSUB(b.x)], 1u);
        const unsigned gen = old / nloc;
        if (old + 1u == (gen + 1u) * nloc) {
            __builtin_amdgcn_fence(__ATOMIC_RELEASE, "agent");
            asm volatile("s_waitcnt vmcnt(0)" ::: "memory");
            const unsigned og = xb_add(&bar[XB_TOP], 1u);
            const unsigned tg = og / nx;
            if (og + 1u == (tg + 1u) * nx) xb_add(&bar[XB_TOPGEN], 1u);
            else XB_SPIN(xb_ld(&bar[XB_TOPGEN]) == tg, bar);
            __builtin_amdgcn_fence(__ATOMIC_ACQUIRE, "agent");
            xb_add(&bar[XB_XGEN(b.x)], 1u);
            asm volatile("s_waitcnt vmcnt(0)" ::: "memory");
        } else {
            XB_SPIN(xb_ld(&bar[XB_XGEN(b.x)]) == gen, bar);
            __builtin_amdgcn_fence(__ATOMIC_ACQUIRE, "agent");
            asm volatile("s_waitcnt vmcnt(0)" ::: "memory");
        }
    }
    __syncthreads();
}

__device__ __forceinline__ void mod_item(const Params& p, char* smem, int it) {
    float* s_silu = (float*)smem;
    float* red = (float*)(smem + 9 * 1024 * 4);
    const int tid = threadIdx.x, lane = tid & 63, w = tid >> 6;
    const int layer = it / 96, col0 = (it % 96) * 64;
    for (int idx = tid; idx < 9 * 1024; idx += NTHREADS) {
        const int b = idx >> 10, k = idx & 1023;
        const float v = (b < 8) ? p.c[b * 1024 + k] : p.c_ctx[k];
        s_silu[idx] = v / (1.f + __expf(-v));
    }
    __syncthreads();
    float acc[9];
#pragma unroll
    for (int b = 0; b < 9; ++b) acc[b] = 0.f;
    const float* wp = p.w_mod + (size_t)layer * 1024 * 6144 + (size_t)(w * 128) * 6144 + col0 + lane;
    for (int kk = 0; kk < 128; kk += 8) {
        float wv[8];
#pragma unroll
        for (int u = 0; u < 8; ++u) wv[u] = wp[(size_t)(kk + u) * 6144];
#pragma unroll
        for (int b = 0; b < 9; ++b) {
            const f32x4 s0 = *(const f32x4*)(s_silu + b * 1024 + w * 128 + kk), s1 = *(const f32x4*)(s_silu + b * 1024 + w * 128 + kk + 4);
            acc[b] += s0[0] * wv[0] + s0[1] * wv[1] + s0[2] * wv[2] + s0[3] * wv[3] + s1[0] * wv[4] + s1[1] * wv[5] + s1[2] * wv[6] + s1[3] * wv[7];
        }
    }
#pragma unroll
    for (int b = 0; b < 9; ++b) red[(w * 9 + b) * 64 + lane] = acc[b];
    __syncthreads();
    for (int idx = tid; idx < 9 * 64; idx += NTHREADS) {
        const int b = idx >> 6, l = idx & 63;
        float s = 0.f;
#pragma unroll
        for (int ww = 0; ww < NWAVES; ++ww) s += red[(ww * 9 + b) * 64 + l];
        p.mod[(size_t)(layer * 9 + b) * 6144 + col0 + l] = s + p.b_mod[layer * 6144 + col0 + l];
    }
}

__device__ __forceinline__ void table_item(const Params& p) {
    const int tid = threadIdx.x;
    for (int idx = tid; idx < 64 * 16; idx += NTHREADS) {
        const int pi = idx >> 4, i = idx & 15;
        const float freq = exp2f(-(float)i * (13.28771238f / 16.f));
        const float ang = (float)pi * freq;
        p.misc[MISC_ROPE64 + idx * 2] = __cosf(ang); p.misc[MISC_ROPE64 + idx * 2 + 1] = __sinf(ang);
    }
    for (int idx = tid; idx < 64 * 8; idx += NTHREADS) {
        const int pi = idx >> 3, i = idx & 7;
        const float freq = exp2f(-(float)i * (13.28771238f / 8.f));
        const float ang = (float)pi * freq;
        p.misc[MISC_ROPE32 + idx * 2] = __cosf(ang); p.misc[MISC_ROPE32 + idx * 2 + 1] = __sinf(ang);
    }
    if (tid == 0) {
        float s1 = 0.f, s2 = 0.f;
        for (int i = 0; i < 64; ++i) { s1 += p.lq1[i] * p.lk1[i]; s2 += p.lq2[i] * p.lk2[i]; }
        p.misc[MISC_LAM] = __expf(s1) - __expf(s2) + LAMBDA_INIT;
    }
}

__device__ __forceinline__ void transpose_tile(char* smem, const float* src, int K, int Nsrc, bf16_t* dst, int ntn, int mode, const float* gain, int tile, int dmul = 1, int dadd = 0) {
    float* t = (float*)smem;
    const int tid = threadIdx.x, tx = tid & 63, ty = tid >> 6;
    const int kt = tile / ntn, nt = tile % ntn;
    const int np = nt * 64 + tx;
    int n = np;
    if (mode == 1) { n = np < 896 ? np : (np < 1024 ? 928 + (np - 896) : (np < 1152 ? 1056 + (np - 1024) : (np < 1184 ? 896 + (np - 1152) : -1))); }
    else if (mode == 2) { if (np < 512) n = (np >> 6) * 96 + (np & 63); else { const int m = np - 512; n = (m >> 5) * 96 + 64 + (m & 31); } }
#pragma unroll
    for (int i = 0; i < 8; ++i) {
        const int kl = ty + 8 * i, k = kt * 64 + kl;
        float v = 0.f;
        if (n >= 0) { v = src[(size_t)k * Nsrc + n]; if (gain) v *= gain[k]; }
        t[kl * 65 + tx] = v;
    }
    __syncthreads();
#pragma unroll
    for (int i = 0; i < 8; ++i) {
        const int nl = ty + 8 * i;
        dst[(size_t)((nt * dmul + dadd) * 64 + nl) * K + kt * 64 + tx] = (bf16_t)(cvt_pk_bf16(t[tx * 65 + nl], 0.f) & 0xffffu);
    }
}

__device__ __forceinline__ void transpose_item(const Params& p, char* smem, int r) {
    constexpr int T0 = 16 * 20, T1 = 4 * 12, T2 = 2 * 16, T3 = 16 * 16, T4 = 16 * 48, T5 = 16 * 16, TF = 16 * 44;
    if (r < T0) { transpose_tile(smem, p.ab_w_in, 1024, 1184, p.wt_in0, 20, 1, nullptr, r); return; } r -= T0;
    if (r < T1) { transpose_tile(smem, p.w_qb, 256, 768, p.wt_qb, 12, 2, p.q_norm, r); return; } r -= T1;
    if (r < T2) { transpose_tile(smem, p.w_kvb, 128, 1024, p.wt_kvb, 16, 0, p.kv_norm, r); return; } r -= T2;
    if (r < T3) { transpose_tile(smem, p.ab_w_out, 1024, 1024, p.wt_out0, 16, 0, nullptr, r); return; } r -= T3;
    if (r < T4) { transpose_tile(smem, p.d_w_in, 1024, 3072, p.wt_din, 48, 0, nullptr, r); return; } r -= T4;
    if (r < T5) { transpose_tile(smem, p.d_w_out, 1024, 1024, p.wt_dout, 16, 0, nullptr, r); return; } r -= T5;
    {
        const int j = r / TF, rr = r % TF;
        if (j < 2) transpose_tile(smem, p.w_gate + (size_t)j * 1024 * 2816, 1024, 2816, p.wt_gate + (size_t)j * 5632 * 1024, 44, 0, nullptr, rr, 2, 0);
        else if (j < 4) transpose_tile(smem, p.w_up + (size_t)(j - 2) * 1024 * 2816, 1024, 2816, p.wt_gate + (size_t)(j - 2) * 5632 * 1024, 44, 0, nullptr, rr, 2, 1);
        else transpose_tile(smem, p.w_down + (size_t)(j - 4) * 2816 * 1024, 2816, 1024, p.wt_down + (size_t)(j - 4) * 1024 * 2816, 16, 0, nullptr, rr);
    }
}
constexpr int N_TR_TILES = 16 * 20 + 4 * 12 + 2 * 16 + 16 * 16 + 16 * 48 + 16 * 16 + 6 * 16 * 44;

__device__ __forceinline__ void phase_prologue(const Params& p, char* smem) {
    const int total = 193 + N_TR_TILES;
    for (int it = blockIdx.x; it < total; it += gridDim.x) {
        if (it < 192) mod_item(p, smem, it);
        else if (it == 192) table_item(p);
        else transpose_item(p, smem, it - 193);
        __syncthreads();
    }
}

__device__ __forceinline__ void phase_h0(const Params& p) {
    const int lane = threadIdx.x & 63, w = threadIdx.x >> 6;
    for (int row = blockIdx.x * NWAVES + w; row < ROWS; row += gridDim.x * NWAVES) {
        const int b = row / TOK, j = row % TOK; const bool isc = j < CTXL;
        const float* rp = isc ? p.ctx + ((size_t)b * CTXL + j) * DM : p.x + ((size_t)b * SEQ + (j - CTXL)) * DM;
        const float* md = p.mod + (size_t)(0 * 9 + (isc ? 8 : b)) * 6144;
#pragma unroll 1
        for (int i = 0; i < 4; ++i) {
            const int col = i * 256 + lane * 4;
            const f32x4 v = *(const f32x4*)(rp + col), sh = *(const f32x4*)(md + col), sc = *(const f32x4*)(md + 1024 + col);
            u32x2 o; o.x = cvt_pk_bf16(v[0] * (1.f + sc[0]) + sh[0], v[1] * (1.f + sc[1]) + sh[1]); o.y = cvt_pk_bf16(v[2] * (1.f + sc[2]) + sh[2], v[3] * (1.f + sc[3]) + sh[3]);
            *(u32x2*)(p.h + (size_t)row * DM + col) = o;
        }
    }
}

__device__ __forceinline__ void gemm_core(char* smem, const bf16_t* __restrict__ A, int lda, int ar0a, int aloa, int ahia, int ar0b, int alob, int ahib,
                                          const bf16_t* __restrict__ B, int ldb, int K, const bf16_t* zero16, f32x4 (&acc)[8][4]) {
    constexpr int ROWB = 128, OPA = 256 * ROWB, STG = 2 * OPA, NI = 4;
    static_assert(2 * STG <= SMEM_BYTES, "LDS");
    const int tid = threadIdx.x, lane = tid & 63, w = __builtin_amdgcn_readfirstlane(tid >> 6), wr = w >> 2, wc = w & 3, fr = lane & 15, fq = lane >> 4;
    const int rl = lane >> 3, kcs = (lane & 7) ^ rl;
#pragma unroll
    for (int m = 0; m < 8; ++m)
#pragma unroll
        for (int n = 0; n < 4; ++n) acc[m][n] = (f32x4){0.f, 0.f, 0.f, 0.f};
    const int nk = K / 64;
    int aoff[NI], boff[NI];
#pragma unroll
    for (int i = 0; i < NI; ++i) {
        const int row = (w * NI + i) * 8 + rl, hf = row >> 7, gr = (hf ? ar0b : ar0a) + (row & 127);
        const bool ok = hf ? (gr >= alob && gr < ahib) : (gr >= aloa && gr < ahia);
        aoff[i] = ok ? gr * lda + kcs * 8 : -1;
        boff[i] = row * ldb + kcs * 8;
    }
    __syncthreads();
#pragma unroll
    for (int i = 0; i < NI; ++i) {
        __builtin_amdgcn_global_load_lds((const unsigned*)(aoff[i] >= 0 ? A + aoff[i] : zero16), (LAS unsigned*)(smem + (w * NI + i) * 1024), 16, 0, 0);
        __builtin_amdgcn_global_load_lds((const unsigned*)(B + boff[i]), (LAS unsigned*)(smem + OPA + (w * NI + i) * 1024), 16, 0, 0);
    }
    asm volatile("s_waitcnt vmcnt(0)" ::: "memory"); __syncthreads();
    const int sw = fr & 7;
    for (int kt = 0; kt < nk; ++kt) {
        const bool pf = kt + 1 < nk; const int nst = ((kt + 1) & 1) * STG;
        const char* base = smem + (kt & 1) * STG;
#pragma unroll
        for (int ks = 0; ks < 2; ++ks) {
            const int co = (((ks * 4 + fq) ^ sw) * 16);
            bf16x8 bfr[4];
#pragma unroll
            for (int n = 0; n < 4; ++n) bfr[n] = *(const bf16x8*)(base + OPA + (wc * 64 + n * 16 + fr) * ROWB + co);
#pragma unroll
            for (int m = 0; m < 8; ++m) {
                const bf16x8 af = *(const bf16x8*)(base + (wr * 128 + m * 16 + fr) * ROWB + co);
#pragma unroll
                for (int n = 0; n < 4; ++n) acc[m][n] = __builtin_amdgcn_mfma_f32_16x16x32_bf16(af, bfr[n], acc[m][n], 0, 0, 0);
                if (pf && ((ks == 0) ? true : (m < 4)) && (ks == 0 ? (m & 1) == 0 || m >= 0 : true) && ((ks * 8 + m) < 12) && (((ks * 8 + m) % 3) != 2)) {
                    const int pi = (ks * 8 + m) - (ks * 8 + m) / 3;
                    const int i = pi & 3, lo_ = nst + (w * NI + i) * 1024;
                    if (pi < 4) __builtin_amdgcn_global_load_lds((const unsigned*)(aoff[i] >= 0 ? A + aoff[i] + (kt + 1) * 64 : zero16), (LAS unsigned*)(smem + lo_), 16, 0, 0);
                    else __builtin_amdgcn_global_load_lds((const unsigned*)(B + boff[i] + (kt + 1) * 64), (LAS unsigned*)(smem + lo_ + OPA), 16, 0, 0);
                }
            }
        }
        asm volatile("s_waitcnt vmcnt(0)" ::: "memory");
        __syncthreads();
    }
}

__device__ __forceinline__ void acc_to_ct(float* Ct0, const f32x4 (&acc)[8][4], int ai) {
    const int tid = threadIdx.x, lane = tid & 63, w = tid >> 6, wr = w >> 2, wc = w & 3, fr = lane & 15, fq = lane >> 4;
    __syncthreads();
    if (wr == ai) {
        float* Ct = Ct0 + (wc >> 1) * CT_FLOATS + (wc & 1) * 64 + fr;
#pragma unroll
        for (int m = 0; m < 8; ++m)
#pragma unroll
            for (int n = 0; n < 4; ++n)
#pragma unroll
                for (int j = 0; j < 4; ++j) Ct[(m * 16 + fq * 4 + j) * LDC + n * 16] = acc[m][n][j];
    }
    __syncthreads();
}

__device__ __forceinline__ void load8(const float* src, float (&v)[8]) {
    const f32x4 a = *(const f32x4*)src, b = *(const f32x4*)(src + 4);
    v[0] = a[0]; v[1] = a[1]; v[2] = a[2]; v[3] = a[3]; v[4] = b[0]; v[5] = b[1]; v[6] = b[2]; v[7] = b[3];
}

__device__ __forceinline__ void rope8(const float* rowp, int c0, int hd, int pos, const float* tab, float (&v)[8]) {
    const int qs = hd >> 2, ch = c0 & (hd - 1), qd = ch / qs, i0 = ch & (qs - 1);
    const int idx = (qd < 2) ? (pos >> 6) : (pos & 63);
    const int pc = (qd & 1) ? c0 - qs : c0 + qs; const float sgn = (qd & 1) ? 1.f : -1.f;
    const float* t = tab + (idx * qs + i0) * 2;
#pragma unroll
    for (int e = 0; e < 8; ++e) v[e] = v[e] * t[2 * e] + sgn * rowp[pc + e] * t[2 * e + 1];
}

__device__ __forceinline__ void store_col8(const float* Ct, int c, int rc, bf16_t* dst, const float* rs) {
    float v[8];
#pragma unroll
    for (int e = 0; e < 8; ++e) { v[e] = Ct[(rc * 8 + e) * LDC + c]; if (rs) v[e] *= rs[rc * 8 + e]; }
    store8(dst, v);
}

__device__ __forceinline__ void epi_proj0(const Params& p, const float* Ct, int mt, int nt) {
    const int tid = threadIdx.x;
    bf16_t* proj0 = p.big + BE_PROJ0; bf16_t* vt_swa = p.big + BE_VT_SWA; bf16_t* k_mla = p.big + BE_K_MLA;
    const float* rope64 = p.misc + MISC_ROPE64; const float* rope32 = p.misc + MISC_ROPE32;
    const int b = mt / 18, jt = mt % 18; const bool is_ctx = jt < 2; const int row0 = mt * 128, tok0 = jt * 128;
    if (nt == 8) {
#pragma unroll 1
        for (int i = 0; i < 4; ++i) { const int id = tid + NTHREADS * i, c = id & 127, rc = id >> 7;
            store_col8(Ct, c, rc, vt_swa + (size_t)((b * 2 + (c >> 6)) * 64 + (c & 63)) * TOK + tok0 + rc * 8, nullptr); }
    } else {
#pragma unroll 1
        for (int i = 0; i < 4; ++i) {
            const int id = tid + NTHREADS * i, r = id >> 4, c0 = (id & 15) * 8;
            const float* rowp = Ct + r * LDC; float v[8]; load8(rowp + c0, v);
            const int grow = row0 + r, pos = tok0 + r - CTXL;
            if (nt <= 1 || nt == 6) { store8(proj0 + (size_t)grow * 1024 + nt * 128 + c0, v); }
            else if (nt <= 5 || nt == 7) { if (!is_ctx) rope8(rowp, c0, 64, pos, rope64, v); store8(proj0 + (size_t)grow * 1024 + (nt == 7 ? 896 : nt * 128) + c0, v); }
            else if (c0 < 32) { if (!is_ctx) rope8(rowp, c0, 32, pos, rope32, v);
#pragma unroll
                for (int hh = 0; hh < 8; ++hh) store8(k_mla + (size_t)grow * 768 + hh * 96 + 64 + c0, v); }
        }
    }
}
__device__ __forceinline__ void phase_proj0(const Params& p, char* smem) {
    float* Ct = (float*)smem;
    for (int it = blockIdx.x; it < 72 * 5; it += gridDim.x) {
        const int mt2 = it / 5, nt2 = it % 5;
        f32x4 acc[8][4];
        gemm_core(smem, p.h, DM, mt2 * 256, 0, ROWS, mt2 * 256 + 128, 0, ROWS, p.wt_in0 + (size_t)nt2 * 256 * DM, DM, DM, (const bf16_t*)p.bar, acc);
#pragma unroll 1
        for (int ai = 0; ai < 2; ++ai) {
            acc_to_ct(Ct, acc, ai);
            epi_proj0(p, Ct, mt2 * 2 + ai, nt2 * 2);
            epi_proj0(p, Ct + CT_FLOATS, mt2 * 2 + ai, nt2 * 2 + 1);
        }
    }
}

__device__ __forceinline__ void row_rstd(const bf16_t* A, int lda, int row0, int K, float* rs) {
    const int tid = threadIdx.x;
    if (tid < 256) {
        const int r = tid >> 1, hf = tid & 1; const int n = K / 2;
        const bf16_t* ap = A + (size_t)(row0 + r) * lda + hf * n; float ss = 0.f;
        for (int k = 0; k < n; k += 8) { const u32x4 v = *(const u32x4*)(ap + k);
            ss += bflo(v.x) * bflo(v.x) + bfhi(v.x) * bfhi(v.x) + bflo(v.y) * bflo(v.y) + bfhi(v.y) * bfhi(v.y) + bflo(v.z) * bflo(v.z) + bfhi(v.z) * bfhi(v.z) + bflo(v.w) * bflo(v.w) + bfhi(v.w) * bfhi(v.w); }
        ss += __shfl_xor(ss, 1);
        if (hf == 0) rs[r] = rsqrtf(ss / (float)K + 1e-6f);
    }
    __syncthreads();
}
__device__ __forceinline__ void epi_mla_q(const Params& p, const float* Ct, const float* rs, int mt, int nt) {
    const int tid = threadIdx.x; bf16_t* q_mla = p.big + BE_Q_MLA; const float* rope32 = p.misc + MISC_ROPE32;
    const int jt = mt % 18; const bool is_ctx = jt < 2; const int row0 = mt * 128, tok0 = jt * 128;
#pragma unroll 1
    for (int i = 0; i < 4; ++i) {
        const int id = tid + NTHREADS * i, r = id >> 4, c0 = (id & 15) * 8;
        const float* rowp = Ct + r * LDC; float v[8]; load8(rowp + c0, v);
        const int grow = row0 + r, pos = tok0 + r - CTXL; const float sc = rs[r];
        int dcol;
        if (nt < 4) { const int cg = nt * 128 + c0; dcol = (cg >> 6) * 96 + (cg & 63); }
        else { const int cg = (nt - 4) * 128 + c0; dcol = (cg >> 5) * 96 + 64 + (cg & 31); if (!is_ctx) rope8(rowp, c0, 32, pos, rope32, v); }
#pragma unroll
        for (int e = 0; e < 8; ++e) v[e] *= sc;
        store8(q_mla + (size_t)grow * 768 + dcol, v);
    }
}
__device__ __forceinline__ void epi_mla_kv(const Params& p, const float* Ct, const float* rs, int mt, int hh) {
    const int tid = threadIdx.x; bf16_t* k_mla = p.big + BE_K_MLA; bf16_t* vt_mla = p.big + BE_VT_MLA;
    const int b = mt / 18, jt = mt % 18; const int row0 = mt * 128, tok0 = jt * 128;
#pragma unroll 1
    for (int i = 0; i < 2; ++i) {
        const int id = tid + NTHREADS * i, r = id >> 3, c0 = (id & 7) * 8;
        float v[8]; load8(Ct + r * LDC + c0, v); const float sc = rs[r];
#pragma unroll
        for (int e = 0; e < 8; ++e) v[e] *= sc;
        store8(k_mla + (size_t)(row0 + r) * 768 + hh * 96 + c0, v);
    }
#pragma unroll 1
    for (int i = 0; i < 2; ++i) { const int id = tid + NTHREADS * i, c = 64 + (id & 63), rc = id >> 6;
        store_col8(Ct, c, rc, vt_mla + (size_t)((b * 8 + hh) * 64 + (c - 64)) * TOK + tok0 + rc * 8, rs); }
}
__device__ __forceinline__ void phase_mla_up(const Params& p, char* smem) {
    float* Ct = (float*)smem; float* rs = (float*)(smem + 2 * CT_FLOATS * 4);
    bf16_t* proj0 = p.big + BE_PROJ0;
    for (int it = blockIdx.x; it < 72 * 7; it += gridDim.x) {
        const int mt2 = it / 7, nt2 = it % 7;
        f32x4 acc[8][4];
        if (nt2 < 3) gemm_core(smem, proj0, 1024, mt2 * 256, 0, ROWS, mt2 * 256 + 128, 0, ROWS, p.wt_qb + (size_t)nt2 * 256 * 256, 256, 256, (const bf16_t*)p.bar, acc);
        else gemm_core(smem, proj0 + 768, 1024, mt2 * 256, 0, ROWS, mt2 * 256 + 128, 0, ROWS, p.wt_kvb + (size_t)(nt2 - 3) * 256 * 128, 128, 128, (const bf16_t*)p.bar, acc);
#pragma unroll 1
        for (int ai = 0; ai < 2; ++ai) {
            acc_to_ct(Ct, acc, ai);
            const int mt = mt2 * 2 + ai;
            if (nt2 < 3) { row_rstd(proj0, 1024, mt * 128, 256, rs); epi_mla_q(p, Ct, rs, mt, nt2 * 2); epi_mla_q(p, Ct + CT_FLOATS, rs, mt, nt2 * 2 + 1); }
            else { row_rstd(proj0 + 768, 1024, mt * 128, 128, rs); epi_mla_kv(p, Ct, rs, mt, (nt2 - 3) * 2); epi_mla_kv(p, Ct + CT_FLOATS, rs, mt, (nt2 - 3) * 2 + 1); }
        }
    }
}

template <int DQK, int DV, bool WINDOWED>
__device__ __forceinline__ void flash_pass(char* smem, const bf16_t* __restrict__ Qp, int ldq, const bf16_t* __restrict__ Kp, int ldk,
                                           const bf16_t* __restrict__ Vtp, int seg2s, int seg2e, int q_tok0, float sc2,
                                           f32x4 (&o)[DV / 16][2], float (&mrun)[2], float (&lrun)[2]) {
    constexpr int KROW = DQK * 2, VROW = 128, KB = 64 * KROW, VB = DV * VROW, STG = KB + VB;
    constexpr int KCPR = DQK / 8, NKI = KCPR, NVI = DV / 8, KCPT = (NKI + 7) / 8, VCPT = NVI / 8, NKS = DQK / 32, NMD = DV / 16;
    static_assert(2 * STG <= SMEM_BYTES, "LDS");
    const int tid = threadIdx.x, lane = tid & 63, w = tid >> 6, fr = lane & 15, fq = lane >> 4, wq0 = w * 32;
    bf16x8 qf[2][NKS];
#pragma unroll
    for (int nq = 0; nq < 2; ++nq)
#pragma unroll
        for (int ks = 0; ks < NKS; ++ks) qf[nq][ks] = *(const bf16x8*)(Qp + (size_t)(wq0 + nq * 16 + fr) * ldq + ks * 32 + fq * 8);
#pragma unroll
    for (int md = 0; md < NMD; ++md) { o[md][0] = (f32x4){0.f, 0.f, 0.f, 0.f}; o[md][1] = (f32x4){0.f, 0.f, 0.f, 0.f}; }
    float mref[2]; mref[0] = mref[1] = -1e30f; lrun[0] = lrun[1] = 0.f;
    const float thr = 8.0f / sc2;
    const int nt = 4 + (seg2e > seg2s ? (seg2e - seg2s) / 64 : 0);
    const int wu = __builtin_amdgcn_readfirstlane(w);
    int koffg[KCPT], voffg[VCPT];
#pragma unroll
    for (int i = 0; i < KCPT; ++i) { const int idx = (wu + 8 * i) * 64 + lane, rho = (idx / KCPR) & 63, cp = idx % KCPR;
        const int key = 32 * (rho >> 5) + 8 * ((rho >> 2) & 3) + 4 * ((rho >> 4) & 1) + (rho & 3);
        const int kcs = (DQK == 64) ? (cp ^ (rho & 7)) : ((cp & ~3) | ((cp & 3) ^ ((4 - ((rho >> 2) & 3)) & 3)));
        koffg[i] = key * ldk + kcs * 8; }
#pragma unroll
    for (int i = 0; i < VCPT; ++i) { const int idx = (wu + 8 * i) * 64 + lane, r = idx >> 3, cp = idx & 7; voffg[i] = r * TOK + ((cp ^ (r & 7)) * 8); }
    __syncthreads();
#define FDMA(t, st) do { const int key0_ = (t) < 4 ? (t) * 64 : seg2s + ((t) - 4) * 64; const bf16_t* kg_ = Kp + (size_t)key0_ * ldk; const bf16_t* vg_ = Vtp + key0_; \
        _Pragma("unroll") for (int i = 0; i < KCPT; ++i) if (wu + 8 * i < NKI) __builtin_amdgcn_global_load_lds((const unsigned*)(kg_ + koffg[i]), (LAS unsigned*)(smem + (st) * STG + (wu + 8 * i) * 1024), 16, 0, 0); \
        _Pragma("unroll") for (int i = 0; i < VCPT; ++i) __builtin_amdgcn_global_load_lds((const unsigned*)(vg_ + voffg[i]), (LAS unsigned*)(smem + (st) * STG + KB + (wu + 8 * i) * 1024), 16, 0, 0); } while (0)
    FDMA(0, 0);
    asm volatile("s_waitcnt vmcnt(0)" ::: "memory"); __syncthreads();
    const int ksw = (DQK == 64) ? (fr & 7) : ((4 - ((fr >> 2) & 3)) & 3);
    for (int t = 0; t < nt; ++t) {
        if (t + 1 < nt) FDMA(t + 1, (t + 1) & 1);
        const char* kb = smem + (t & 1) * STG; const char* vb = kb + KB;
        const int key0 = t < 4 ? t * 64 : seg2s + (t - 4) * 64;
        f32x4 s[4][2];
#pragma unroll
        for (int mk = 0; mk < 4; ++mk) { s[mk][0] = (f32x4){0.f, 0.f, 0.f, 0.f}; s[mk][1] = (f32x4){0.f, 0.f, 0.f, 0.f}; }
#pragma unroll
        for (int ks = 0; ks < NKS; ++ks) {
            const int co = (DQK == 64) ? (((ks * 4 + fq) ^ ksw) * 16) : ((ks * 4 + (fq ^ ksw)) * 16);
#pragma unroll
            for (int mk = 0; mk < 4; ++mk) {
                const bf16x8 kf = *(const bf16x8*)(kb + (mk * 16 + fr) * KROW + co);
                s[mk][0] = __builtin_amdgcn_mfma_f32_16x16x32_bf16(kf, qf[0][ks], s[mk][0], 0, 0, 0);
                s[mk][1] = __builtin_amdgcn_mfma_f32_16x16x32_bf16(kf, qf[1][ks], s[mk][1], 0, 0, 0);
            }
        }
        __builtin_amdgcn_sched_barrier(0);
        bf16x8 pf[2][2];
#pragma unroll
        for (int nq = 0; nq < 2; ++nq) {
            if (WINDOWED && key0 >= CTXL) {
                const int qpos = q_tok0 - CTXL + wq0 + nq * 16 + fr;
#pragma unroll
                for (int mk = 0; mk < 4; ++mk)
#pragma unroll
                    for (int j = 0; j < 4; ++j) { const int kpos = key0 - CTXL + 32 * (mk >> 1) + 8 * fq + 4 * (mk & 1) + j; const int d = qpos - kpos; if (d > 128 || d < -128) s[mk][nq][j] = -1e30f; }
            }
            float mx = fmaxf(fmaxf(s[0][nq][0], s[0][nq][1]), fmaxf(s[0][nq][2], s[0][nq][3]));
#pragma unroll
            for (int mk = 1; mk < 4; ++mk) mx = fmaxf(fmaxf(mx, fmaxf(s[mk][nq][0], s[mk][nq][1])), fmaxf(s[mk][nq][2], s[mk][nq][3]));
            mx = fmaxf(mx, __shfl_xor(mx, 16)); mx = fmaxf(mx, __shfl_xor(mx, 32));
            const bool need = mx > mref[nq] + thr;
            if (__any(need)) {
                const float mnew = need ? mx : mref[nq];
                const float alpha = fast_exp2((mref[nq] - mnew) * sc2);
                mref[nq] = mnew; lrun[nq] *= alpha;
#pragma unroll
                for (int md = 0; md < NMD; ++md) o[md][nq] = o[md][nq] * alpha;
            }
            const float nm = -mref[nq] * sc2;
            float ls = 0.f;
#pragma unroll
            for (int mk = 0; mk < 4; ++mk)
#pragma unroll
                for (int j = 0; j < 4; ++j) { const float pv = fast_exp2(fmaf(s[mk][nq][j], sc2, nm)); s[mk][nq][j] = pv; ls += pv; }
            lrun[nq] += ls;
#pragma unroll
            for (int kk = 0; kk < 2; ++kk) {
                u32x4 pk; pk.x = cvt_pk_bf16(s[2 * kk][nq][0], s[2 * kk][nq][1]); pk.y = cvt_pk_bf16(s[2 * kk][nq][2], s[2 * kk][nq][3]);
                pk.z = cvt_pk_bf16(s[2 * kk + 1][nq][0], s[2 * kk + 1][nq][1]); pk.w = cvt_pk_bf16(s[2 * kk + 1][nq][2], s[2 * kk + 1][nq][3]);
                pf[nq][kk] = __builtin_bit_cast(bf16x8, pk);
            }
        }
        __builtin_amdgcn_sched_barrier(0);
#pragma unroll
        for (int kk = 0; kk < 2; ++kk) {
            const int co = (((kk * 4 + fq) ^ (fr & 7)) * 16);
#pragma unroll
            for (int md = 0; md < NMD; ++md) {
                const bf16x8 vf = *(const bf16x8*)(vb + (md * 16 + fr) * VROW + co);
                o[md][0] = __builtin_amdgcn_mfma_f32_16x16x32_bf16(vf, pf[0][kk], o[md][0], 0, 0, 0);
                o[md][1] = __builtin_amdgcn_mfma_f32_16x16x32_bf16(vf, pf[1][kk], o[md][1], 0, 0, 0);
            }
        }
        asm volatile("s_waitcnt vmcnt(0)" ::: "memory");
        __syncthreads();
    }
#undef FDMA
#pragma unroll
    for (int nq = 0; nq < 2; ++nq) { float l = lrun[nq]; l += __shfl_xor(l, 16); l += __shfl_xor(l, 32); lrun[nq] = l; mrun[nq] = mref[nq] * sc2; }
}

template <int NMD>
__device__ __forceinline__ void store_o(bf16_t* Op, int ldo, const f32x4 (&o)[NMD][2], const float (&inv)[2]) {
    const int lane = threadIdx.x & 63, w = threadIdx.x >> 6, fr = lane & 15, fq = lane >> 4, wq0 = w * 32;
#pragma unroll
    for (int nq = 0; nq < 2; ++nq)
#pragma unroll
        for (int md = 0; md < NMD; ++md) {
            u32x2 v; v.x = cvt_pk_bf16(o[md][nq][0] * inv[nq], o[md][nq][1] * inv[nq]); v.y = cvt_pk_bf16(o[md][nq][2] * inv[nq], o[md][nq][3] * inv[nq]);
            *(u32x2*)(Op + (size_t)(wq0 + nq * 16 + fr) * ldo + md * 16 + fq * 4) = v;
        }
}

__device__ __forceinline__ void phase_attn0(const Params& p, char* smem) {
    const bf16_t* proj0 = p.big + BE_PROJ0; const bf16_t* vt_swa = p.big + BE_VT_SWA; const bf16_t* q_mla = p.big + BE_Q_MLA;
    const bf16_t* k_mla = p.big + BE_K_MLA; const bf16_t* vt_mla = p.big + BE_VT_MLA;
    for (int it = blockIdx.x; it < 1152; it += gridDim.x) {
        int kind, b, hh, qbl; bool lat;
        if (it < 1024) { lat = true; kind = it >> 9; const int r = it & 511; b = r >> 6; hh = (r >> 3) & 7; qbl = r & 7; }
        else { lat = false; const int r = it - 1024; kind = r >> 6; b = (r >> 3) & 7; hh = r & 7; qbl = 0; }
        const int qtok0 = lat ? CTXL + 256 * qbl : 0, row0 = b * TOK + qtok0;
        f32x4 o[4][2]; float m[2], l[2], inv[2];
        if (kind == 0) {
            flash_pass<96, 64, false>(smem, q_mla + (size_t)row0 * 768 + hh * 96, 768, k_mla + (size_t)b * TOK * 768 + hh * 96, 768,
                               vt_mla + (size_t)((b * 8 + hh) * 64) * TOK, CTXL, lat ? TOK : CTXL, qtok0, 0.10206207262f * LOG2E, o, m, l);
            inv[0] = 1.f / l[0]; inv[1] = 1.f / l[1];
            store_o<4>(p.o + (size_t)row0 * 1024 + hh * 64, 1024, o, inv);
        } else {
            int s2s = CTXL, s2e = CTXL;
            if (lat) { const int lo = 256 * qbl - 128, hi = 256 * qbl + 384; s2s = CTXL + (lo > 0 ? lo : 0); s2e = CTXL + (hi < SEQ ? hi : SEQ); }
            flash_pass<64, 64, true>(smem, proj0 + (size_t)row0 * 1024 + 256 + hh * 64, 1024, proj0 + (size_t)b * TOK * 1024 + 896 + (hh >> 2) * 64, 1024,
                               vt_swa + (size_t)((b * 2 + (hh >> 2)) * 64) * TOK, s2s, s2e, qtok0, 0.125f * LOG2E, o, m, l);
            const float sk = p.sink[hh] * LOG2E;
            inv[0] = 1.f / (l[0] + fast_exp2(sk - m[0])); inv[1] = 1.f / (l[1] + fast_exp2(sk - m[1]));
            store_o<4>(p.o + (size_t)row0 * 1024 + 512 + hh * 64, 1024, o, inv);
        }
    }
}

__device__ __forceinline__ void epi_plain(const float* Ct, bf16_t* out, int ldo, int mt, int nt) {
    const int tid = threadIdx.x;
#pragma unroll 1
    for (int i = 0; i < 4; ++i) {
        const int id = tid + NTHREADS * i, r = id >> 4, c0 = (id & 15) * 8;
        float v[8]; load8(Ct + r * LDC + c0, v);
        store8(out + (size_t)(mt * 128 + r) * ldo + nt * 128 + c0, v);
    }
}
__device__ __forceinline__ void phase_gemm_plain(char* smem, const bf16_t* zero16, const bf16_t* A, int lda, const bf16_t* Wt, int K, int ntn2, bf16_t* out, int ldo, bool lat_only) {
    float* Ct = (float*)smem;
    const int nmt2 = lat_only ? 64 : 72;
    for (int it = blockIdx.x; it < nmt2 * ntn2; it += gridDim.x) {
        int mt2 = it / ntn2; const int nt2 = it % ntn2;
        if (lat_only) mt2 = (mt2 >> 3) * 9 + 1 + (mt2 & 7);
        f32x4 acc[8][4];
        gemm_core(smem, A, lda, mt2 * 256, 0, ROWS, mt2 * 256 + 128, 0, ROWS, Wt + (size_t)nt2 * 256 * K, K, K, zero16, acc);
#pragma unroll 1
        for (int ai = 0; ai < 2; ++ai) {
            acc_to_ct(Ct, acc, ai);
            epi_plain(Ct, out, ldo, mt2 * 2 + ai, nt2 * 2);
            epi_plain(Ct + CT_FLOATS, out, ldo, mt2 * 2 + ai, nt2 * 2 + 1);
        }
    }
}

__device__ __forceinline__ void phase_ln(const Params& p, const float* res_lat, const float* res_ctx, int layer, int gate_idx, const float* lng, const float* lnb,
                                         float* out_lat, float* out_ctx, bool write_h, int hl, int sh_idx, int sc_idx, bool inc_ctx) {
    const int lane = threadIdx.x & 63, w = threadIdx.x >> 6;
    for (int row = blockIdx.x * NWAVES + w; row < ROWS; row += gridDim.x * NWAVES) {
        const int b = row / TOK, j = row % TOK; const bool isc = j < CTXL;
        if (isc && !inc_ctx) continue;
        const size_t ro = isc ? ((size_t)b * CTXL + j) * DM : ((size_t)b * SEQ + (j - CTXL)) * DM;
        const float* rp = (isc ? res_ctx : res_lat) + ro; float* op = (isc ? out_ctx : out_lat) + ro;
        const int bm = isc ? 8 : b;
        const float* gate = p.mod + (size_t)(layer * 9 + bm) * 6144 + gate_idx * 1024;
        bf16_t* fp = p.h + (size_t)row * DM;
        f32x4 y[4]; float sum = 0.f;
#pragma unroll
        for (int i = 0; i < 4; ++i) {
            const int col = i * 256 + lane * 4;
            const f32x4 r = *(const f32x4*)(rp + col), gt = *(const f32x4*)(gate + col); const u32x2 f = *(const u32x2*)(fp + col);
            y[i][0] = ALPHA_RES * r[0] + gt[0] * bflo(f.x); y[i][1] = ALPHA_RES * r[1] + gt[1] * bfhi(f.x);
            y[i][2] = ALPHA_RES * r[2] + gt[2] * bflo(f.y); y[i][3] = ALPHA_RES * r[3] + gt[3] * bfhi(f.y);
            sum += (y[i][0] + y[i][1]) + (y[i][2] + y[i][3]);
        }
        const float mean = wave_sum(sum) * (1.f / DM); float sq = 0.f;
#pragma unroll
        for (int i = 0; i < 4; ++i) { y[i] = y[i] - mean; sq += (y[i][0] * y[i][0] + y[i][1] * y[i][1]) + (y[i][2] * y[i][2] + y[i][3] * y[i][3]); }
        const float rstd = rsqrtf(wave_sum(sq) * (1.f / DM) + 1e-5f);
        const float* mh = p.mod + (size_t)(hl * 9 + bm) * 6144;
#pragma unroll
        for (int i = 0; i < 4; ++i) {
            const int col = i * 256 + lane * 4;
            const f32x4 g = *(const f32x4*)(lng + col), bb = *(const f32x4*)(lnb + col);
            const f32x4 xl = y[i] * rstd * g + bb;
            *(f32x4*)(op + col) = xl;
            if (write_h) {
                const f32x4 sh = *(const f32x4*)(mh + sh_idx * 1024 + col), sc = *(const f32x4*)(mh + sc_idx * 1024 + col);
                u32x2 hv; hv.x = cvt_pk_bf16(xl[0] * (1.f + sc[0]) + sh[0], xl[1] * (1.f + sc[1]) + sh[1]); hv.y = cvt_pk_bf16(xl[2] * (1.f + sc[2]) + sh[2], xl[3] * (1.f + sc[3]) + sh[3]);
                *(u32x2*)(fp + col) = hv;
            }
        }
    }
}

struct SubTile { int alo, ahi, ar0, jm, seg_len; bool valid; };
__device__ __forceinline__ SubTile ffn_subtile(int layer, int b, int sidx) {
    SubTile t; const int cnt = layer == 0 ? 20 : 17; t.valid = sidx < cnt;
    int jm = sidx, seg_off = CTXL, seg_len = SEQ;
    if (layer == 0) { if (sidx < 3) { seg_off = 0; seg_len = CTXL; } else jm = sidx - 3; }
    t.jm = jm; t.seg_len = seg_len; t.alo = b * TOK + seg_off; t.ahi = t.valid ? t.alo + seg_len : t.alo; t.ar0 = t.alo + 126 * jm - 1;
    return t;
}
__device__ __forceinline__ void epi_ffn1(const Params& p, const float* Ct, int layer, const SubTile& t, int hc0) {
    if (!t.valid) return;
    const int tid = threadIdx.x; bf16_t* hid = p.big + BE_HID;
    const float* cw = p.conv_w + (size_t)layer * 3 * DFF; const float* cb = p.conv_b + (size_t)layer * DFF;
#pragma unroll 1
    for (int i = 0; i < 2; ++i) {
        const int id = tid + NTHREADS * i, r = id >> 3, c0 = (id & 7) * 8;
        const int srow = 126 * t.jm - 1 + r;
        if (r < 1 || r > 126 || srow >= t.seg_len) continue;
        float gm[8], g0[8], gp[8], u[8], hv[8];
        load8(Ct + (r - 1) * LDC + c0, gm); load8(Ct + r * LDC + c0, g0); load8(Ct + (r + 1) * LDC + c0, gp); load8(Ct + r * LDC + 64 + c0, u);
        const int hc = hc0 + c0;
        float w0[8], w1[8], w2[8], bs[8];
        load8(cw + hc, w0); load8(cw + DFF + hc, w1); load8(cw + 2 * DFF + hc, w2); load8(cb + hc, bs);
#pragma unroll
        for (int e = 0; e < 8; ++e) { const float cv = gm[e] * w0[e] + g0[e] * w1[e] + gp[e] * w2[e] + bs[e]; hv[e] = cv / (1.f + __expf(-cv)) * u[e]; }
        store8(hid + (size_t)(t.alo + srow) * DFF + hc, hv);
    }
}
__device__ __forceinline__ void phase_ffn1(const Params& p, char* smem, int layer) {
    float* Ct = (float*)smem;
    const bf16_t* wgu = p.wt_gate + (size_t)layer * 5632 * 1024;
    const int npb = layer == 0 ? 10 : 9;
    for (int it = blockIdx.x; it < 8 * npb * 22; it += gridDim.x) {
        int mt2, nt2; const int nfirst = 8 * npb * 16;
        if (it < nfirst) { mt2 = it >> 4; nt2 = it & 15; } else { const int r = it - nfirst; mt2 = r / 6; nt2 = 16 + r % 6; }
        const int b = mt2 / npb, J = mt2 % npb;
        const SubTile t0 = ffn_subtile(layer, b, 2 * J), t1 = ffn_subtile(layer, b, 2 * J + 1);
        f32x4 acc[8][4];
        gemm_core(smem, p.h, DM, t0.ar0, t0.alo, t0.ahi, t1.ar0, t1.alo, t1.ahi, wgu + (size_t)nt2 * 256 * DM, DM, DM, (const bf16_t*)p.bar, acc);
#pragma unroll 1
        for (int ai = 0; ai < 2; ++ai) {
            acc_to_ct(Ct, acc, ai);
            const SubTile& t = ai ? t1 : t0;
            epi_ffn1(p, Ct, layer, t, (nt2 * 2) * 64);
            epi_ffn1(p, Ct + CT_FLOATS, layer, t, (nt2 * 2 + 1) * 64);
        }
    }
}

__device__ __forceinline__ void epi_proj1(const Params& p, const float* Ct, int mt, int nt) {
    const int tid = threadIdx.x;
    bf16_t* qd = p.big + BE_QD; bf16_t* kd = p.big + BE_KD; bf16_t* vt_d = p.big + BE_VT_D;
    const float* rope64 = p.misc + MISC_ROPE64;
    const int b = mt / 18, jt = mt % 18; const bool is_ctx = jt < 2; const int row0 = mt * 128, tok0 = jt * 128;
    if (nt >= 16) {
        const int hh = nt - 16;
#pragma unroll 1
        for (int i = 0; i < 4; ++i) { const int id = tid + NTHREADS * i, c = id & 127, rc = id >> 7;
            store_col8(Ct, c, rc, vt_d + (size_t)((b * 8 + hh) * 128 + c) * TOK + tok0 + rc * 8, nullptr); }
    } else {
        bf16_t* dst = nt < 8 ? qd : kd; const int dc = (nt & 7) * 128;
#pragma unroll 1
        for (int i = 0; i < 4; ++i) {
            const int id = tid + NTHREADS * i, r = id >> 4, c0 = (id & 15) * 8;
            const float* rowp = Ct + r * LDC; float v[8]; load8(rowp + c0, v);
            if (!is_ctx) rope8(rowp, c0, 64, tok0 + r - CTXL, rope64, v);
            store8(dst + (size_t)(row0 + r) * 1024 + dc + c0, v);
        }
    }
}
__device__ __forceinline__ void phase_proj1(const Params& p, char* smem) {
    float* Ct = (float*)smem;
    for (int it = blockIdx.x; it < 72 * 12; it += gridDim.x) {
        int mt2, nt2;
        if (it < 72 * 8) { mt2 = it >> 3; nt2 = it & 7; } else { const int r = it - 72 * 8; mt2 = r >> 2; nt2 = 8 + (r & 3); }
        if ((mt2 % 9) == 0 && nt2 < 4) continue;
        f32x4 acc[8][4];
        gemm_core(smem, p.h, DM, mt2 * 256, 0, ROWS, mt2 * 256 + 128, 0, ROWS, p.wt_din + (size_t)nt2 * 256 * DM, DM, DM, (const bf16_t*)p.bar, acc);
#pragma unroll 1
        for (int ai = 0; ai < 2; ++ai) {
            acc_to_ct(Ct, acc, ai);
            epi_proj1(p, Ct, mt2 * 2 + ai, nt2 * 2);
            epi_proj1(p, Ct + CT_FLOATS, mt2 * 2 + ai, nt2 * 2 + 1);
        }
    }
}

__device__ __forceinline__ void phase_attn1(const Params& p, char* smem) {
    const bf16_t* qd = p.big + BE_QD; const bf16_t* kd = p.big + BE_KD; const bf16_t* vt_d = p.big + BE_VT_D;
    const int lane = threadIdx.x & 63, w = threadIdx.x >> 6, fr = lane & 15, fq = lane >> 4, wq0 = w * 32;
    const float lam = p.misc[MISC_LAM];
    for (int it = blockIdx.x; it < 512; it += gridDim.x) {
        const int b = it >> 6, hh = (it >> 3) & 7, qbl = it & 7; const int qtok0 = CTXL + 256 * qbl, row0 = b * TOK + qtok0;
        const bf16_t* vt = vt_d + (size_t)((b * 8 + hh) * 128) * TOK;
        f32x4 o[8][2]; float m[2], l[2];
        flash_pass<64, 128, false>(smem, qd + (size_t)row0 * 1024 + hh * 128, 1024, kd + (size_t)b * TOK * 1024 + hh * 128, 1024, vt, CTXL, TOK, qtok0, 0.125f * LOG2E, o, m, l);
        {
            float inv[2]; inv[0] = 1.f / l[0]; inv[1] = 1.f / l[1];
            store_o<8>(p.o + (size_t)row0 * 1024 + hh * 128, 1024, o, inv);
        }
        flash_pass<64, 128, false>(smem, qd + (size_t)row0 * 1024 + hh * 128 + 64, 1024, kd + (size_t)b * TOK * 1024 + hh * 128 + 64, 1024, vt, CTXL, TOK, qtok0, 0.125f * LOG2E, o, m, l);
#pragma unroll
        for (int nq = 0; nq < 2; ++nq) {
            const float inv = lam / l[nq]; float ss = 0.f;
            const bf16_t* o1p = p.o + (size_t)(row0 + wq0 + nq * 16 + fr) * 1024 + hh * 128;
#pragma unroll
            for (int md = 0; md < 8; ++md) {
                const u32x2 o1 = *(const u32x2*)(o1p + md * 16 + fq * 4);
                o[md][nq][0] = bflo(o1.x) - o[md][nq][0] * inv; o[md][nq][1] = bfhi(o1.x) - o[md][nq][1] * inv;
                o[md][nq][2] = bflo(o1.y) - o[md][nq][2] * inv; o[md][nq][3] = bfhi(o1.y) - o[md][nq][3] * inv;
                ss += (o[md][nq][0] * o[md][nq][0] + o[md][nq][1] * o[md][nq][1]) + (o[md][nq][2] * o[md][nq][2] + o[md][nq][3] * o[md][nq][3]);
            }
            ss += __shfl_xor(ss, 16); ss += __shfl_xor(ss, 32);
            const float rstd = rsqrtf(ss * (1.f / 128.f) + 1e-6f) * (1.f - LAMBDA_INIT);
            bf16_t* op = p.o + (size_t)(row0 + wq0 + nq * 16 + fr) * 1024 + hh * 128;
#pragma unroll
            for (int md = 0; md < 8; ++md) {
                const f32x4 g = *(const f32x4*)(p.subln + md * 16 + fq * 4);
                u32x2 v; v.x = cvt_pk_bf16(o[md][nq][0] * rstd * g[0], o[md][nq][1] * rstd * g[1]); v.y = cvt_pk_bf16(o[md][nq][2] * rstd * g[2], o[md][nq][3] * rstd * g[3]);
                *(u32x2*)(op + md * 16 + fq * 4) = v;
            }
        }
    }
}

constexpr int N_PHASES = 17;
#ifndef ONLY_PHASE
#define ONLY_PHASE -1
#endif
#define PH_ON(k) (ONLY_PHASE < 0 || ONLY_PHASE == (k))
#ifndef DUP_MASK
#define DUP_MASK 0
#endif
#define RUN_PHASE(k, call) if constexpr (PH_ON(k)) { if (ph_lo <= (k) && (k) < ph_hi) { _Pragma("unroll 1") for (int rep_ = 0; rep_ < 1 + ((DUP_MASK >> (k)) & 1); ++rep_) { call; } if ((k) + 1 < ph_hi) xcd_barrier(xb); } }
__global__ void __launch_bounds__(NTHREADS, 2) mega_fwd(Params p, int ph_lo, int ph_hi) {
    extern __shared__ __attribute__((aligned(16))) char smem[];
    __shared__ uint4 xb_words;
    if (threadIdx.x == 0) xb_words = make_uint4(0u, 0u, 0u, 0u);
    __syncthreads();
    const XcdBarrier xb = xcd_barrier_post(p.bar, (volatile LAS unsigned*)&xb_words);
    if (ph_lo < 0) cg::this_grid().sync();
    if (ph_hi - ph_lo > 1) { _Pragma("unroll 1") for (int i_ = 0; i_ < EXTRA_SYNCS; ++i_) xcd_barrier(xb); }
    RUN_PHASE(0, phase_prologue(p, smem))
    RUN_PHASE(1, phase_h0(p))
    RUN_PHASE(2, phase_proj0(p, smem))
    RUN_PHASE(3, phase_mla_up(p, smem))
    RUN_PHASE(4, phase_attn0(p, smem))
    RUN_PHASE(5, phase_gemm_plain(smem, (const bf16_t*)p.bar, p.o, 1024, p.wt_out0, 1024, 4, p.h, 1024, false))
    RUN_PHASE(6, phase_ln(p, p.x, p.ctx, 0, 2, p.ln1_g, p.ln1_b, p.out, p.xc, true, 0, 3, 4, true))
    RUN_PHASE(7, phase_ffn1(p, smem, 0))
    RUN_PHASE(8, phase_gemm_plain(smem, (const bf16_t*)p.bar, p.big + BE_HID, DFF, p.wt_down, DFF, 4, p.h, 1024, false))
    RUN_PHASE(9, phase_ln(p, p.out, p.xc, 0, 5, p.ln2_g, p.ln2_b, p.out, p.xc, true, 1, 0, 1, true))
    RUN_PHASE(10, phase_proj1(p, smem))
    RUN_PHASE(11, phase_attn1(p, smem))
    RUN_PHASE(12, phase_gemm_plain(smem, (const bf16_t*)p.bar, p.o, 1024, p.wt_dout, 1024, 4, p.h, 1024, true))
    RUN_PHASE(13, phase_ln(p, p.out, p.xc, 1, 2, p.ln1_g + DM, p.ln1_b + DM, p.out, p.xc, true, 1, 3, 4, false))
    RUN_PHASE(14, phase_ffn1(p, smem, 1))
    RUN_PHASE(15, phase_gemm_plain(smem, (const bf16_t*)p.bar, p.big + BE_HID, DFF, p.wt_down + (size_t)1024 * 2816, DFF, 4, p.h, 1024, true))
    RUN_PHASE(16, phase_ln(p, p.out, p.xc, 1, 5, p.ln2_g + DM, p.ln2_b + DM, p.out, p.xc, false, 1, 0, 1, false))
}

extern "C" void kernel_launch(void* const* d_in, const int* in_sizes, int n_in, void* d_out, int out_size, void* d_ws, size_t ws_size, hipStream_t stream) {
    static int grid = 0;
    if (grid == 0) {
        if (n_in != 29 || out_size != NBATCH * SEQ * DM || ws_size < WS_END) {
            fprintf(stderr, "kernel_launch: unexpected shapes (n_in %d, out %d, ws %zu, need %zu)\n", n_in, out_size, ws_size, (size_t)WS_END); grid = -1; return; }
        int dev = 0, cus = 0, per_cu = 0;
        hipGetDevice(&dev); hipDeviceGetAttribute(&cus, hipDeviceAttributeMultiprocessorCount, dev);
        if (hipFuncSetAttribute((const void*)mega_fwd, hipFuncAttributeMaxDynamicSharedMemorySize, SMEM_BYTES) != hipSuccess) { fprintf(stderr, "kernel_launch: hipFuncSetAttribute failed\n"); grid = -1; return; }
        if (hipOccupancyMaxActiveBlocksPerMultiprocessor(&per_cu, (const void*)mega_fwd, NTHREADS, SMEM_BYTES) != hipSuccess || per_cu < 1) { fprintf(stderr, "kernel_launch: occupancy query failed\n"); grid = -1; return; }
        if (per_cu > 1) per_cu = 1;
        grid = cus * per_cu;
        fprintf(stderr, "kernel_launch: grid %d (%d CUs x %d)\n", grid, cus, per_cu);
    }
    if (grid < 0) return;
    Params p{};
    const float* const* in = (const float* const*)d_in;
    p.x = in[0]; p.c = in[1]; p.ctx = in[2]; p.c_ctx = in[3]; p.w_mod = in[4]; p.b_mod = in[5]; p.ln1_g = in[6]; p.ln1_b = in[7]; p.ln2_g = in[8]; p.ln2_b = in[9];
    p.w_gate = in[10]; p.w_up = in[11]; p.conv_w = in[12]; p.conv_b = in[13]; p.w_down = in[14];
    p.ab_w_in = in[15]; p.q_norm = in[16]; p.w_qb = in[17]; p.kv_norm = in[18]; p.w_kvb = in[19]; p.sink = in[20]; p.ab_w_out = in[21];
    p.d_w_in = in[22]; p.lq1 = in[23]; p.lk1 = in[24]; p.lq2 = in[25]; p.lk2 = in[26]; p.subln = in[27]; p.d_w_out = in[28];
    p.out = (float*)d_out;
    char* ws = (char*)d_ws;
    p.wt_in0 = (bf16_t*)(ws + OFF_WT_IN0); p.wt_qb = (bf16_t*)(ws + OFF_WT_QB); p.wt_kvb = (bf16_t*)(ws + OFF_WT_KVB); p.wt_out0 = (bf16_t*)(ws + OFF_WT_OUT0);
    p.wt_din = (bf16_t*)(ws + OFF_WT_DIN); p.wt_dout = (bf16_t*)(ws + OFF_WT_DOUT); p.wt_gate = (bf16_t*)(ws + OFF_WT_GATE); p.wt_up = (bf16_t*)(ws + OFF_WT_UP);
    p.wt_down = (bf16_t*)(ws + OFF_WT_DOWN); p.mod = (float*)(ws + OFF_MOD); p.misc = (float*)(ws + OFF_MISC); p.bar = (unsigned*)(ws + OFF_BAR); p.xc = (float*)(ws + OFF_XC);
    p.h = (bf16_t*)(ws + OFF_H); p.o = (bf16_t*)(ws + OFF_O); p.big = (bf16_t*)(ws + OFF_BIG);
    if (hipMemsetAsync(ws + OFF_BAR, 0, 16384, stream) != hipSuccess) { fprintf(stderr, "kernel_launch: memset failed\n"); return; }
#if MULTI_LAUNCH
    for (int ph = 0; ph < N_PHASES; ++ph) hipLaunchKernelGGL(mega_fwd, dim3(grid), dim3(NTHREADS), SMEM_BYTES, stream, p, ph, ph + 1);
#else
    int lo = 0, hi = N_PHASES;
    void* args[] = {&p, &lo, &hi};
    hipError_t e = hipLaunchCooperativeKernel((const void*)mega_fwd, dim3(grid), dim3(NTHREADS), args, SMEM_BYTES, stream);
    if (e != hipSuccess) fprintf(stderr, "kernel_launch: cooperative launch failed: %s (grid %d)\n", hipGetErrorString(e), grid);
#if EXTRA_PHASE >= 0
    int lo2 = EXTRA_PHASE, hi2 = EXTRA_PHASE + 1;
    void* args2[] = {&p, &lo2, &hi2};
    (void)hipLaunchCooperativeKernel((const void*)mega_fwd, dim3(grid), dim3(NTHREADS), args2, SMEM_BYTES, stream);
#endif
#endif
}
```

```cpp
#include <hip/hip_runtime.h>
#include <hip/hip_cooperative_groups.h>
#include <cstdio>
#include <cstdint>
namespace cg = cooperative_groups;

#ifndef EXTRA_PHASE
#define EXTRA_PHASE -1
#endif
#ifndef EXTRA_SYNCS
#define EXTRA_SYNCS 0
#endif
#ifndef MULTI_LAUNCH
#define MULTI_LAUNCH 0
#endif

typedef unsigned short bf16_t;
typedef short bf16x8 __attribute__((ext_vector_type(8)));
typedef float f32x4 __attribute__((ext_vector_type(4)));
typedef unsigned u32x4 __attribute__((ext_vector_type(4)));
typedef unsigned u32x2 __attribute__((ext_vector_type(2)));

constexpr int NBATCH = 8, SEQ = 2048, CTXL = 256, TOK = 2304, ROWS = NBATCH * TOK, DM = 1024, DFF = 2816;
constexpr int NTHREADS = 512, NWAVES = 8;
constexpr int LDC = 132;
constexpr int CT_FLOATS = 128 * 132;
constexpr int SMEM_BYTES = 139264;
constexpr float ALPHA_RES = 1.41421356237f;
constexpr float LOG2E = 1.44269504089f;
constexpr float LAMBDA_INIT = 0.35550907f;

struct Params {
    const float *x, *c, *ctx, *c_ctx, *w_mod, *b_mod, *ln1_g, *ln1_b, *ln2_g, *ln2_b;
    const float *w_gate, *w_up, *conv_w, *conv_b, *w_down;
    const float *ab_w_in, *q_norm, *w_qb, *kv_norm, *w_kvb, *sink, *ab_w_out;
    const float *d_w_in, *lq1, *lk1, *lq2, *lk2, *subln, *d_w_out;
    float* out;
    bf16_t *wt_in0, *wt_qb, *wt_kvb, *wt_out0, *wt_din, *wt_dout, *wt_gate, *wt_up, *wt_down;
    float *mod, *misc, *xc;
    unsigned* bar;
    bf16_t *h, *o, *big;
};

constexpr size_t SZ_WT_IN0 = 1280ull * 1024 * 2, SZ_WT_QB = 768ull * 256 * 2, SZ_WT_KVB = 1024ull * 128 * 2, SZ_WT_SQ = 1024ull * 1024 * 2,
                 SZ_WT_DIN = 3072ull * 1024 * 2, SZ_WT_FF = 2ull * 2816 * 1024 * 2;
constexpr size_t OFF_WT_IN0 = 0, OFF_WT_QB = OFF_WT_IN0 + SZ_WT_IN0, OFF_WT_KVB = OFF_WT_QB + SZ_WT_QB, OFF_WT_OUT0 = OFF_WT_KVB + SZ_WT_KVB,
                 OFF_WT_DIN = OFF_WT_OUT0 + SZ_WT_SQ, OFF_WT_DOUT = OFF_WT_DIN + SZ_WT_DIN, OFF_WT_GATE = OFF_WT_DOUT + SZ_WT_SQ,
                 OFF_WT_UP = OFF_WT_GATE + SZ_WT_FF, OFF_WT_DOWN = OFF_WT_UP + SZ_WT_FF, OFF_MOD = OFF_WT_DOWN + SZ_WT_FF,
                 OFF_MISC = OFF_MOD + 2ull * 9 * 6144 * 4, OFF_BAR = OFF_MISC + 65536, OFF_XC = OFF_BAR + 16384, OFF_H = OFF_XC + 2048ull * 1024 * 4,
                 OFF_O = OFF_H + (size_t)ROWS * 1024 * 2, OFF_BIG = OFF_O + (size_t)ROWS * 1024 * 2;
constexpr size_t BE_PROJ0 = 0, BE_VT_SWA = BE_PROJ0 + (size_t)ROWS * 1024, BE_Q_MLA = BE_VT_SWA + 8ull * 2 * 64 * TOK,
                 BE_K_MLA = BE_Q_MLA + (size_t)ROWS * 768, BE_VT_MLA = BE_K_MLA + (size_t)ROWS * 768, BE_END0 = BE_VT_MLA + 8ull * 8 * 64 * TOK;
constexpr size_t BE_QD = 0, BE_KD = BE_QD + (size_t)ROWS * 1024, BE_VT_D = BE_KD + (size_t)ROWS * 1024, BE_END1 = BE_VT_D + 8ull * 8 * 128 * TOK;
constexpr size_t BE_HID = 0, BE_END2 = (size_t)ROWS * DFF;
constexpr size_t BIG_ELEMS = BE_END0 > BE_END1 ? (BE_END0 > BE_END2 ? BE_END0 : BE_END2) : (BE_END1 > BE_END2 ? BE_END1 : BE_END2);
constexpr size_t WS_END = OFF_BIG + BIG_ELEMS * 2;
constexpr int MISC_ROPE64 = 0, MISC_ROPE32 = 2048, MISC_LAM = 3072;

__device__ __forceinline__ unsigned cvt_pk_bf16(float lo, float hi) { unsigned r; asm("v_cvt_pk_bf16_f32 %0, %1, %2" : "=v"(r) : "v"(lo), "v"(hi)); return r; }
__device__ __forceinline__ float bf2f(unsigned short v) { return __uint_as_float((unsigned)v << 16); }
__device__ __forceinline__ float bflo(unsigned v) { return __uint_as_float(v << 16); }
__device__ __forceinline__ float bfhi(unsigned v) { return __uint_as_float(v & 0xffff0000u); }
__device__ __forceinline__ void store8(bf16_t* dst, const float (&v)[8]) {
    u32x4 w; w.x = cvt_pk_bf16(v[0], v[1]); w.y = cvt_pk_bf16(v[2], v[3]); w.z = cvt_pk_bf16(v[4], v[5]); w.w = cvt_pk_bf16(v[6], v[7]);
    *(u32x4*)dst = w;
}
__device__ __forceinline__ float wave_sum(float v) {
#pragma unroll
    for (int o = 1; o < 64; o <<= 1) v += __shfl_xor(v, o);
    return v;
}
__device__ __forceinline__ float fast_exp2(float x) { return __builtin_amdgcn_exp2f(x); }


#define XB_TMO      128
#define XB_XCNT(j)  (256  + 64 * (j))
#define XB_XSUB(j)  (1280 + 64 * (j))
#define XB_XGEN(j)  (2304 + 64 * (j))
#define XB_TOP      3328
#define XB_TOPGEN   3392
#define XCD_BAR_WORDS 3456
#define XB_SPIN_CAP (1u << 18)
#define LAS __attribute__((address_space(3)))
__device__ __forceinline__ unsigned xb_ld(unsigned* p)              { return __hip_atomic_load(p, __ATOMIC_RELAXED, __HIP_MEMORY_SCOPE_AGENT); }
__device__ __forceinline__ unsigned xb_add(unsigned* p, unsigned v) { return __hip_atomic_fetch_add(p, v, __ATOMIC_RELAXED, __HIP_MEMORY_SCOPE_AGENT); }
__device__ __forceinline__ unsigned xb_xcc_id() { return (unsigned)__builtin_amdgcn_s_getreg((3 << 11) | 20) & 0xFu; }
#define XB_SPIN(cond, bar) do { unsigned _sp = 0; while (cond) { __builtin_amdgcn_s_sleep(1); \
    if ((++_sp & 255u) == 0u) { if (xb_ld(&(bar)[XB_TMO])) break; if (_sp > XB_SPIN_CAP) { atomicAdd(&(bar)[XB_TMO], 1u); break; } } } } while (0)
struct XcdBarrier { unsigned* bar; unsigned x; volatile LAS unsigned* st; };
__device__ __forceinline__ XcdBarrier xcd_barrier_post(unsigned* bar, volatile LAS unsigned* st) {
    XcdBarrier b; b.bar = bar; b.x = xb_xcc_id(); b.st = st;
    if (threadIdx.x == 0) (void)xb_add(&bar[XB_XCNT(b.x)], 1u);
    return b;
}
__device__ __forceinline__ void xcd_barrier_complete(unsigned* bar, unsigned x, unsigned& nloc, unsigned& nx) {
    const unsigned G = gridDim.x * gridDim.y * gridDim.z;
    unsigned sum, cnt, mine, sp = 0u;
    for (;;) {
        sum = 0u; cnt = 0u; mine = 0u;
#pragma unroll
        for (unsigned j = 0; j < 16; ++j) { const unsigned c = xb_ld(&bar[XB_XCNT(j)]); sum += c; cnt += (c > 0u) ? 1u : 0u; mine = (j == x) ? c : mine; }
        if (sum == G) break;
        __builtin_amdgcn_s_sleep(1);
        if ((++sp & 255u) == 0u) { if (xb_ld(&bar[XB_TMO])) break; if (sp > XB_SPIN_CAP) { atomicAdd(&bar[XB_TMO], 1u); break; } }
    }
    nloc = mine > 0u ? mine : 1u; nx = cnt > 0u ? cnt : 1u;
}
__device__ __forceinline__ void xcd_barrier(const XcdBarrier& b) {
    asm volatile("s_waitcnt vmcnt(0)" ::: "memory");
    __syncthreads();
    if (threadIdx.x == 0) {
        unsigned* bar = b.bar;
        __builtin_amdgcn_s_waitcnt(0);
        unsigned nloc = b.st[0], nx = b.st[1];
        if (nloc == 0u) { xcd_barrier_complete(bar, b.x, nloc, nx); b.st[0] = nloc; b.st[1] = nx; }
        const unsigned old = xb_add(&bar[XB_XSUB(b.x)], 1u);
        const unsigned gen = old / nloc;
        if (old + 1u == (gen + 1u) * nloc) {
            __builtin_amdgcn_fence(__ATOMIC_RELEASE, "agent");
            asm volatile("s_waitcnt vmcnt(0)" ::: "memory");
            const unsigned og = xb_add(&bar[XB_TOP], 1u);
            const unsigned tg = og / nx;
            if (og + 1u == (tg + 1u) * nx) xb_add(&bar[XB_TOPGEN], 1u);
            else XB_SPIN(xb_ld(&bar[XB_TOPGEN]) == tg, bar);
            __builtin_amdgcn_fence(__ATOMIC_ACQUIRE, "agent");
            xb_add(&bar[XB_XGEN(b.x)], 1u);
            asm volatile("s_waitcnt vmcnt(0)" ::: "memory");
        } else {
            XB_SPIN(xb_ld(&bar[XB_XGEN(b.x)]) == gen, bar);
            __builtin_amdgcn_fence(__ATOMIC_ACQUIRE, "agent");
            asm volatile("s_waitcnt vmcnt(0)" ::: "memory");
        }
    }
    __syncthreads();
}

__device__ __forceinline__ void mod_item(const Params& p, char* smem, int it) {
    float* s_silu = (float*)smem;
    float* red = (float*)(smem + 9 * 1024 * 4);
    const int tid = threadIdx.x, lane = tid & 63, w = tid >> 6;
    const int layer = it / 96, col0 = (it % 96) * 64;
    for (int idx = tid; idx < 9 * 1024; idx += NTHREADS) {
        const int b = idx >> 10, k = idx & 1023;
        const float v = (b < 8) ? p.c[b * 1024 + k] : p.c_ctx[k];
        s_silu[idx] = v / (1.f + __expf(-v));
    }
    __syncthreads();
    float acc[9];
#pragma unroll
    for (int b = 0; b < 9; ++b) acc[b] = 0.f;
    const float* wp = p.w_mod + (size_t)layer * 1024 * 6144 + (size_t)(w * 128) * 6144 + col0 + lane;
    for (int kk = 0; kk < 128; kk += 8) {
        float wv[8];
#pragma unroll
        for (int u = 0; u < 8; ++u) wv[u] = wp[(size_t)(kk + u) * 6144];
#pragma unroll
        for (int b = 0; b < 9; ++b) {
            const f32x4 s0 = *(const f32x4*)(s_silu + b * 1024 + w * 128 + kk), s1 = *(const f32x4*)(s_silu + b * 1024 + w * 128 + kk + 4);
            acc[b] += s0[0] * wv[0] + s0[1] * wv[1] + s0[2] * wv[2] + s0[3] * wv[3] + s1[0] * wv[4] + s1[1] * wv[5] + s1[2] * wv[6] + s1[3] * wv[7];
        }
    }
#pragma unroll
    for (int b = 0; b < 9; ++b) red[(w * 9 + b) * 64 + lane] = acc[b];
    __syncthreads();
    for (int idx = tid; idx < 9 * 64; idx += NTHREADS) {
        const int b = idx >> 6, l = idx & 63;
        float s = 0.f;
#pragma unroll
        for (int ww = 0; ww < NWAVES; ++ww) s += red[(ww * 9 + b) * 64 + l];
        p.mod[(size_t)(layer * 9 + b) * 6144 + col0 + l] = s + p.b_mod[layer * 6144 + col0 + l];
    }
}

__device__ __forceinline__ void table_item(const Params& p) {
    const int tid = threadIdx.x;
    for (int idx = tid; idx < 64 * 16; idx += NTHREADS) {
        const int pi = idx >> 4, i = idx & 15;
        const float freq = exp2f(-(float)i * (13.28771238f / 16.f));
        const float ang = (float)pi * freq;
        p.misc[MISC_ROPE64 + idx * 2] = __cosf(ang); p.misc[MISC_ROPE64 + idx * 2 + 1] = __sinf(ang);
    }
    for (int idx = tid; idx < 64 * 8; idx += NTHREADS) {
        const int pi = idx >> 3, i = idx & 7;
        const float freq = exp2f(-(float)i * (13.28771238f / 8.f));
        const float ang = (float)pi * freq;
        p.misc[MISC_ROPE32 + idx * 2] = __cosf(ang); p.misc[MISC_ROPE32 + idx * 2 + 1] = __sinf(ang);
    }
    if (tid == 0) {
        float s1 = 0.f, s2 = 0.f;
        for (int i = 0; i < 64; ++i) { s1 += p.lq1[i] * p.lk1[i]; s2 += p.lq2[i] * p.lk2[i]; }
        p.misc[MISC_LAM] = __expf(s1) - __expf(s2) + LAMBDA_INIT;
    }
}

__device__ __forceinline__ void transpose_tile(char* smem, const float* src, int K, int Nsrc, bf16_t* dst, int ntn, int mode, const float* gain, int tile, int dmul = 1, int dadd = 0) {
    float* t = (float*)smem;
    const int tid = threadIdx.x, tx = tid & 63, ty = tid >> 6;
    const int kt = tile / ntn, nt = tile % ntn;
    const int np = nt * 64 + tx;
    int n = np;
    if (mode == 1) { n = np < 896 ? np : (np < 1024 ? 928 + (np - 896) : (np < 1152 ? 1056 + (np - 1024) : (np < 1184 ? 896 + (np - 1152) : -1))); }
    else if (mode == 2) { if (np < 512) n = (np >> 6) * 96 + (np & 63); else { const int m = np - 512; n = (m >> 5) * 96 + 64 + (m & 31); } }
#pragma unroll
    for (int i = 0; i < 8; ++i) {
        const int kl = ty + 8 * i, k = kt * 64 + kl;
        float v = 0.f;
        if (n >= 0) { v = src[(size_t)k * Nsrc + n]; if (gain) v *= gain[k]; }
        t[kl * 65 + tx] = v;
    }
    __syncthreads();
#pragma unroll
    for (int i = 0; i < 8; ++i) {
        const int nl = ty + 8 * i;
        dst[(size_t)((nt * dmul + dadd) * 64 + nl) * K + kt * 64 + tx] = (bf16_t)(cvt_pk_bf16(t[tx * 65 + nl], 0.f) & 0xffffu);
    }
}

__device__ __forceinline__ void transpose_item(const Params& p, char* smem, int r) {
    constexpr int T0 = 16 * 20, T1 = 4 * 12, T2 = 2 * 16, T3 = 16 * 16, T4 = 16 * 48, T5 = 16 * 16, TF = 16 * 44;
    if (r < T0) { transpose_tile(smem, p.ab_w_in, 1024, 1184, p.wt_in0, 20, 1, nullptr, r); return; } r -= T0;
    if (r < T1) { transpose_tile(smem, p.w_qb, 256, 768, p.wt_qb, 12, 2, p.q_norm, r); return; } r -= T1;
    if (r < T2) { transpose_tile(smem, p.w_kvb, 128, 1024, p.wt_kvb, 16, 0, p.kv_norm, r); return; } r -= T2;
    if (r < T3) { transpose_tile(smem, p.ab_w_out, 1024, 1024, p.wt_out0, 16, 0, nullptr, r); return; } r -= T3;
    if (r < T4) { transpose_tile(smem, p.d_w_in, 1024, 3072, p.wt_din, 48, 0, nullptr, r); return; } r -= T4;
    if (r < T5) { transpose_tile(smem, p.d_w_out, 1024, 1024, p.wt_dout, 16, 0, nullptr, r); return; } r -= T5;
    {
        const int j = r / TF, rr = r % TF;
        if (j < 2) transpose_tile(smem, p.w_gate + (size_t)j * 1024 * 2816, 1024, 2816, p.wt_gate + (size_t)j * 5632 * 1024, 44, 0, nullptr, rr, 2, 0);
        else if (j < 4) transpose_tile(smem, p.w_up + (size_t)(j - 2) * 1024 * 2816, 1024, 2816, p.wt_gate + (size_t)(j - 2) * 5632 * 1024, 44, 0, nullptr, rr, 2, 1);
        else transpose_tile(smem, p.w_down + (size_t)(j - 4) * 2816 * 1024, 2816, 1024, p.wt_down + (size_t)(j - 4) * 1024 * 2816, 16, 0, nullptr, rr);
    }
}
constexpr int N_TR_TILES = 16 * 20 + 4 * 12 + 2 * 16 + 16 * 16 + 16 * 48 + 16 * 16 + 6 * 16 * 44;

__device__ __forceinline__ void phase_prologue(const Params& p, char* smem) {
    const int total = 193 + N_TR_TILES;
    for (int it = blockIdx.x; it < total; it += gridDim.x) {
        if (it < 192) mod_item(p, smem, it);
        else if (it == 192) table_item(p);
        else transpose_item(p, smem, it - 193);
        __syncthreads();
    }
}

__device__ __forceinline__ void phase_h0(const Params& p) {
    const int lane = threadIdx.x & 63, w = threadIdx.x >> 6;
    for (int row = blockIdx.x * NWAVES + w; row < ROWS; row += gridDim.x * NWAVES) {
        const int b = row / TOK, j = row % TOK; const bool isc = j < CTXL;
        const float* rp = isc ? p.ctx + ((size_t)b * CTXL + j) * DM : p.x + ((size_t)b * SEQ + (j - CTXL)) * DM;
        const float* md = p.mod + (size_t)(0 * 9 + (isc ? 8 : b)) * 6144;
#pragma unroll 1
        for (int i = 0; i < 4; ++i) {
            const int col = i * 256 + lane * 4;
            const f32x4 v = *(const f32x4*)(rp + col), sh = *(const f32x4*)(md + col), sc = *(const f32x4*)(md + 1024 + col);
            u32x2 o; o.x = cvt_pk_bf16(v[0] * (1.f + sc[0]) + sh[0], v[1] * (1.f + sc[1]) + sh[1]); o.y = cvt_pk_bf16(v[2] * (1.f + sc[2]) + sh[2], v[3] * (1.f + sc[3]) + sh[3]);
            *(u32x2*)(p.h + (size_t)row * DM + col) = o;
        }
    }
}

__device__ __forceinline__ void gemm_core(char* smem, const bf16_t* __restrict__ A, int lda, int ar0a, int aloa, int ahia, int ar0b, int alob, int ahib,
                                          const bf16_t* __restrict__ B, int ldb, int K, const bf16_t* zero16, f32x4 (&acc)[8][4]) {
    constexpr int ROWB = 128, OPA = 256 * ROWB, STG = 2 * OPA, NI = 4;
    static_assert(2 * STG <= SMEM_BYTES, "LDS");
    const int tid = threadIdx.x, lane = tid & 63, w = __builtin_amdgcn_readfirstlane(tid >> 6), wr = w >> 2, wc = w & 3, fr = lane & 15, fq = lane >> 4;
    const int rl = lane >> 3, kcs = (lane & 7) ^ rl;
#pragma unroll
    for (int m = 0; m < 8; ++m)
#pragma unroll
        for (int n = 0; n < 4; ++n) acc[m][n] = (f32x4){0.f, 0.f, 0.f, 0.f};
    const int nk = K / 64;
    int aoff[NI], boff[NI];
#pragma unroll
    for (int i = 0; i < NI; ++i) {
        const int row = (w * NI + i) * 8 + rl, hf = row >> 7, gr = (hf ? ar0b : ar0a) + (row & 127);
        const bool ok = hf ? (gr >= alob && gr < ahib) : (gr >= aloa && gr < ahia);
        aoff[i] = ok ? gr * lda + kcs * 8 : -1;
        boff[i] = row * ldb + kcs * 8;
    }
    __syncthreads();
#pragma unroll
    for (int i = 0; i < NI; ++i) {
        __builtin_amdgcn_global_load_lds((const unsigned*)(aoff[i] >= 0 ? A + aoff[i] : zero16), (LAS unsigned*)(smem + (w * NI + i) * 1024), 16, 0, 0);
        __builtin_amdgcn_global_load_lds((const unsigned*)(B + boff[i]), (LAS unsigned*)(smem + OPA + (w * NI + i) * 1024), 16, 0, 0);
    }
    asm volatile("s_waitcnt vmcnt(0)" ::: "memory"); __syncthreads();
    const int sw = fr & 7;
    for (int kt = 0; kt < nk; ++kt) {
        const bool pf = kt + 1 < nk; const int nst = ((kt + 1) & 1) * STG;
        const char* base = smem + (kt & 1) * STG;
#pragma unroll
        for (int ks = 0; ks < 2; ++ks) {
            const int co = (((ks * 4 + fq) ^ sw) * 16);
            bf16x8 bfr[4];
#pragma unroll
            for (int n = 0; n < 4; ++n) bfr[n] = *(const bf16x8*)(base + OPA + (wc * 64 + n * 16 + fr) * ROWB + co);
#pragma unroll
            for (int m = 0; m < 8; ++m) {
                const bf16x8 af = *(const bf16x8*)(base + (wr * 128 + m * 16 + fr) * ROWB + co);
#pragma unroll
                for (int n = 0; n < 4; ++n) acc[m][n] = __builtin_amdgcn_mfma_f32_16x16x32_bf16(af, bfr[n], acc[m][n], 0, 0, 0);
                if (ks == 0 && pf) {
                    const int i = m & 3, lo_ = nst + (w * NI + i) * 1024;
                    if (m < 4) __builtin_amdgcn_global_load_lds((const unsigned*)(aoff[i] >= 0 ? A + aoff[i] + (kt + 1) * 64 : zero16), (LAS unsigned*)(smem + lo_), 16, 0, 0);
                    else __builtin_amdgcn_global_load_lds((const unsigned*)(B + boff[i] + (kt + 1) * 64), (LAS unsigned*)(smem + lo_ + OPA), 16, 0, 0);
                }
            }
        }
        asm volatile("s_waitcnt vmcnt(0)" ::: "memory");
        __syncthreads();
    }
}

__device__ __forceinline__ void acc_to_ct(float* Ct0, const f32x4 (&acc)[8][4], int ai) {
    const int tid = threadIdx.x, lane = tid & 63, w = tid >> 6, wr = w >> 2, wc = w & 3, fr = lane & 15, fq = lane >> 4;
    __syncthreads();
    if (wr == ai) {
        float* Ct = Ct0 + (wc >> 1) * CT_FLOATS + (wc & 1) * 64 + fr;
#pragma unroll
        for (int m = 0; m < 8; ++m)
#pragma unroll
            for (int n = 0; n < 4; ++n)
#pragma unroll
                for (int j = 0; j < 4; ++j) Ct[(m * 16 + fq * 4 + j) * LDC + n * 16] = acc[m][n][j];
    }
    __syncthreads();
}

__device__ __forceinline__ void gemm_core_h(char* smem, const bf16_t* __restrict__ A, int lda, int ar0a, int aloa, int ahia, int ar0b, int alob, int ahib,
                                            const bf16_t* __restrict__ B, int ldb, int K, const bf16_t* zero16, f32x4 (&acc)[4][4]) {
    constexpr int ROWB = 128, OPA = 256 * ROWB, STG = 2 * OPA, NI = 4, NIB = 2;
    const int tid = threadIdx.x, lane = tid & 63, w = __builtin_amdgcn_readfirstlane(tid >> 6), wr = w >> 1, wc = w & 1, fr = lane & 15, fq = lane >> 4;
    const int rl = lane >> 3, kcs = (lane & 7) ^ rl;
#pragma unroll
    for (int m = 0; m < 4; ++m)
#pragma unroll
        for (int n = 0; n < 4; ++n) acc[m][n] = (f32x4){0.f, 0.f, 0.f, 0.f};
    const int nk = K / 64;
    int aoff[NI], boff[NIB];
#pragma unroll
    for (int i = 0; i < NI; ++i) {
        const int row = (w * NI + i) * 8 + rl, hf = row >> 7, gr = (hf ? ar0b : ar0a) + (row & 127);
        const bool ok = hf ? (gr >= alob && gr < ahib) : (gr >= aloa && gr < ahia);
        aoff[i] = ok ? gr * lda + kcs * 8 : -1;
    }
#pragma unroll
    for (int i = 0; i < NIB; ++i) boff[i] = ((w * NIB + i) * 8 + rl) * ldb + kcs * 8;
    __syncthreads();
#pragma unroll
    for (int i = 0; i < NI; ++i) __builtin_amdgcn_global_load_lds((const unsigned*)(aoff[i] >= 0 ? A + aoff[i] : zero16), (LAS unsigned*)(smem + (w * NI + i) * 1024), 16, 0, 0);
#pragma unroll
    for (int i = 0; i < NIB; ++i) __builtin_amdgcn_global_load_lds((const unsigned*)(B + boff[i]), (LAS unsigned*)(smem + OPA + (w * NIB + i) * 1024), 16, 0, 0);
    asm volatile("s_waitcnt vmcnt(0)" ::: "memory"); __syncthreads();
    const int sw = fr & 7;
    for (int kt = 0; kt < nk; ++kt) {
        const bool pf = kt + 1 < nk; const int nst = ((kt + 1) & 1) * STG;
        const char* base = smem + (kt & 1) * STG;
#pragma unroll
        for (int ks = 0; ks < 2; ++ks) {
            const int co = (((ks * 4 + fq) ^ sw) * 16);
            bf16x8 bfr[4];
#pragma unroll
            for (int n = 0; n < 4; ++n) bfr[n] = *(const bf16x8*)(base + OPA + (wc * 64 + n * 16 + fr) * ROWB + co);
#pragma unroll
            for (int m = 0; m < 4; ++m) {
                const bf16x8 af = *(const bf16x8*)(base + (wr * 64 + m * 16 + fr) * ROWB + co);
#pragma unroll
                for (int n = 0; n < 4; ++n) acc[m][n] = __builtin_amdgcn_mfma_f32_16x16x32_bf16(af, bfr[n], acc[m][n], 0, 0, 0);
                if (pf) {
                    if (ks == 0) __builtin_amdgcn_global_load_lds((const unsigned*)(aoff[m] >= 0 ? A + aoff[m] + (kt + 1) * 64 : zero16), (LAS unsigned*)(smem + nst + (w * NI + m) * 1024), 16, 0, 0);
                    else if (m < NIB) __builtin_amdgcn_global_load_lds((const unsigned*)(B + boff[m & 1] + (kt + 1) * 64), (LAS unsigned*)(smem + nst + OPA + (w * NIB + (m & 1)) * 1024), 16, 0, 0);
                }
            }
        }
        asm volatile("s_waitcnt vmcnt(0)" ::: "memory");
        __syncthreads();
    }
}
__device__ __forceinline__ void acc_to_ct_h(float* Ct0, const f32x4 (&acc)[4][4], int ai) {
    const int tid = threadIdx.x, lane = tid & 63, w = tid >> 6, wr = w >> 1, wc = w & 1, fr = lane & 15, fq = lane >> 4;
    __syncthreads();
    if ((wr >> 1) == ai) {
        float* Ct = Ct0 + ((wr & 1) * 64 + fq * 4) * LDC + wc * 64 + fr;
#pragma unroll
        for (int m = 0; m < 4; ++m)
#pragma unroll
            for (int n = 0; n < 4; ++n)
#pragma unroll
                for (int j = 0; j < 4; ++j) Ct[(m * 16 + j) * LDC + n * 16] = acc[m][n][j];
    }
    __syncthreads();
}
#define TAIL_DECODE(T) const int G_ = gridDim.x, Tfull_ = ((T) / G_) * G_, total_ = Tfull_ + 2 * ((T) - Tfull_)
#define NOTAIL_DECODE(T) const int G_ = gridDim.x, Tfull_ = (T), total_ = (T)
#define TAIL_ITEM(it, tile, half) int tile, half; if ((it) < Tfull_) { tile = (it); half = -1; } else { const int r_ = (it) - Tfull_; tile = Tfull_ + (r_ >> 1); half = r_ & 1; }

__device__ __forceinline__ void load8(const float* src, float (&v)[8]) {
    const f32x4 a = *(const f32x4*)src, b = *(const f32x4*)(src + 4);
    v[0] = a[0]; v[1] = a[1]; v[2] = a[2]; v[3] = a[3]; v[4] = b[0]; v[5] = b[1]; v[6] = b[2]; v[7] = b[3];
}

__device__ __forceinline__ void rope8(const float* rowp, int c0, int hd, int pos, const float* tab, float (&v)[8]) {
    const int qs = hd >> 2, ch = c0 & (hd - 1), qd = ch / qs, i0 = ch & (qs - 1);
    const int idx = (qd < 2) ? (pos >> 6) : (pos & 63);
    const int pc = (qd & 1) ? c0 - qs : c0 + qs; const float sgn = (qd & 1) ? 1.f : -1.f;
    const float* t = tab + (idx * qs + i0) * 2;
#pragma unroll
    for (int e = 0; e < 8; ++e) v[e] = v[e] * t[2 * e] + sgn * rowp[pc + e] * t[2 * e + 1];
}

__device__ __forceinline__ void store_col8(const float* Ct, int c, int rc, bf16_t* dst, const float* rs) {
    float v[8];
#pragma unroll
    for (int e = 0; e < 8; ++e) { v[e] = Ct[(rc * 8 + e) * LDC + c]; if (rs) v[e] *= rs[rc * 8 + e]; }
    store8(dst, v);
}

__device__ __forceinline__ void epi_proj0(const Params& p, const float* Ct, int mt, int nt) {
    const int tid = threadIdx.x;
    bf16_t* proj0 = p.big + BE_PROJ0; bf16_t* vt_swa = p.big + BE_VT_SWA; bf16_t* k_mla = p.big + BE_K_MLA;
    const float* rope64 = p.misc + MISC_ROPE64; const float* rope32 = p.misc + MISC_ROPE32;
    const int b = mt / 18, jt = mt % 18; const bool is_ctx = jt < 2; const int row0 = mt * 128, tok0 = jt * 128;
    if (nt == 8) {
#pragma unroll 1
        for (int i = 0; i < 4; ++i) { const int id = tid + NTHREADS * i, c = id & 127, rc = id >> 7;
            store_col8(Ct, c, rc, vt_swa + (size_t)((b * 2 + (c >> 6)) * 64 + (c & 63)) * TOK + tok0 + rc * 8, nullptr); }
    } else {
#pragma unroll 1
        for (int i = 0; i < 4; ++i) {
            const int id = tid + NTHREADS * i, r = id >> 4, c0 = (id & 15) * 8;
            const float* rowp = Ct + r * LDC; float v[8]; load8(rowp + c0, v);
            const int grow = row0 + r, pos = tok0 + r - CTXL;
            if (nt <= 1 || nt == 6) { store8(proj0 + (size_t)grow * 1024 + nt * 128 + c0, v); }
            else if (nt <= 5 || nt == 7) { if (!is_ctx) rope8(rowp, c0, 64, pos, rope64, v); store8(proj0 + (size_t)grow * 1024 + (nt == 7 ? 896 : nt * 128) + c0, v); }
            else if (c0 < 32) { if (!is_ctx) rope8(rowp, c0, 32, pos, rope32, v);
#pragma unroll
                for (int hh = 0; hh < 8; ++hh) store8(k_mla + (size_t)grow * 768 + hh * 96 + 64 + c0, v); }
        }
    }
}
__device__ __forceinline__ void phase_proj0(const Params& p, char* smem) {
    float* Ct = (float*)smem;
    TAIL_DECODE(72 * 5);
    for (int it = blockIdx.x; it < total_; it += G_) {
        TAIL_ITEM(it, tile, half)
        const int mt2 = tile / 5, nt2 = tile % 5;
        if (half < 0) {
            f32x4 acc[8][4];
            gemm_core(smem, p.h, DM, mt2 * 256, 0, ROWS, mt2 * 256 + 128, 0, ROWS, p.wt_in0 + (size_t)nt2 * 256 * DM, DM, DM, (const bf16_t*)p.bar, acc);
#pragma unroll 1
            for (int ai = 0; ai < 2; ++ai) {
                acc_to_ct(Ct, acc, ai);
                epi_proj0(p, Ct, mt2 * 2 + ai, nt2 * 2);
                epi_proj0(p, Ct + CT_FLOATS, mt2 * 2 + ai, nt2 * 2 + 1);
            }
        } else {
            const int nt = nt2 * 2 + half;
            f32x4 acc[4][4];
            gemm_core_h(smem, p.h, DM, mt2 * 256, 0, ROWS, mt2 * 256 + 128, 0, ROWS, p.wt_in0 + (size_t)nt * 128 * DM, DM, DM, (const bf16_t*)p.bar, acc);
#pragma unroll 1
            for (int ai = 0; ai < 2; ++ai) { acc_to_ct_h(Ct, acc, ai); epi_proj0(p, Ct, mt2 * 2 + ai, nt); }
        }
    }
}

__device__ __forceinline__ void row_rstd(const bf16_t* A, int lda, int row0, int K, float* rs) {
    const int tid = threadIdx.x;
    if (tid < 256) {
        const int r = tid >> 1, hf = tid & 1; const int n = K / 2;
        const bf16_t* ap = A + (size_t)(row0 + r) * lda + hf * n; float ss = 0.f;
        for (int k = 0; k < n; k += 8) { const u32x4 v = *(const u32x4*)(ap + k);
            ss += bflo(v.x) * bflo(v.x) + bfhi(v.x) * bfhi(v.x) + bflo(v.y) * bflo(v.y) + bfhi(v.y) * bfhi(v.y) + bflo(v.z) * bflo(v.z) + bfhi(v.z) * bfhi(v.z) + bflo(v.w) * bflo(v.w) + bfhi(v.w) * bfhi(v.w); }
        ss += __shfl_xor(ss, 1);
        if (hf == 0) rs[r] = rsqrtf(ss / (float)K + 1e-6f);
    }
    __syncthreads();
}
__device__ __forceinline__ void epi_mla_q(const Params& p, const float* Ct, const float* rs, int mt, int nt) {
    const int tid = threadIdx.x; bf16_t* q_mla = p.big + BE_Q_MLA; const float* rope32 = p.misc + MISC_ROPE32;
    const int jt = mt % 18; const bool is_ctx = jt < 2; const int row0 = mt * 128, tok0 = jt * 128;
#pragma unroll 1
    for (int i = 0; i < 4; ++i) {
        const int id = tid + NTHREADS * i, r = id >> 4, c0 = (id & 15) * 8;
        const float* rowp = Ct + r * LDC; float v[8]; load8(rowp + c0, v);
        const int grow = row0 + r, pos = tok0 + r - CTXL; const float sc = rs[r];
        int dcol;
        if (nt < 4) { const int cg = nt * 128 + c0; dcol = (cg >> 6) * 96 + (cg & 63); }
        else { const int cg = (nt - 4) * 128 + c0; dcol = (cg >> 5) * 96 + 64 + (cg & 31); if (!is_ctx) rope8(rowp, c0, 32, pos, rope32, v); }
#pragma unroll
        for (int e = 0; e < 8; ++e) v[e] *= sc;
        store8(q_mla + (size_t)grow * 768 + dcol, v);
    }
}
__device__ __forceinline__ void epi_mla_kv(const Params& p, const float* Ct, const float* rs, int mt, int hh) {
    const int tid = threadIdx.x; bf16_t* k_mla = p.big + BE_K_MLA; bf16_t* vt_mla = p.big + BE_VT_MLA;
    const int b = mt / 18, jt = mt % 18; const int row0 = mt * 128, tok0 = jt * 128;
#pragma unroll 1
    for (int i = 0; i < 2; ++i) {
        const int id = tid + NTHREADS * i, r = id >> 3, c0 = (id & 7) * 8;
        float v[8]; load8(Ct + r * LDC + c0, v); const float sc = rs[r];
#pragma unroll
        for (int e = 0; e < 8; ++e) v[e] *= sc;
        store8(k_mla + (size_t)(row0 + r) * 768 + hh * 96 + c0, v);
    }
#pragma unroll 1
    for (int i = 0; i < 2; ++i) { const int id = tid + NTHREADS * i, c = 64 + (id & 63), rc = id >> 6;
        store_col8(Ct, c, rc, vt_mla + (size_t)((b * 8 + hh) * 64 + (c - 64)) * TOK + tok0 + rc * 8, rs); }
}
__device__ __forceinline__ void phase_mla_up(const Params& p, char* smem) {
    float* Ct = (float*)smem; float* rs = (float*)(smem + 2 * CT_FLOATS * 4);
    bf16_t* proj0 = p.big + BE_PROJ0;
    for (int it = blockIdx.x; it < 72 * 7; it += gridDim.x) {
        const int mt2 = it / 7, nt2 = it % 7;
        f32x4 acc[8][4];
        if (nt2 < 3) gemm_core(smem, proj0, 1024, mt2 * 256, 0, ROWS, mt2 * 256 + 128, 0, ROWS, p.wt_qb + (size_t)nt2 * 256 * 256, 256, 256, (const bf16_t*)p.bar, acc);
        else gemm_core(smem, proj0 + 768, 1024, mt2 * 256, 0, ROWS, mt2 * 256 + 128, 0, ROWS, p.wt_kvb + (size_t)(nt2 - 3) * 256 * 128, 128, 128, (const bf16_t*)p.bar, acc);
#pragma unroll 1
        for (int ai = 0; ai < 2; ++ai) {
            acc_to_ct(Ct, acc, ai);
            const int mt = mt2 * 2 + ai;
            if (nt2 < 3) { row_rstd(proj0, 1024, mt * 128, 256, rs); epi_mla_q(p, Ct, rs, mt, nt2 * 2); epi_mla_q(p, Ct + CT_FLOATS, rs, mt, nt2 * 2 + 1); }
            else { row_rstd(proj0 + 768, 1024, mt * 128, 128, rs); epi_mla_kv(p, Ct, rs, mt, (nt2 - 3) * 2); epi_mla_kv(p, Ct + CT_FLOATS, rs, mt, (nt2 - 3) * 2 + 1); }
        }
    }
}

template <int DQK, int DV, bool WINDOWED>
__device__ __forceinline__ void flash_pass(char* smem, const bf16_t* __restrict__ Qp, int ldq, const bf16_t* __restrict__ Kp, int ldk,
                                           const bf16_t* __restrict__ Vtp, int seg2s, int seg2e, int q_tok0, float sc2,
                                           f32x4 (&o)[DV / 16][2], float (&mrun)[2], float (&lrun)[2]) {
    constexpr int KROW = DQK * 2, VROW = 128, KB = 64 * KROW, VB = DV * VROW, STG = KB + VB;
    constexpr int KCPR = DQK / 8, NKI = KCPR, NVI = DV / 8, KCPT = (NKI + 7) / 8, VCPT = NVI / 8, NKS = DQK / 32, NMD = DV / 16;
    static_assert(2 * STG <= SMEM_BYTES, "LDS");
    const int tid = threadIdx.x, lane = tid & 63, w = tid >> 6, fr = lane & 15, fq = lane >> 4, wq0 = w * 32;
    bf16x8 qf[2][NKS];
#pragma unroll
    for (int nq = 0; nq < 2; ++nq)
#pragma unroll
        for (int ks = 0; ks < NKS; ++ks) qf[nq][ks] = *(const bf16x8*)(Qp + (size_t)(wq0 + nq * 16 + fr) * ldq + ks * 32 + fq * 8);
#pragma unroll
    for (int md = 0; md < NMD; ++md) { o[md][0] = (f32x4){0.f, 0.f, 0.f, 0.f}; o[md][1] = (f32x4){0.f, 0.f, 0.f, 0.f}; }
    float mref[2]; mref[0] = mref[1] = -1e30f; lrun[0] = lrun[1] = 0.f;
    const float thr = 8.0f / sc2;
    const int nt = 4 + (seg2e > seg2s ? (seg2e - seg2s) / 64 : 0);
    const int wu = __builtin_amdgcn_readfirstlane(w);
    int koffg[KCPT], voffg[VCPT];
#pragma unroll
    for (int i = 0; i < KCPT; ++i) { const int idx = (wu + 8 * i) * 64 + lane, rho = (idx / KCPR) & 63, cp = idx % KCPR;
        const int key = 32 * (rho >> 5) + 8 * ((rho >> 2) & 3) + 4 * ((rho >> 4) & 1) + (rho & 3);
        const int kcs = (DQK == 64) ? (cp ^ (rho & 7)) : ((cp & ~3) | ((cp & 3) ^ ((4 - ((rho >> 2) & 3)) & 3)));
        koffg[i] = key * ldk + kcs * 8; }
#pragma unroll
    for (int i = 0; i < VCPT; ++i) { const int idx = (wu + 8 * i) * 64 + lane, r = idx >> 3, cp = idx & 7; voffg[i] = r * TOK + ((cp ^ (r & 7)) * 8); }
    __syncthreads();
#define FDMA(t, st) do { const int key0_ = (t) < 4 ? (t) * 64 : seg2s + ((t) - 4) * 64; const bf16_t* kg_ = Kp + (size_t)key0_ * ldk; const bf16_t* vg_ = Vtp + key0_; \
        _Pragma("unroll") for (int i = 0; i < KCPT; ++i) if (wu + 8 * i < NKI) __builtin_amdgcn_global_load_lds((const unsigned*)(kg_ + koffg[i]), (LAS unsigned*)(smem + (st) * STG + (wu + 8 * i) * 1024), 16, 0, 0); \
        _Pragma("unroll") for (int i = 0; i < VCPT; ++i) __builtin_amdgcn_global_load_lds((const unsigned*)(vg_ + voffg[i]), (LAS unsigned*)(smem + (st) * STG + KB + (wu + 8 * i) * 1024), 16, 0, 0); } while (0)
    FDMA(0, 0);
    asm volatile("s_waitcnt vmcnt(0)" ::: "memory"); __syncthreads();
    const int ksw = (DQK == 64) ? (fr & 7) : ((4 - ((fr >> 2) & 3)) & 3);
    for (int t = 0; t < nt; ++t) {
        if (t + 1 < nt) FDMA(t + 1, (t + 1) & 1);
        const char* kb = smem + (t & 1) * STG; const char* vb = kb + KB;
        const int key0 = t < 4 ? t * 64 : seg2s + (t - 4) * 64;
        f32x4 s[4][2];
#pragma unroll
        for (int mk = 0; mk < 4; ++mk) { s[mk][0] = (f32x4){0.f, 0.f, 0.f, 0.f}; s[mk][1] = (f32x4){0.f, 0.f, 0.f, 0.f}; }
#pragma unroll
        for (int ks = 0; ks < NKS; ++ks) {
            const int co = (DQK == 64) ? (((ks * 4 + fq) ^ ksw) * 16) : ((ks * 4 + (fq ^ ksw)) * 16);
#pragma unroll
            for (int mk = 0; mk < 4; ++mk) {
                const bf16x8 kf = *(const bf16x8*)(kb + (mk * 16 + fr) * KROW + co);
                s[mk][0] = __builtin_amdgcn_mfma_f32_16x16x32_bf16(kf, qf[0][ks], s[mk][0], 0, 0, 0);
                s[mk][1] = __builtin_amdgcn_mfma_f32_16x16x32_bf16(kf, qf[1][ks], s[mk][1], 0, 0, 0);
            }
        }
        __builtin_amdgcn_sched_barrier(0);
        bf16x8 pf[2][2];
#pragma unroll
        for (int nq = 0; nq < 2; ++nq) {
            if (WINDOWED && key0 >= CTXL) {
                const int qpos = q_tok0 - CTXL + wq0 + nq * 16 + fr;
#pragma unroll
                for (int mk = 0; mk < 4; ++mk)
#pragma unroll
                    for (int j = 0; j < 4; ++j) { const int kpos = key0 - CTXL + 32 * (mk >> 1) + 8 * fq + 4 * (mk & 1) + j; const int d = qpos - kpos; if (d > 128 || d < -128) s[mk][nq][j] = -1e30f; }
            }
            float mx = fmaxf(fmaxf(s[0][nq][0], s[0][nq][1]), fmaxf(s[0][nq][2], s[0][nq][3]));
#pragma unroll
            for (int mk = 1; mk < 4; ++mk) mx = fmaxf(fmaxf(mx, fmaxf(s[mk][nq][0], s[mk][nq][1])), fmaxf(s[mk][nq][2], s[mk][nq][3]));
            mx = fmaxf(mx, __shfl_xor(mx, 16)); mx = fmaxf(mx, __shfl_xor(mx, 32));
            const bool need = mx > mref[nq] + thr;
            if (__any(need)) {
                const float mnew = need ? mx : mref[nq];
                const float alpha = fast_exp2((mref[nq] - mnew) * sc2);
                mref[nq] = mnew; lrun[nq] *= alpha;
#pragma unroll
                for (int md = 0; md < NMD; ++md) o[md][nq] = o[md][nq] * alpha;
            }
            const float nm = -mref[nq] * sc2;
            float ls = 0.f;
#pragma unroll
            for (int mk = 0; mk < 4; ++mk)
#pragma unroll
                for (int j = 0; j < 4; ++j) { const float pv = fast_exp2(fmaf(s[mk][nq][j], sc2, nm)); s[mk][nq][j] = pv; ls += pv; }
            lrun[nq] += ls;
#pragma unroll
            for (int kk = 0; kk < 2; ++kk) {
                u32x4 pk; pk.x = cvt_pk_bf16(s[2 * kk][nq][0], s[2 * kk][nq][1]); pk.y = cvt_pk_bf16(s[2 * kk][nq][2], s[2 * kk][nq][3]);
                pk.z = cvt_pk_bf16(s[2 * kk + 1][nq][0], s[2 * kk + 1][nq][1]); pk.w = cvt_pk_bf16(s[2 * kk + 1][nq][2], s[2 * kk + 1][nq][3]);
                pf[nq][kk] = __builtin_bit_cast(bf16x8, pk);
            }
        }
        __builtin_amdgcn_sched_barrier(0);
#pragma unroll
        for (int kk = 0; kk < 2; ++kk) {
            const int co = (((kk * 4 + fq) ^ (fr & 7)) * 16);
#pragma unroll
            for (int md = 0; md < NMD; ++md) {
                const bf16x8 vf = *(const bf16x8*)(vb + (md * 16 + fr) * VROW + co);
                o[md][0] = __builtin_amdgcn_mfma_f32_16x16x32_bf16(vf, pf[0][kk], o[md][0], 0, 0, 0);
                o[md][1] = __builtin_amdgcn_mfma_f32_16x16x32_bf16(vf, pf[1][kk], o[md][1], 0, 0, 0);
            }
        }
        asm volatile("s_waitcnt vmcnt(0)" ::: "memory");
        __syncthreads();
    }
#undef FDMA
#pragma unroll
    for (int nq = 0; nq < 2; ++nq) { float l = lrun[nq]; l += __shfl_xor(l, 16); l += __shfl_xor(l, 32); lrun[nq] = l; mrun[nq] = mref[nq] * sc2; }
}

template <int NMD>
__device__ __forceinline__ void store_o(bf16_t* Op, int ldo, const f32x4 (&o)[NMD][2], const float (&inv)[2]) {
    const int lane = threadIdx.x & 63, w = threadIdx.x >> 6, fr = lane & 15, fq = lane >> 4, wq0 = w * 32;
#pragma unroll
    for (int nq = 0; nq < 2; ++nq)
#pragma unroll
        for (int md = 0; md < NMD; ++md) {
            u32x2 v; v.x = cvt_pk_bf16(o[md][nq][0] * inv[nq], o[md][nq][1] * inv[nq]); v.y = cvt_pk_bf16(o[md][nq][2] * inv[nq], o[md][nq][3] * inv[nq]);
            *(u32x2*)(Op + (size_t)(wq0 + nq * 16 + fr) * ldo + md * 16 + fq * 4) = v;
        }
}

__device__ __forceinline__ void phase_attn0(const Params& p, char* smem) {
    const bf16_t* proj0 = p.big + BE_PROJ0; const bf16_t* vt_swa = p.big + BE_VT_SWA; const bf16_t* q_mla = p.big + BE_Q_MLA;
    const bf16_t* k_mla = p.big + BE_K_MLA; const bf16_t* vt_mla = p.big + BE_VT_MLA;
    for (int it = blockIdx.x; it < 1152; it += gridDim.x) {
        int kind, b, hh, qbl; bool lat;
        if (it < 1024) { lat = true; kind = it >> 9; const int r = it & 511; b = r >> 6; hh = (r >> 3) & 7; qbl = r & 7; }
        else { lat = false; const int r = it - 1024; kind = r >> 6; b = (r >> 3) & 7; hh = r & 7; qbl = 0; }
        const int qtok0 = lat ? CTXL + 256 * qbl : 0, row0 = b * TOK + qtok0;
        f32x4 o[4][2]; float m[2], l[2], inv[2];
        if (kind == 0) {
            flash_pass<96, 64, false>(smem, q_mla + (size_t)row0 * 768 + hh * 96, 768, k_mla + (size_t)b * TOK * 768 + hh * 96, 768,
                               vt_mla + (size_t)((b * 8 + hh) * 64) * TOK, CTXL, lat ? TOK : CTXL, qtok0, 0.10206207262f * LOG2E, o, m, l);
            inv[0] = 1.f / l[0]; inv[1] = 1.f / l[1];
            store_o<4>(p.o + (size_t)row0 * 1024 + hh * 64, 1024, o, inv);
        } else {
            int s2s = CTXL, s2e = CTXL;
            if (lat) { const int lo = 256 * qbl - 128, hi = 256 * qbl + 384; s2s = CTXL + (lo > 0 ? lo : 0); s2e = CTXL + (hi < SEQ ? hi : SEQ); }
            flash_pass<64, 64, true>(smem, proj0 + (size_t)row0 * 1024 + 256 + hh * 64, 1024, proj0 + (size_t)b * TOK * 1024 + 896 + (hh >> 2) * 64, 1024,
                               vt_swa + (size_t)((b * 2 + (hh >> 2)) * 64) * TOK, s2s, s2e, qtok0, 0.125f * LOG2E, o, m, l);
            const float sk = p.sink[hh] * LOG2E;
            inv[0] = 1.f / (l[0] + fast_exp2(sk - m[0])); inv[1] = 1.f / (l[1] + fast_exp2(sk - m[1]));
            store_o<4>(p.o + (size_t)row0 * 1024 + 512 + hh * 64, 1024, o, inv);
        }
    }
}

__device__ __forceinline__ void epi_plain(const float* Ct, bf16_t* out, int ldo, int mt, int nt) {
    const int tid = threadIdx.x;
#pragma unroll 1
    for (int i = 0; i < 4; ++i) {
        const int id = tid + NTHREADS * i, r = id >> 4, c0 = (id & 15) * 8;
        float v[8]; load8(Ct + r * LDC + c0, v);
        store8(out + (size_t)(mt * 128 + r) * ldo + nt * 128 + c0, v);
    }
}
__device__ __forceinline__ void phase_gemm_plain(char* smem, const bf16_t* zero16, const bf16_t* A, int lda, const bf16_t* Wt, int K, int ntn2, bf16_t* out, int ldo, bool lat_only) {
    float* Ct = (float*)smem;
    const int nmt2 = lat_only ? 64 : 72;
    TAIL_DECODE(nmt2 * ntn2);
    for (int it = blockIdx.x; it < total_; it += G_) {
        TAIL_ITEM(it, tile, half)
        int mt2 = tile / ntn2; const int nt2 = tile % ntn2;
        if (lat_only) mt2 = (mt2 >> 3) * 9 + 1 + (mt2 & 7);
        if (half < 0) {
            f32x4 acc[8][4];
            gemm_core(smem, A, lda, mt2 * 256, 0, ROWS, mt2 * 256 + 128, 0, ROWS, Wt + (size_t)nt2 * 256 * K, K, K, zero16, acc);
#pragma unroll 1
            for (int ai = 0; ai < 2; ++ai) {
                acc_to_ct(Ct, acc, ai);
                epi_plain(Ct, out, ldo, mt2 * 2 + ai, nt2 * 2);
                epi_plain(Ct + CT_FLOATS, out, ldo, mt2 * 2 + ai, nt2 * 2 + 1);
            }
        } else {
            const int nt = nt2 * 2 + half;
            f32x4 acc[4][4];
            gemm_core_h(smem, A, lda, mt2 * 256, 0, ROWS, mt2 * 256 + 128, 0, ROWS, Wt + (size_t)nt * 128 * K, K, K, zero16, acc);
#pragma unroll 1
            for (int ai = 0; ai < 2; ++ai) { acc_to_ct_h(Ct, acc, ai); epi_plain(Ct, out, ldo, mt2 * 2 + ai, nt); }
        }
    }
}

__device__ __forceinline__ void phase_ln(const Params& p, const float* res_lat, const float* res_ctx, int layer, int gate_idx, const float* lng, const float* lnb,
                                         float* out_lat, float* out_ctx, bool write_h, int hl, int sh_idx, int sc_idx, bool inc_ctx) {
    const int lane = threadIdx.x & 63, w = threadIdx.x >> 6;
    for (int row = blockIdx.x * NWAVES + w; row < ROWS; row += gridDim.x * NWAVES) {
        const int b = row / TOK, j = row % TOK; const bool isc = j < CTXL;
        if (isc && !inc_ctx) continue;
        const size_t ro = isc ? ((size_t)b * CTXL + j) * DM : ((size_t)b * SEQ + (j - CTXL)) * DM;
        const float* rp = (isc ? res_ctx : res_lat) + ro; float* op = (isc ? out_ctx : out_lat) + ro;
        const int bm = isc ? 8 : b;
        const float* gate = p.mod + (size_t)(layer * 9 + bm) * 6144 + gate_idx * 1024;
        bf16_t* fp = p.h + (size_t)row * DM;
        f32x4 y[4]; float sum = 0.f;
#pragma unroll
        for (int i = 0; i < 4; ++i) {
            const int col = i * 256 + lane * 4;
            const f32x4 r = *(const f32x4*)(rp + col), gt = *(const f32x4*)(gate + col); const u32x2 f = *(const u32x2*)(fp + col);
            y[i][0] = ALPHA_RES * r[0] + gt[0] * bflo(f.x); y[i][1] = ALPHA_RES * r[1] + gt[1] * bfhi(f.x);
            y[i][2] = ALPHA_RES * r[2] + gt[2] * bflo(f.y); y[i][3] = ALPHA_RES * r[3] + gt[3] * bfhi(f.y);
            sum += (y[i][0] + y[i][1]) + (y[i][2] + y[i][3]);
        }
        const float mean = wave_sum(sum) * (1.f / DM); float sq = 0.f;
#pragma unroll
        for (int i = 0; i < 4; ++i) { y[i] = y[i] - mean; sq += (y[i][0] * y[i][0] + y[i][1] * y[i][1]) + (y[i][2] * y[i][2] + y[i][3] * y[i][3]); }
        const float rstd = rsqrtf(wave_sum(sq) * (1.f / DM) + 1e-5f);
        const float* mh = p.mod + (size_t)(hl * 9 + bm) * 6144;
#pragma unroll
        for (int i = 0; i < 4; ++i) {
            const int col = i * 256 + lane * 4;
            const f32x4 g = *(const f32x4*)(lng + col), bb = *(const f32x4*)(lnb + col);
            const f32x4 xl = y[i] * rstd * g + bb;
            *(f32x4*)(op + col) = xl;
            if (write_h) {
                const f32x4 sh = *(const f32x4*)(mh + sh_idx * 1024 + col), sc = *(const f32x4*)(mh + sc_idx * 1024 + col);
                u32x2 hv; hv.x = cvt_pk_bf16(xl[0] * (1.f + sc[0]) + sh[0], xl[1] * (1.f + sc[1]) + sh[1]); hv.y = cvt_pk_bf16(xl[2] * (1.f + sc[2]) + sh[2], xl[3] * (1.f + sc[3]) + sh[3]);
                *(u32x2*)(fp + col) = hv;
            }
        }
    }
}

struct SubTile { int alo, ahi, ar0, jm, seg_len; bool valid; };
__device__ __forceinline__ SubTile ffn_subtile(int layer, int b, int sidx) {
    SubTile t; const int cnt = layer == 0 ? 20 : 17; t.valid = sidx < cnt;
    int jm = sidx, seg_off = CTXL, seg_len = SEQ;
    if (layer == 0) { if (sidx < 3) { seg_off = 0; seg_len = CTXL; } else jm = sidx - 3; }
    t.jm = jm; t.seg_len = seg_len; t.alo = b * TOK + seg_off; t.ahi = t.valid ? t.alo + seg_len : t.alo; t.ar0 = t.alo + 126 * jm - 1;
    return t;
}
__device__ __forceinline__ SubTile sel_subtile(const SubTile& a, const SubTile& b, int ai) {
    SubTile t; t.alo = ai ? b.alo : a.alo; t.ahi = ai ? b.ahi : a.ahi; t.ar0 = ai ? b.ar0 : a.ar0; t.jm = ai ? b.jm : a.jm; t.seg_len = ai ? b.seg_len : a.seg_len; t.valid = ai ? b.valid : a.valid; return t;
}
__device__ __forceinline__ void epi_ffn1(const Params& p, const float* Ct, int layer, const SubTile& t, int hc0) {
    if (!t.valid) return;
    const int tid = threadIdx.x; bf16_t* hid = p.big + BE_HID;
    const float* cw = p.conv_w + (size_t)layer * 3 * DFF; const float* cb = p.conv_b + (size_t)layer * DFF;
#pragma unroll 1
    for (int i = 0; i < 2; ++i) {
        const int id = tid + NTHREADS * i, r = id >> 3, c0 = (id & 7) * 8;
        const int srow = 126 * t.jm - 1 + r;
        if (r < 1 || r > 126 || srow >= t.seg_len) continue;
        float gm[8], g0[8], gp[8], u[8], hv[8];
        load8(Ct + (r - 1) * LDC + c0, gm); load8(Ct + r * LDC + c0, g0); load8(Ct + (r + 1) * LDC + c0, gp); load8(Ct + r * LDC + 64 + c0, u);
        const int hc = hc0 + c0;
        float w0[8], w1[8], w2[8], bs[8];
        load8(cw + hc, w0); load8(cw + DFF + hc, w1); load8(cw + 2 * DFF + hc, w2); load8(cb + hc, bs);
#pragma unroll
        for (int e = 0; e < 8; ++e) { const float cv = gm[e] * w0[e] + g0[e] * w1[e] + gp[e] * w2[e] + bs[e]; hv[e] = cv / (1.f + __expf(-cv)) * u[e]; }
        store8(hid + (size_t)(t.alo + srow) * DFF + hc, hv);
    }
}
__device__ __forceinline__ void phase_ffn1(const Params& p, char* smem, int layer) {
    float* Ct = (float*)smem;
    const bf16_t* wgu = p.wt_gate + (size_t)layer * 5632 * 1024;
    const int npb = layer == 0 ? 10 : 9;
    NOTAIL_DECODE(8 * npb * 22);
    for (int it0 = blockIdx.x; it0 < total_; it0 += G_) {
        TAIL_ITEM(it0, it, half)
        int mt2, nt2; const int nfirst = 8 * npb * 16;
        if (it < nfirst) { mt2 = it >> 4; nt2 = it & 15; } else { const int r = it - nfirst; mt2 = r / 6; nt2 = 16 + r % 6; }
        const int b = mt2 / npb, J = mt2 % npb;
        const SubTile t0 = ffn_subtile(layer, b, 2 * J), t1 = ffn_subtile(layer, b, 2 * J + 1);
        if (half < 0) {
            f32x4 acc[8][4];
            gemm_core(smem, p.h, DM, t0.ar0, t0.alo, t0.ahi, t1.ar0, t1.alo, t1.ahi, wgu + (size_t)nt2 * 256 * DM, DM, DM, (const bf16_t*)p.bar, acc);
#pragma unroll 1
            for (int ai = 0; ai < 2; ++ai) {
                acc_to_ct(Ct, acc, ai);
                const SubTile t = sel_subtile(t0, t1, ai);
                epi_ffn1(p, Ct, layer, t, (nt2 * 2) * 64);
                epi_ffn1(p, Ct + CT_FLOATS, layer, t, (nt2 * 2 + 1) * 64);
            }
        } else {
            const int nt = nt2 * 2 + half;
            f32x4 acc[4][4];
            gemm_core_h(smem, p.h, DM, t0.ar0, t0.alo, t0.ahi, t1.ar0, t1.alo, t1.ahi, wgu + (size_t)nt * 128 * DM, DM, DM, (const bf16_t*)p.bar, acc);
#pragma unroll 1
            for (int ai = 0; ai < 2; ++ai) { acc_to_ct_h(Ct, acc, ai); epi_ffn1(p, Ct, layer, sel_subtile(t0, t1, ai), nt * 64); }
        }
    }
}

__device__ __forceinline__ void epi_proj1(const Params& p, const float* Ct, int mt, int nt) {
    const int tid = threadIdx.x;
    bf16_t* qd = p.big + BE_QD; bf16_t* kd = p.big + BE_KD; bf16_t* vt_d = p.big + BE_VT_D;
    const float* rope64 = p.misc + MISC_ROPE64;
    const int b = mt / 18, jt = mt % 18; const bool is_ctx = jt < 2; const int row0 = mt * 128, tok0 = jt * 128;
    if (nt >= 16) {
        const int hh = nt - 16;
#pragma unroll 1
        for (int i = 0; i < 4; ++i) { const int id = tid + NTHREADS * i, c = id & 127, rc = id >> 7;
            store_col8(Ct, c, rc, vt_d + (size_t)((b * 8 + hh) * 128 + c) * TOK + tok0 + rc * 8, nullptr); }
    } else {
        bf16_t* dst = nt < 8 ? qd : kd; const int dc = (nt & 7) * 128;
#pragma unroll 1
        for (int i = 0; i < 4; ++i) {
            const int id = tid + NTHREADS * i, r = id >> 4, c0 = (id & 15) * 8;
            const float* rowp = Ct + r * LDC; float v[8]; load8(rowp + c0, v);
            if (!is_ctx) rope8(rowp, c0, 64, tok0 + r - CTXL, rope64, v);
            store8(dst + (size_t)(row0 + r) * 1024 + dc + c0, v);
        }
    }
}
__device__ __forceinline__ void phase_proj1(const Params& p, char* smem) {
    float* Ct = (float*)smem;
    TAIL_DECODE(72 * 12);
    for (int it0 = blockIdx.x; it0 < total_; it0 += G_) {
        TAIL_ITEM(it0, it, half)
        int mt2, nt2;
        if (it < 72 * 8) { mt2 = it >> 3; nt2 = it & 7; } else { const int r = it - 72 * 8; mt2 = r >> 2; nt2 = 8 + (r & 3); }
        if ((mt2 % 9) == 0 && nt2 < 4) continue;
        if (half < 0) {
            f32x4 acc[8][4];
            gemm_core(smem, p.h, DM, mt2 * 256, 0, ROWS, mt2 * 256 + 128, 0, ROWS, p.wt_din + (size_t)nt2 * 256 * DM, DM, DM, (const bf16_t*)p.bar, acc);
#pragma unroll 1
            for (int ai = 0; ai < 2; ++ai) {
                acc_to_ct(Ct, acc, ai);
                epi_proj1(p, Ct, mt2 * 2 + ai, nt2 * 2);
                epi_proj1(p, Ct + CT_FLOATS, mt2 * 2 + ai, nt2 * 2 + 1);
            }
        } else {
            const int nt = nt2 * 2 + half;
            f32x4 acc[4][4];
            gemm_core_h(smem, p.h, DM, mt2 * 256, 0, ROWS, mt2 * 256 + 128, 0, ROWS, p.wt_din + (size_t)nt * 128 * DM, DM, DM, (const bf16_t*)p.bar, acc);
#pragma unroll 1
            for (int ai = 0; ai < 2; ++ai) { acc_to_ct_h(Ct, acc, ai); epi_proj1(p, Ct, mt2 * 2 + ai, nt); }
        }
    }
}

__device__ __forceinline__ void phase_attn1(const Params& p, char* smem) {
    const bf16_t* qd = p.big + BE_QD; const bf16_t* kd = p.big + BE_KD; const bf16_t* vt_d = p.big + BE_VT_D;
    const int lane = threadIdx.x & 63, w = threadIdx.x >> 6, fr = lane & 15, fq = lane >> 4, wq0 = w * 32;
    const float lam = p.misc[MISC_LAM];
    for (int it = blockIdx.x; it < 512; it += gridDim.x) {
        const int b = it >> 6, hh = (it >> 3) & 7, qbl = it & 7; const int qtok0 = CTXL + 256 * qbl, row0 = b * TOK + qtok0;
        const bf16_t* vt = vt_d + (size_t)((b * 8 + hh) * 128) * TOK;
        f32x4 o[8][2]; float m[2], l[2];
        flash_pass<64, 128, false>(smem, qd + (size_t)row0 * 1024 + hh * 128, 1024, kd + (size_t)b * TOK * 1024 + hh * 128, 1024, vt, CTXL, TOK, qtok0, 0.125f * LOG2E, o, m, l);
        {
            float inv[2]; inv[0] = 1.f / l[0]; inv[1] = 1.f / l[1];
            store_o<8>(p.o + (size_t)row0 * 1024 + hh * 128, 1024, o, inv);
        }
        flash_pass<64, 128, false>(smem, qd + (size_t)row0 * 1024 + hh * 128 + 64, 1024, kd + (size_t)b * TOK * 1024 + hh * 128 + 64, 1024, vt, CTXL, TOK, qtok0, 0.125f * LOG2E, o, m, l);
#pragma unroll
        for (int nq = 0; nq < 2; ++nq) {
            const float inv = lam / l[nq]; float ss = 0.f;
            const bf16_t* o1p = p.o + (size_t)(row0 + wq0 + nq * 16 + fr) * 1024 + hh * 128;
#pragma unroll
            for (int md = 0; md < 8; ++md) {
                const u32x2 o1 = *(const u32x2*)(o1p + md * 16 + fq * 4);
                o[md][nq][0] = bflo(o1.x) - o[md][nq][0] * inv; o[md][nq][1] = bfhi(o1.x) - o[md][nq][1] * inv;
                o[md][nq][2] = bflo(o1.y) - o[md][nq][2] * inv; o[md][nq][3] = bfhi(o1.y) - o[md][nq][3] * inv;
                ss += (o[md][nq][0] * o[md][nq][0] + o[md][nq][1] * o[md][nq][1]) + (o[md][nq][2] * o[md][nq][2] + o[md][nq][3] * o[md][nq][3]);
            }
            ss += __shfl_xor(ss, 16); ss += __shfl_xor(ss, 32);
            const float rstd = rsqrtf(ss * (1.f / 128.f) + 1e-6f) * (1.f - LAMBDA_INIT);
            bf16_t* op = p.o + (size_t)(row0 + wq0 + nq * 16 + fr) * 1024 + hh * 128;
#pragma unroll
            for (int md = 0; md < 8; ++md) {
                const f32x4 g = *(const f32x4*)(p.subln + md * 16 + fq * 4);
                u32x2 v; v.x = cvt_pk_bf16(o[md][nq][0] * rstd * g[0], o[md][nq][1] * rstd * g[1]); v.y = cvt_pk_bf16(o[md][nq][2] * rstd * g[2], o[md][nq][3] * rstd * g[3]);
                *(u32x2*)(op + md * 16 + fq * 4) = v;
            }
        }
    }
}

constexpr int N_PHASES = 17;
#ifndef ONLY_PHASE
#define ONLY_PHASE -1
#endif
#define PH_ON(k) (ONLY_PHASE < 0 || ONLY_PHASE == (k))
#ifndef DUP_MASK
#define DUP_MASK 0
#endif
#define RUN_PHASE(k, call) if constexpr (PH_ON(k)) { if (ph_lo <= (k) && (k) < ph_hi) { call; if ((k) + 1 < ph_hi) xcd_barrier(xb); } }
__global__ void __launch_bounds__(NTHREADS, 2) mega_fwd(Params p, int ph_lo, int ph_hi) {
    extern __shared__ __attribute__((aligned(16))) char smem[];
    __shared__ uint4 xb_words;
    if (threadIdx.x == 0) xb_words = make_uint4(0u, 0u, 0u, 0u);
    __syncthreads();
    const XcdBarrier xb = xcd_barrier_post(p.bar, (volatile LAS unsigned*)&xb_words);
    if (ph_lo < 0) cg::this_grid().sync();
    RUN_PHASE(0, phase_prologue(p, smem))
    RUN_PHASE(1, phase_h0(p))
    RUN_PHASE(2, phase_proj0(p, smem))
    RUN_PHASE(3, phase_mla_up(p, smem))
    RUN_PHASE(4, phase_attn0(p, smem))
    RUN_PHASE(5, phase_gemm_plain(smem, (const bf16_t*)p.bar, p.o, 1024, p.wt_out0, 1024, 4, p.h, 1024, false))
    RUN_PHASE(6, phase_ln(p, p.x, p.ctx, 0, 2, p.ln1_g, p.ln1_b, p.out, p.xc, true, 0, 3, 4, true))
    RUN_PHASE(7, phase_ffn1(p, smem, 0))
    RUN_PHASE(8, phase_gemm_plain(smem, (const bf16_t*)p.bar, p.big + BE_HID, DFF, p.wt_down, DFF, 4, p.h, 1024, false))
    RUN_PHASE(9, phase_ln(p, p.out, p.xc, 0, 5, p.ln2_g, p.ln2_b, p.out, p.xc, true, 1, 0, 1, true))
    RUN_PHASE(10, phase_proj1(p, smem))
    RUN_PHASE(11, phase_attn1(p, smem))
    RUN_PHASE(12, phase_gemm_plain(smem, (const bf16_t*)p.bar, p.o, 1024, p.wt_dout, 1024, 4, p.h, 1024, true))
    RUN_PHASE(13, phase_ln(p, p.out, p.xc, 1, 2, p.ln1_g + DM, p.ln1_b + DM, p.out, p.xc, true, 1, 3, 4, false))
    RUN_PHASE(14, phase_ffn1(p, smem, 1))
    RUN_PHASE(15, phase_gemm_plain(smem, (const bf16_t*)p.bar, p.big + BE_HID, DFF, p.wt_down + (size_t)1024 * 2816, DFF, 4, p.h, 1024, true))
    RUN_PHASE(16, phase_ln(p, p.out, p.xc, 1, 5, p.ln2_g + DM, p.ln2_b + DM, p.out, p.xc, false, 1, 0, 1, false))
}

extern "C" void kernel_launch(void* const* d_in, const int* in_sizes, int n_in, void* d_out, int out_size, void* d_ws, size_t ws_size, hipStream_t stream) {
    static int grid = 0;
    if (grid == 0) {
        if (n_in != 29 || out_size != NBATCH * SEQ * DM || ws_size < WS_END) {
            fprintf(stderr, "kernel_launch: unexpected shapes (n_in %d, out %d, ws %zu, need %zu)\n", n_in, out_size, ws_size, (size_t)WS_END); grid = -1; return; }
        int dev = 0, cus = 0, per_cu = 0;
        hipGetDevice(&dev); hipDeviceGetAttribute(&cus, hipDeviceAttributeMultiprocessorCount, dev);
        if (hipFuncSetAttribute((const void*)mega_fwd, hipFuncAttributeMaxDynamicSharedMemorySize, SMEM_BYTES) != hipSuccess) { fprintf(stderr, "kernel_launch: hipFuncSetAttribute failed\n"); grid = -1; return; }
        if (hipOccupancyMaxActiveBlocksPerMultiprocessor(&per_cu, (const void*)mega_fwd, NTHREADS, SMEM_BYTES) != hipSuccess || per_cu < 1) { fprintf(stderr, "kernel_launch: occupancy query failed\n"); grid = -1; return; }
        if (per_cu > 1) per_cu = 1;
        grid = cus * per_cu;
        fprintf(stderr, "kernel_launch: grid %d (%d CUs x %d)\n", grid, cus, per_cu);
    }
    if (grid < 0) return;
    Params p{};
    const float* const* in = (const float* const*)d_in;
    p.x = in[0]; p.c = in[1]; p.ctx = in[2]; p.c_ctx = in[3]; p.w_mod = in[4]; p.b_mod = in[5]; p.ln1_g = in[6]; p.ln1_b = in[7]; p.ln2_g = in[8]; p.ln2_b = in[9];
    p.w_gate = in[10]; p.w_up = in[11]; p.conv_w = in[12]; p.conv_b = in[13]; p.w_down = in[14];
    p.ab_w_in = in[15]; p.q_norm = in[16]; p.w_qb = in[17]; p.kv_norm = in[18]; p.w_kvb = in[19]; p.sink = in[20]; p.ab_w_out = in[21];
    p.d_w_in = in[22]; p.lq1 = in[23]; p.lk1 = in[24]; p.lq2 = in[25]; p.lk2 = in[26]; p.subln = in[27]; p.d_w_out = in[28];
    p.out = (float*)d_out;
    char* ws = (char*)d_ws;
    p.wt_in0 = (bf16_t*)(ws + OFF_WT_IN0); p.wt_qb = (bf16_t*)(ws + OFF_WT_QB); p.wt_kvb = (bf16_t*)(ws + OFF_WT_KVB); p.wt_out0 = (bf16_t*)(ws + OFF_WT_OUT0);
    p.wt_din = (bf16_t*)(ws + OFF_WT_DIN); p.wt_dout = (bf16_t*)(ws + OFF_WT_DOUT); p.wt_gate = (bf16_t*)(ws + OFF_WT_GATE); p.wt_up = (bf16_t*)(ws + OFF_WT_UP);
    p.wt_down = (bf16_t*)(ws + OFF_WT_DOWN); p.mod = (float*)(ws + OFF_MOD); p.misc = (float*)(ws + OFF_MISC); p.bar = (unsigned*)(ws + OFF_BAR); p.xc = (float*)(ws + OFF_XC);
    p.h = (bf16_t*)(ws + OFF_H); p.o = (bf16_t*)(ws + OFF_O); p.big = (bf16_t*)(ws + OFF_BIG);
    if (hipMemsetAsync(ws + OFF_BAR, 0, 16384, stream) != hipSuccess) { fprintf(stderr, "kernel_launch: memset failed\n"); return; }
#if MULTI_LAUNCH
    for (int ph = 0; ph < N_PHASES; ++ph) hipLaunchKernelGGL(mega_fwd, dim3(grid), dim3(NTHREADS), SMEM_BYTES, stream, p, ph, ph + 1);
#else
    int lo = 0, hi = N_PHASES;
    void* args[] = {&p, &lo, &hi};
    hipError_t e = hipLaunchCooperativeKernel((const void*)mega_fwd, dim3(grid), dim3(NTHREADS), args, SMEM_BYTES, stream);
    if (e != hipSuccess) fprintf(stderr, "kernel_launch: cooperative launch failed: %s (grid %d)\n", hipGetErrorString(e), grid);
#if EXTRA_PHASE >= 0
    int lo2 = EXTRA_PHASE, hi2 = EXTRA_PHASE + 1;
    void* args2[] = {&p, &lo2, &hi2};
    (void)hipLaunchCooperativeKernel((const void*)mega_fwd, dim3(grid), dim3(NTHREADS), args2, SMEM_BYTES, stream);
#endif
#endif
}
```

```cpp
#include <hip/hip_runtime.h>
#include <hip/hip_cooperative_groups.h>
#include <cstdio>
#include <cstdint>
namespace cg = cooperative_groups;

#ifndef EXTRA_PHASE
#define EXTRA_PHASE -1
#endif
#ifndef EXTRA_SYNCS
#define EXTRA_SYNCS 0
#endif
#ifndef MULTI_LAUNCH
#define MULTI_LAUNCH 0
#endif

typedef unsigned short bf16_t;
typedef short bf16x8 __attribute__((ext_vector_type(8)));
typedef float f32x4 __attribute__((ext_vector_type(4)));
typedef unsigned u32x4 __attribute__((ext_vector_type(4)));
typedef unsigned u32x2 __attribute__((ext_vector_type(2)));

constexpr int NBATCH = 8, SEQ = 2048, CTXL = 256, TOK = 2304, ROWS = NBATCH * TOK, DM = 1024, DFF = 2816;
constexpr int NTHREADS = 512, NWAVES = 8;
constexpr int LDC = 132;
constexpr int CT_FLOATS = 128 * 132;
constexpr int SMEM_TABLES = 12288;
constexpr int SMEM_BYTES = 139264;
constexpr float ALPHA_RES = 1.41421356237f;
constexpr float LOG2E = 1.44269504089f;
constexpr float LAMBDA_INIT = 0.35550907f;

struct Params {
    const float *x, *c, *ctx, *c_ctx, *w_mod, *b_mod, *ln1_g, *ln1_b, *ln2_g, *ln2_b;
    const float *w_gate, *w_up, *conv_w, *conv_b, *w_down;
    const float *ab_w_in, *q_norm, *w_qb, *kv_norm, *w_kvb, *sink, *ab_w_out;
    const float *d_w_in, *lq1, *lk1, *lq2, *lk2, *subln, *d_w_out;
    float* out;
    bf16_t *wt_in0, *wt_qb, *wt_kvb, *wt_out0, *wt_din, *wt_dout, *wt_gate, *wt_up, *wt_down;
    float *mod, *misc, *xc;
    unsigned* bar;
    bf16_t *h, *o, *big;
};

constexpr size_t SZ_WT_IN0 = 1280ull * 1024 * 2, SZ_WT_QB = 768ull * 256 * 2, SZ_WT_KVB = 1024ull * 128 * 2, SZ_WT_SQ = 1024ull * 1024 * 2,
                 SZ_WT_DIN = 3072ull * 1024 * 2, SZ_WT_FF = 2ull * 2816 * 1024 * 2;
constexpr size_t OFF_WT_IN0 = 0, OFF_WT_QB = OFF_WT_IN0 + SZ_WT_IN0, OFF_WT_KVB = OFF_WT_QB + SZ_WT_QB, OFF_WT_OUT0 = OFF_WT_KVB + SZ_WT_KVB,
                 OFF_WT_DIN = OFF_WT_OUT0 + SZ_WT_SQ, OFF_WT_DOUT = OFF_WT_DIN + SZ_WT_DIN, OFF_WT_GATE = OFF_WT_DOUT + SZ_WT_SQ,
                 OFF_WT_UP = OFF_WT_GATE + SZ_WT_FF, OFF_WT_DOWN = OFF_WT_UP + SZ_WT_FF, OFF_MOD = OFF_WT_DOWN + SZ_WT_FF,
                 OFF_MISC = OFF_MOD + 2ull * 9 * 6144 * 4, OFF_BAR = OFF_MISC + 65536, OFF_XC = OFF_BAR + 16384, OFF_H = OFF_XC + 2048ull * 1024 * 4,
                 OFF_O = OFF_H + (size_t)ROWS * 1024 * 2, OFF_BIG = OFF_O + (size_t)ROWS * 1024 * 2;
constexpr size_t BE_PROJ0 = 0, BE_VT_SWA = BE_PROJ0 + (size_t)ROWS * 1024, BE_Q_MLA = BE_VT_SWA + 8ull * 2 * 64 * TOK,
                 BE_K_MLA = BE_Q_MLA + (size_t)ROWS * 768, BE_VT_MLA = BE_K_MLA + (size_t)ROWS * 768, BE_END0 = BE_VT_MLA + 8ull * 8 * 64 * TOK;
constexpr size_t BE_QD = 0, BE_KD = BE_QD + (size_t)ROWS * 1024, BE_VT_D = BE_KD + (size_t)ROWS * 1024, BE_END1 = BE_VT_D + 8ull * 8 * 128 * TOK;
constexpr size_t BE_HID = 0, BE_END2 = (size_t)ROWS * DFF;
constexpr size_t BIG_ELEMS = BE_END0 > BE_END1 ? (BE_END0 > BE_END2 ? BE_END0 : BE_END2) : (BE_END1 > BE_END2 ? BE_END1 : BE_END2);
constexpr size_t WS_END = OFF_BIG + BIG_ELEMS * 2;
constexpr int MISC_ROPE64 = 0, MISC_ROPE32 = 2048, MISC_LAM = 3072;

__device__ __forceinline__ unsigned cvt_pk_bf16(float lo, float hi) { unsigned r; asm("v_cvt_pk_bf16_f32 %0, %1, %2" : "=v"(r) : "v"(lo), "v"(hi)); return r; }
__device__ __forceinline__ float bf2f(unsigned short v) { return __uint_as_float((unsigned)v << 16); }
__device__ __forceinline__ float bflo(unsigned v) { return __uint_as_float(v << 16); }
__device__ __forceinline__ float bfhi(unsigned v) { return __uint_as_float(v & 0xffff0000u); }
__device__ __forceinline__ void store8(bf16_t* dst, const float (&v)[8]) {
    u32x4 w; w.x = cvt_pk_bf16(v[0], v[1]); w.y = cvt_pk_bf16(v[2], v[3]); w.z = cvt_pk_bf16(v[4], v[5]); w.w = cvt_pk_bf16(v[6], v[7]);
    *(u32x4*)dst = w;
}
__device__ __forceinline__ float wave_sum(float v) {
#pragma unroll
    for (int o = 1; o < 64; o <<= 1) v += __shfl_xor(v, o);
    return v;
}
__device__ __forceinline__ float fast_exp2(float x) { return __builtin_amdgcn_exp2f(x); }


#define XB_TMO      128
#define XB_XCNT(j)  (256  + 64 * (j))
#define XB_XSUB(j)  (1280 + 64 * (j))
#define XB_XGEN(j)  (2304 + 64 * (j))
#define XB_TOP      3328
#define XB_TOPGEN   3392
#define XCD_BAR_WORDS 3456
#define XB_SPIN_CAP (1u << 18)
#define LAS __attribute__((address_space(3)))
__device__ __forceinline__ unsigned xb_ld(unsigned* p)              { return __hip_atomic_load(p, __ATOMIC_RELAXED, __HIP_MEMORY_SCOPE_AGENT); }
__device__ __forceinline__ unsigned xb_add(unsigned* p, unsigned v) { return __hip_atomic_fetch_add(p, v, __ATOMIC_RELAXED, __HIP_MEMORY_SCOPE_AGENT); }
__device__ __forceinline__ unsigned xb_xcc_id() { return (unsigned)__builtin_amdgcn_s_getreg((3 << 11) | 20) & 0xFu; }
#define XB_SPIN(cond, bar) do { unsigned _sp = 0; while (cond) { __builtin_amdgcn_s_sleep(1); \
    if ((++_sp & 255u) == 0u) { if (xb_ld(&(bar)[XB_TMO])) break; if (_sp > XB_SPIN_CAP) { atomicAdd(&(bar)[XB_TMO], 1u); break; } } } } while (0)
struct XcdBarrier { unsigned* bar; unsigned x; volatile LAS unsigned* st; };
__device__ __forceinline__ XcdBarrier xcd_barrier_post(unsigned* bar, volatile LAS unsigned* st) {
    XcdBarrier b; b.bar = bar; b.x = xb_xcc_id(); b.st = st;
    if (threadIdx.x == 0) (void)xb_add(&bar[XB_XCNT(b.x)], 1u);
    return b;
}
__device__ __forceinline__ void xcd_barrier_complete(unsigned* bar, unsigned x, unsigned& nloc, unsigned& nx) {
    const unsigned G = gridDim.x * gridDim.y * gridDim.z;
    unsigned sum, cnt, mine, sp = 0u;
    for (;;) {
        sum = 0u; cnt = 0u; mine = 0u;
#pragma unroll
        for (unsigned j = 0; j < 16; ++j) { const unsigned c = xb_ld(&bar[XB_XCNT(j)]); sum += c; cnt += (c > 0u) ? 1u : 0u; mine = (j == x) ? c : mine; }
        if (sum == G) break;
        __builtin_amdgcn_s_sleep(1);
        if ((++sp & 255u) == 0u) { if (xb_ld(&bar[XB_TMO])) break; if (sp > XB_SPIN_CAP) { atomicAdd(&bar[XB_TMO], 1u); break; } }
    }
    nloc = mine > 0u ? mine : 1u; nx = cnt > 0u ? cnt : 1u;
}
__device__ __forceinline__ void xcd_barrier(const XcdBarrier& b) {
    asm volatile("s_waitcnt vmcnt(0)" ::: "memory");
    __syncthreads();
    if (threadIdx.x == 0) {
        unsigned* bar = b.bar;
        __builtin_amdgcn_s_waitcnt(0);
        unsigned nloc = b.st[0], nx = b.st[1];
        if (nloc == 0u) { xcd_barrier_complete(bar, b.x, nloc, nx); b.st[0] = nloc; b.st[1] = nx; }
        const unsigned old = xb_add(&bar[XB_XSUB(b.x)], 1u);
        const unsigned gen = old / nloc;
        if (old + 1u == (gen + 1u) * nloc) {
            __builtin_amdgcn_fence(__ATOMIC_RELEASE, "agent");
            asm volatile("s_waitcnt vmcnt(0)" ::: "memory");
            const unsigned og = xb_add(&bar[XB_TOP], 1u);
            const unsigned tg = og / nx;
            if (og + 1u == (tg + 1u) * nx) xb_add(&bar[XB_TOPGEN], 1u);
            else XB_SPIN(xb_ld(&bar[XB_TOPGEN]) == tg, bar);
            __builtin_amdgcn_fence(__ATOMIC_ACQUIRE, "agent");
            xb_add(&bar[XB_XGEN(b.x)], 1u);
            asm volatile("s_waitcnt vmcnt(0)" ::: "memory");
        } else {
            XB_SPIN(xb_ld(&bar[XB_XGEN(b.x)]) == gen, bar);
            __builtin_amdgcn_fence(__ATOMIC_ACQUIRE, "agent");
            asm volatile("s_waitcnt vmcnt(0)" ::: "memory");
        }
    }
    __syncthreads();
}

__device__ __forceinline__ void mod_item(const Params& p, char* smem, int it) {
    float* s_silu = (float*)smem;
    float* red = (float*)(smem + 9 * 1024 * 4);
    const int tid = threadIdx.x, lane = tid & 63, w = tid >> 6;
    const int layer = it / 96, col0 = (it % 96) * 64;
    for (int idx = tid; idx < 9 * 1024; idx += NTHREADS) {
        const int b = idx >> 10, k = idx & 1023;
        const float v = (b < 8) ? p.c[b * 1024 + k] : p.c_ctx[k];
        s_silu[idx] = v / (1.f + __expf(-v));
    }
    __syncthreads();
    float acc[9];
#pragma unroll
    for (int b = 0; b < 9; ++b) acc[b] = 0.f;
    const float* wp = p.w_mod + (size_t)layer * 1024 * 6144 + (size_t)(w * 128) * 6144 + col0 + lane;
    for (int kk = 0; kk < 128; kk += 8) {
        float wv[8];
#pragma unroll
        for (int u = 0; u < 8; ++u) wv[u] = wp[(size_t)(kk + u) * 6144];
#pragma unroll
        for (int b = 0; b < 9; ++b) {
            const f32x4 s0 = *(const f32x4*)(s_silu + b * 1024 + w * 128 + kk), s1 = *(const f32x4*)(s_silu + b * 1024 + w * 128 + kk + 4);
            acc[b] += s0[0] * wv[0] + s0[1] * wv[1] + s0[2] * wv[2] + s0[3] * wv[3] + s1[0] * wv[4] + s1[1] * wv[5] + s1[2] * wv[6] + s1[3] * wv[7];
        }
    }
#pragma unroll
    for (int b = 0; b < 9; ++b) red[(w * 9 + b) * 64 + lane] = acc[b];
    __syncthreads();
    for (int idx = tid; idx < 9 * 64; idx += NTHREADS) {
        const int b = idx >> 6, l = idx & 63;
        float s = 0.f;
#pragma unroll
        for (int ww = 0; ww < NWAVES; ++ww) s += red[(ww * 9 + b) * 64 + l];
        p.mod[(size_t)(layer * 9 + b) * 6144 + col0 + l] = s + p.b_mod[layer * 6144 + col0 + l];
    }
}

__device__ __forceinline__ void table_item(const Params& p) {
    const int tid = threadIdx.x;
    for (int idx = tid; idx < 64 * 16; idx += NTHREADS) {
        const int pi = idx >> 4, i = idx & 15;
        const float freq = exp2f(-(float)i * (13.28771238f / 16.f));
        const float ang = (float)pi * freq;
        p.misc[MISC_ROPE64 + idx * 2] = __cosf(ang); p.misc[MISC_ROPE64 + idx * 2 + 1] = __sinf(ang);
    }
    for (int idx = tid; idx < 64 * 8; idx += NTHREADS) {
        const int pi = idx >> 3, i = idx & 7;
        const float freq = exp2f(-(float)i * (13.28771238f / 8.f));
        const float ang = (float)pi * freq;
        p.misc[MISC_ROPE32 + idx * 2] = __cosf(ang); p.misc[MISC_ROPE32 + idx * 2 + 1] = __sinf(ang);
    }
    if (tid == 0) {
        float s1 = 0.f, s2 = 0.f;
        for (int i = 0; i < 64; ++i) { s1 += p.lq1[i] * p.lk1[i]; s2 += p.lq2[i] * p.lk2[i]; }
        p.misc[MISC_LAM] = __expf(s1) - __expf(s2) + LAMBDA_INIT;
    }
}

__device__ __forceinline__ void transpose_tile(char* smem, const float* src, int K, int Nsrc, bf16_t* dst, int ntn, int mode, const float* gain, int tile, int dmul = 1, int dadd = 0) {
    float* t = (float*)smem;
    const int tid = threadIdx.x, tx = tid & 63, ty = tid >> 6;
    const int kt = tile / ntn, nt = tile % ntn;
    const int np = nt * 64 + tx;
    int n = np;
    if (mode == 1) { n = np < 896 ? np : (np < 1024 ? 928 + (np - 896) : (np < 1152 ? 1056 + (np - 1024) : (np < 1184 ? 896 + (np - 1152) : -1))); }
    else if (mode == 2) { if (np < 512) n = (np >> 6) * 96 + (np & 63); else { const int m = np - 512; n = (m >> 5) * 96 + 64 + (m & 31); } }
#pragma unroll
    for (int i = 0; i < 8; ++i) {
        const int kl = ty + 8 * i, k = kt * 64 + kl;
        float v = 0.f;
        if (n >= 0) { v = src[(size_t)k * Nsrc + n]; if (gain) v *= gain[k]; }
        t[kl * 65 + tx] = v;
    }
    __syncthreads();
#pragma unroll
    for (int i = 0; i < 8; ++i) {
        const int nl = ty + 8 * i;
        dst[(size_t)((nt * dmul + dadd) * 64 + nl) * K + kt * 64 + tx] = (bf16_t)(cvt_pk_bf16(t[tx * 65 + nl], 0.f) & 0xffffu);
    }
}

__device__ __forceinline__ void transpose_item(const Params& p, char* smem, int r) {
    constexpr int T0 = 16 * 20, T1 = 4 * 12, T2 = 2 * 16, T3 = 16 * 16, T4 = 16 * 48, T5 = 16 * 16, TF = 16 * 44;
    if (r < T0) { transpose_tile(smem, p.ab_w_in, 1024, 1184, p.wt_in0, 20, 1, nullptr, r); return; } r -= T0;
    if (r < T1) { transpose_tile(smem, p.w_qb, 256, 768, p.wt_qb, 12, 2, p.q_norm, r); return; } r -= T1;
    if (r < T2) { transpose_tile(smem, p.w_kvb, 128, 1024, p.wt_kvb, 16, 0, p.kv_norm, r); return; } r -= T2;
    if (r < T3) { transpose_tile(smem, p.ab_w_out, 1024, 1024, p.wt_out0, 16, 0, nullptr, r); return; } r -= T3;
    if (r < T4) { transpose_tile(smem, p.d_w_in, 1024, 3072, p.wt_din, 48, 0, nullptr, r); return; } r -= T4;
    if (r < T5) { transpose_tile(smem, p.d_w_out, 1024, 1024, p.wt_dout, 16, 0, nullptr, r); return; } r -= T5;
    {
        const int j = r / TF, rr = r % TF;
        if (j < 2) transpose_tile(smem, p.w_gate + (size_t)j * 1024 * 2816, 1024, 2816, p.wt_gate + (size_t)j * 5632 * 1024, 44, 0, nullptr, rr, 2, 0);
        else if (j < 4) transpose_tile(smem, p.w_up + (size_t)(j - 2) * 1024 * 2816, 1024, 2816, p.wt_gate + (size_t)(j - 2) * 5632 * 1024, 44, 0, nullptr, rr, 2, 1);
        else transpose_tile(smem, p.w_down + (size_t)(j - 4) * 2816 * 1024, 2816, 1024, p.wt_down + (size_t)(j - 4) * 1024 * 2816, 16, 0, nullptr, rr);
    }
}
constexpr int N_TR_TILES = 16 * 20 + 4 * 12 + 2 * 16 + 16 * 16 + 16 * 48 + 16 * 16 + 6 * 16 * 44;

__device__ __forceinline__ void phase_prologue(const Params& p, char* smem) {
    const int total = 193 + N_TR_TILES;
    for (int it = blockIdx.x; it < total; it += gridDim.x) {
        if (it < 192) mod_item(p, smem, it);
        else if (it == 192) table_item(p);
        else transpose_item(p, smem, it - 193);
        __syncthreads();
    }
}

__device__ __forceinline__ void phase_h0(const Params& p) {
    const int lane = threadIdx.x & 63, w = threadIdx.x >> 6;
    for (int row = blockIdx.x * NWAVES + w; row < ROWS; row += gridDim.x * NWAVES) {
        const int b = row / TOK, j = row % TOK; const bool isc = j < CTXL;
        const float* rp = isc ? p.ctx + ((size_t)b * CTXL + j) * DM : p.x + ((size_t)b * SEQ + (j - CTXL)) * DM;
        const float* md = p.mod + (size_t)(0 * 9 + (isc ? 8 : b)) * 6144;
#pragma unroll 1
        for (int i = 0; i < 4; ++i) {
            const int col = i * 256 + lane * 4;
            const f32x4 v = *(const f32x4*)(rp + col), sh = *(const f32x4*)(md + col), sc = *(const f32x4*)(md + 1024 + col);
            u32x2 o; o.x = cvt_pk_bf16(v[0] * (1.f + sc[0]) + sh[0], v[1] * (1.f + sc[1]) + sh[1]); o.y = cvt_pk_bf16(v[2] * (1.f + sc[2]) + sh[2], v[3] * (1.f + sc[3]) + sh[3]);
            *(u32x2*)(p.h + (size_t)row * DM + col) = o;
        }
    }
}

__device__ __forceinline__ void gemm_core(char* smem, const bf16_t* __restrict__ A, int lda, int ar0a, int aloa, int ahia, int ar0b, int alob, int ahib,
                                          const bf16_t* __restrict__ B, int ldb, int K, const bf16_t* zero16, f32x4 (&acc)[8][4]) {
    constexpr int ROWB = 128, OPA = 256 * ROWB, STG = 2 * OPA, NI = 4;
    static_assert(2 * STG <= SMEM_BYTES, "LDS");
    const int tid = threadIdx.x, lane = tid & 63, w = __builtin_amdgcn_readfirstlane(tid >> 6), wr = w >> 2, wc = w & 3, fr = lane & 15, fq = lane >> 4;
    const int rl = lane >> 3, kcs = (lane & 7) ^ rl;
#pragma unroll
    for (int m = 0; m < 8; ++m)
#pragma unroll
        for (int n = 0; n < 4; ++n) acc[m][n] = (f32x4){0.f, 0.f, 0.f, 0.f};
    const int nk = K / 64;
    int aoff[NI], boff[NI];
#pragma unroll
    for (int i = 0; i < NI; ++i) {
        const int row = (w * NI + i) * 8 + rl, hf = row >> 7, gr = (hf ? ar0b : ar0a) + (row & 127);
        const bool ok = hf ? (gr >= alob && gr < ahib) : (gr >= aloa && gr < ahia);
        aoff[i] = ok ? gr * lda + kcs * 8 : -1;
        boff[i] = row * ldb + kcs * 8;
    }
    __syncthreads();
#pragma unroll
    for (int i = 0; i < NI; ++i) {
        __builtin_amdgcn_global_load_lds((const unsigned*)(aoff[i] >= 0 ? A + aoff[i] : zero16), (LAS unsigned*)(smem + (w * NI + i) * 1024), 16, 0, 0);
        __builtin_amdgcn_global_load_lds((const unsigned*)(B + boff[i]), (LAS unsigned*)(smem + OPA + (w * NI + i) * 1024), 16, 0, 0);
    }
    asm volatile("s_waitcnt vmcnt(0)" ::: "memory"); __syncthreads();
    const int sw = fr & 7;
    for (int kt = 0; kt < nk; ++kt) {
        const bool pf = kt + 1 < nk; const int nst = ((kt + 1) & 1) * STG;
        const char* base = smem + (kt & 1) * STG;
#pragma unroll
        for (int ks = 0; ks < 2; ++ks) {
            const int co = (((ks * 4 + fq) ^ sw) * 16);
            bf16x8 bfr[4];
#pragma unroll
            for (int n = 0; n < 4; ++n) bfr[n] = *(const bf16x8*)(base + OPA + (wc * 64 + n * 16 + fr) * ROWB + co);
#pragma unroll
            for (int m = 0; m < 8; ++m) {
                const bf16x8 af = *(const bf16x8*)(base + (wr * 128 + m * 16 + fr) * ROWB + co);
#pragma unroll
                for (int n = 0; n < 4; ++n) acc[m][n] = __builtin_amdgcn_mfma_f32_16x16x32_bf16(af, bfr[n], acc[m][n], 0, 0, 0);
                if (ks == 0 && pf) {
                    const int i = m & 3, lo_ = nst + (w * NI + i) * 1024;
                    if (m < 4) __builtin_amdgcn_global_load_lds((const unsigned*)(aoff[i] >= 0 ? A + aoff[i] + (kt + 1) * 64 : zero16), (LAS unsigned*)(smem + lo_), 16, 0, 0);
                    else __builtin_amdgcn_global_load_lds((const unsigned*)(B + boff[i] + (kt + 1) * 64), (LAS unsigned*)(smem + lo_ + OPA), 16, 0, 0);
                }
            }
        }
        asm volatile("s_waitcnt vmcnt(0)" ::: "memory");
        __syncthreads();
    }
}

__device__ __forceinline__ void acc_to_ct(float* Ct0, const f32x4 (&acc)[8][4], int ai) {
    const int tid = threadIdx.x, lane = tid & 63, w = tid >> 6, wr = w >> 2, wc = w & 3, fr = lane & 15, fq = lane >> 4;
    __syncthreads();
    if (wr == ai) {
        float* Ct = Ct0 + (wc >> 1) * CT_FLOATS + (wc & 1) * 64 + fr;
#pragma unroll
        for (int m = 0; m < 8; ++m)
#pragma unroll
            for (int n = 0; n < 4; ++n)
#pragma unroll
                for (int j = 0; j < 4; ++j) Ct[(m * 16 + fq * 4 + j) * LDC + n * 16] = acc[m][n][j];
    }
    __syncthreads();
}

__device__ __forceinline__ void gemm_core_h(char* smem, const bf16_t* __restrict__ A, int lda, int ar0a, int aloa, int ahia, int ar0b, int alob, int ahib,
                                            const bf16_t* __restrict__ B, int ldb, int K, const bf16_t* zero16, f32x4 (&acc)[4][4]) {
    constexpr int ROWB = 128, OPA = 256 * ROWB, STG = 2 * OPA, NI = 4, NIB = 2;
    const int tid = threadIdx.x, lane = tid & 63, w = __builtin_amdgcn_readfirstlane(tid >> 6), wr = w >> 1, wc = w & 1, fr = lane & 15, fq = lane >> 4;
    const int rl = lane >> 3, kcs = (lane & 7) ^ rl;
#pragma unroll
    for (int m = 0; m < 4; ++m)
#pragma unroll
        for (int n = 0; n < 4; ++n) acc[m][n] = (f32x4){0.f, 0.f, 0.f, 0.f};
    const int nk = K / 64;
    int aoff[NI], boff[NIB];
#pragma unroll
    for (int i = 0; i < NI; ++i) {
        const int row = (w * NI + i) * 8 + rl, hf = row >> 7, gr = (hf ? ar0b : ar0a) + (row & 127);
        const bool ok = hf ? (gr >= alob && gr < ahib) : (gr >= aloa && gr < ahia);
        aoff[i] = ok ? gr * lda + kcs * 8 : -1;
    }
#pragma unroll
    for (int i = 0; i < NIB; ++i) boff[i] = ((w * NIB + i) * 8 + rl) * ldb + kcs * 8;
    __syncthreads();
#pragma unroll
    for (int i = 0; i < NI; ++i) __builtin_amdgcn_global_load_lds((const unsigned*)(aoff[i] >= 0 ? A + aoff[i] : zero16), (LAS unsigned*)(smem + (w * NI + i) * 1024), 16, 0, 0);
#pragma unroll
    for (int i = 0; i < NIB; ++i) __builtin_amdgcn_global_load_lds((const unsigned*)(B + boff[i]), (LAS unsigned*)(smem + OPA + (w * NIB + i) * 1024), 16, 0, 0);
    asm volatile("s_waitcnt vmcnt(0)" ::: "memory"); __syncthreads();
    const int sw = fr & 7;
    for (int kt = 0; kt < nk; ++kt) {
        const bool pf = kt + 1 < nk; const int nst = ((kt + 1) & 1) * STG;
        const char* base = smem + (kt & 1) * STG;
#pragma unroll
        for (int ks = 0; ks < 2; ++ks) {
            const int co = (((ks * 4 + fq) ^ sw) * 16);
            bf16x8 bfr[4];
#pragma unroll
            for (int n = 0; n < 4; ++n) bfr[n] = *(const bf16x8*)(base + OPA + (wc * 64 + n * 16 + fr) * ROWB + co);
#pragma unroll
            for (int m = 0; m < 4; ++m) {
                const bf16x8 af = *(const bf16x8*)(base + (wr * 64 + m * 16 + fr) * ROWB + co);
#pragma unroll
                for (int n = 0; n < 4; ++n) acc[m][n] = __builtin_amdgcn_mfma_f32_16x16x32_bf16(af, bfr[n], acc[m][n], 0, 0, 0);
                if (pf) {
                    if (ks == 0) __builtin_amdgcn_global_load_lds((const unsigned*)(aoff[m] >= 0 ? A + aoff[m] + (kt + 1) * 64 : zero16), (LAS unsigned*)(smem + nst + (w * NI + m) * 1024), 16, 0, 0);
                    else if (m < NIB) __builtin_amdgcn_global_load_lds((const unsigned*)(B + boff[m & 1] + (kt + 1) * 64), (LAS unsigned*)(smem + nst + OPA + (w * NIB + (m & 1)) * 1024), 16, 0, 0);
                }
            }
        }
        asm volatile("s_waitcnt vmcnt(0)" ::: "memory");
        __syncthreads();
    }
}
__device__ __forceinline__ void acc_to_ct_h(float* Ct0, const f32x4 (&acc)[4][4], int ai) {
    const int tid = threadIdx.x, lane = tid & 63, w = tid >> 6, wr = w >> 1, wc = w & 1, fr = lane & 15, fq = lane >> 4;
    __syncthreads();
    if ((wr >> 1) == ai) {
        float* Ct = Ct0 + ((wr & 1) * 64 + fq * 4) * LDC + wc * 64 + fr;
#pragma unroll
        for (int m = 0; m < 4; ++m)
#pragma unroll
            for (int n = 0; n < 4; ++n)
#pragma unroll
                for (int j = 0; j < 4; ++j) Ct[(m * 16 + j) * LDC + n * 16] = acc[m][n][j];
    }
    __syncthreads();
}
#define TAIL_DECODE(T) const int G_ = gridDim.x, Tfull_ = ((T) / G_) * G_, total_ = Tfull_ + 2 * ((T) - Tfull_)
#define NOTAIL_DECODE(T) const int G_ = gridDim.x, Tfull_ = (T), total_ = (T)
#define TAIL_ITEM(it, tile, half) int tile, half; if ((it) < Tfull_) { tile = (it); half = -1; } else { const int r_ = (it) - Tfull_; tile = Tfull_ + (r_ >> 1); half = r_ & 1; }

__device__ __forceinline__ void load8(const float* src, float (&v)[8]) {
    const f32x4 a = *(const f32x4*)src, b = *(const f32x4*)(src + 4);
    v[0] = a[0]; v[1] = a[1]; v[2] = a[2]; v[3] = a[3]; v[4] = b[0]; v[5] = b[1]; v[6] = b[2]; v[7] = b[3];
}

__device__ __forceinline__ void rope8(const float* rowp, int c0, int hd, int pos, const float* tab, float (&v)[8]) {
    const int qs = hd >> 2, ch = c0 & (hd - 1), qd = ch / qs, i0 = ch & (qs - 1);
    const int idx = (qd < 2) ? (pos >> 6) : (pos & 63);
    const int pc = (qd & 1) ? c0 - qs : c0 + qs; const float sgn = (qd & 1) ? 1.f : -1.f;
    const float* t = tab + (idx * qs + i0) * 2;
#pragma unroll
    for (int e = 0; e < 8; ++e) v[e] = v[e] * t[2 * e] + sgn * rowp[pc + e] * t[2 * e + 1];
}

__device__ __forceinline__ void store_col8(const float* Ct, int c, int rc, bf16_t* dst, const float* rs) {
    float v[8];
#pragma unroll
    for (int e = 0; e < 8; ++e) { v[e] = Ct[(rc * 8 + e) * LDC + c]; if (rs) v[e] *= rs[rc * 8 + e]; }
    store8(dst, v);
}

__device__ __forceinline__ void epi_proj0(const Params& p, const float* Ct, int mt, int nt) {
    const int tid = threadIdx.x;
    bf16_t* proj0 = p.big + BE_PROJ0; bf16_t* vt_swa = p.big + BE_VT_SWA; bf16_t* k_mla = p.big + BE_K_MLA;
    extern __shared__ __attribute__((aligned(16))) char smem_dyn_[]; const float* lds_tab_ = (const float*)(smem_dyn_ + SMEM_BYTES);
    const float* rope64 = lds_tab_ + MISC_ROPE64; const float* rope32 = lds_tab_ + MISC_ROPE32;
    const int b = mt / 18, jt = mt % 18; const bool is_ctx = jt < 2; const int row0 = mt * 128, tok0 = jt * 128;
    if (nt == 8) {
#pragma unroll 1
        for (int i = 0; i < 4; ++i) { const int id = tid + NTHREADS * i, c = id & 127, rc = id >> 7;
            store_col8(Ct, c, rc, vt_swa + (size_t)((b * 2 + (c >> 6)) * 64 + (c & 63)) * TOK + tok0 + rc * 8, nullptr); }
    } else {
#pragma unroll 1
        for (int i = 0; i < 4; ++i) {
            const int id = tid + NTHREADS * i, r = id >> 4, c0 = (id & 15) * 8;
            const float* rowp = Ct + r * LDC; float v[8]; load8(rowp + c0, v);
            const int grow = row0 + r, pos = tok0 + r - CTXL;
            if (nt <= 1 || nt == 6) { store8(proj0 + (size_t)grow * 1024 + nt * 128 + c0, v); }
            else if (nt <= 5 || nt == 7) { if (!is_ctx) rope8(rowp, c0, 64, pos, rope64, v); store8(proj0 + (size_t)grow * 1024 + (nt == 7 ? 896 : nt * 128) + c0, v); }
            else if (c0 < 32) { if (!is_ctx) rope8(rowp, c0, 32, pos, rope32, v);
#pragma unroll
                for (int hh = 0; hh < 8; ++hh) store8(k_mla + (size_t)grow * 768 + hh * 96 + 64 + c0, v); }
        }
    }
}
__device__ __forceinline__ void phase_proj0(const Params& p, char* smem) {
    float* Ct = (float*)smem;
    TAIL_DECODE(72 * 5);
    for (int it = blockIdx.x; it < total_; it += G_) {
        TAIL_ITEM(it, tile, half)
        const int mt2 = tile / 5, nt2 = tile % 5;
        if (half < 0) {
            f32x4 acc[8][4];
            gemm_core(smem, p.h, DM, mt2 * 256, 0, ROWS, mt2 * 256 + 128, 0, ROWS, p.wt_in0 + (size_t)nt2 * 256 * DM, DM, DM, (const bf16_t*)p.bar, acc);
#pragma unroll 1
            for (int ai = 0; ai < 2; ++ai) {
                acc_to_ct(Ct, acc, ai);
                epi_proj0(p, Ct, mt2 * 2 + ai, nt2 * 2);
                epi_proj0(p, Ct + CT_FLOATS, mt2 * 2 + ai, nt2 * 2 + 1);
            }
        } else {
            const int nt = nt2 * 2 + half;
            f32x4 acc[4][4];
            gemm_core_h(smem, p.h, DM, mt2 * 256, 0, ROWS, mt2 * 256 + 128, 0, ROWS, p.wt_in0 + (size_t)nt * 128 * DM, DM, DM, (const bf16_t*)p.bar, acc);
#pragma unroll 1
            for (int ai = 0; ai < 2; ++ai) { acc_to_ct_h(Ct, acc, ai); epi_proj0(p, Ct, mt2 * 2 + ai, nt); }
        }
    }
}

__device__ __forceinline__ void row_rstd(const bf16_t* A, int lda, int row0, int K, float* rs) {
    const int tid = threadIdx.x;
    if (tid < 256) {
        const int r = tid >> 1, hf = tid & 1; const int n = K / 2;
        const bf16_t* ap = A + (size_t)(row0 + r) * lda + hf * n; float ss = 0.f;
        for (int k = 0; k < n; k += 8) { const u32x4 v = *(const u32x4*)(ap + k);
            ss += bflo(v.x) * bflo(v.x) + bfhi(v.x) * bfhi(v.x) + bflo(v.y) * bflo(v.y) + bfhi(v.y) * bfhi(v.y) + bflo(v.z) * bflo(v.z) + bfhi(v.z) * bfhi(v.z) + bflo(v.w) * bflo(v.w) + bfhi(v.w) * bfhi(v.w); }
        ss += __shfl_xor(ss, 1);
        if (hf == 0) rs[r] = rsqrtf(ss / (float)K + 1e-6f);
    }
    __syncthreads();
}
__device__ __forceinline__ void epi_mla_q(const Params& p, const float* Ct, const float* rs, int mt, int nt) {
    extern __shared__ __attribute__((aligned(16))) char smem_dyn_[]; const float* lds_tab_ = (const float*)(smem_dyn_ + SMEM_BYTES);
    const int tid = threadIdx.x; bf16_t* q_mla = p.big + BE_Q_MLA; const float* rope32 = lds_tab_ + MISC_ROPE32;
    const int jt = mt % 18; const bool is_ctx = jt < 2; const int row0 = mt * 128, tok0 = jt * 128;
#pragma unroll 1
    for (int i = 0; i < 4; ++i) {
        const int id = tid + NTHREADS * i, r = id >> 4, c0 = (id & 15) * 8;
        const float* rowp = Ct + r * LDC; float v[8]; load8(rowp + c0, v);
        const int grow = row0 + r, pos = tok0 + r - CTXL; const float sc = rs[r];
        int dcol;
        if (nt < 4) { const int cg = nt * 128 + c0; dcol = (cg >> 6) * 96 + (cg & 63); }
        else { const int cg = (nt - 4) * 128 + c0; dcol = (cg >> 5) * 96 + 64 + (cg & 31); if (!is_ctx) rope8(rowp, c0, 32, pos, rope32, v); }
#pragma unroll
        for (int e = 0; e < 8; ++e) v[e] *= sc;
        store8(q_mla + (size_t)grow * 768 + dcol, v);
    }
}
__device__ __forceinline__ void epi_mla_kv(const Params& p, const float* Ct, const float* rs, int mt, int hh) {
    const int tid = threadIdx.x; bf16_t* k_mla = p.big + BE_K_MLA; bf16_t* vt_mla = p.big + BE_VT_MLA;
    const int b = mt / 18, jt = mt % 18; const int row0 = mt * 128, tok0 = jt * 128;
#pragma unroll 1
    for (int i = 0; i < 2; ++i) {
        const int id = tid + NTHREADS * i, r = id >> 3, c0 = (id & 7) * 8;
        float v[8]; load8(Ct + r * LDC + c0, v); const float sc = rs[r];
#pragma unroll
        for (int e = 0; e < 8; ++e) v[e] *= sc;
        store8(k_mla + (size_t)(row0 + r) * 768 + hh * 96 + c0, v);
    }
#pragma unroll 1
    for (int i = 0; i < 2; ++i) { const int id = tid + NTHREADS * i, c = 64 + (id & 63), rc = id >> 6;
        store_col8(Ct, c, rc, vt_mla + (size_t)((b * 8 + hh) * 64 + (c - 64)) * TOK + tok0 + rc * 8, rs); }
}
__device__ __forceinline__ void phase_mla_up(const Params& p, char* smem) {
    float* Ct = (float*)smem; float* rs = (float*)(smem + 2 * CT_FLOATS * 4);
    bf16_t* proj0 = p.big + BE_PROJ0;
    for (int it = blockIdx.x; it < 72 * 7; it += gridDim.x) {
        const int mt2 = it / 7, nt2 = it % 7;
        f32x4 acc[8][4];
        if (nt2 < 3) gemm_core(smem, proj0, 1024, mt2 * 256, 0, ROWS, mt2 * 256 + 128, 0, ROWS, p.wt_qb + (size_t)nt2 * 256 * 256, 256, 256, (const bf16_t*)p.bar, acc);
        else gemm_core(smem, proj0 + 768, 1024, mt2 * 256, 0, ROWS, mt2 * 256 + 128, 0, ROWS, p.wt_kvb + (size_t)(nt2 - 3) * 256 * 128, 128, 128, (const bf16_t*)p.bar, acc);
#pragma unroll 1
        for (int ai = 0; ai < 2; ++ai) {
            acc_to_ct(Ct, acc, ai);
            const int mt = mt2 * 2 + ai;
            if (nt2 < 3) { row_rstd(proj0, 1024, mt * 128, 256, rs); epi_mla_q(p, Ct, rs, mt, nt2 * 2); epi_mla_q(p, Ct + CT_FLOATS, rs, mt, nt2 * 2 + 1); }
            else { row_rstd(proj0 + 768, 1024, mt * 128, 128, rs); epi_mla_kv(p, Ct, rs, mt, (nt2 - 3) * 2); epi_mla_kv(p, Ct + CT_FLOATS, rs, mt, (nt2 - 3) * 2 + 1); }
        }
    }
}

template <int DQK, int DV, bool WINDOWED>
__device__ __forceinline__ void flash_pass(char* smem, const bf16_t* __restrict__ Qp, int ldq, const bf16_t* __restrict__ Kp, int ldk,
                                           const bf16_t* __restrict__ Vtp, int seg2s, int seg2e, int q_tok0, float sc2,
                                           f32x4 (&o)[DV / 16][2], float (&mrun)[2], float (&lrun)[2]) {
    constexpr int KROW = DQK * 2, VROW = 128, KB = 64 * KROW, VB = DV * VROW, STG = KB + VB;
    constexpr int KCPR = DQK / 8, NKI = KCPR, NVI = DV / 8, KCPT = (NKI + 7) / 8, VCPT = NVI / 8, NKS = DQK / 32, NMD = DV / 16;
    static_assert(2 * STG <= SMEM_BYTES, "LDS");
    const int tid = threadIdx.x, lane = tid & 63, w = tid >> 6, fr = lane & 15, fq = lane >> 4, wq0 = w * 32;
    bf16x8 qf[2][NKS];
#pragma unroll
    for (int nq = 0; nq < 2; ++nq)
#pragma unroll
        for (int ks = 0; ks < NKS; ++ks) qf[nq][ks] = *(const bf16x8*)(Qp + (size_t)(wq0 + nq * 16 + fr) * ldq + ks * 32 + fq * 8);
#pragma unroll
    for (int md = 0; md < NMD; ++md) { o[md][0] = (f32x4){0.f, 0.f, 0.f, 0.f}; o[md][1] = (f32x4){0.f, 0.f, 0.f, 0.f}; }
    float mref[2]; mref[0] = mref[1] = -1e30f; lrun[0] = lrun[1] = 0.f;
    const float thr = 8.0f / sc2;
    const int nt = 4 + (seg2e > seg2s ? (seg2e - seg2s) / 64 : 0);
    const int wu = __builtin_amdgcn_readfirstlane(w);
    int koffg[KCPT], voffg[VCPT];
#pragma unroll
    for (int i = 0; i < KCPT; ++i) { const int idx = (wu + 8 * i) * 64 + lane, rho = (idx / KCPR) & 63, cp = idx % KCPR;
        const int key = 32 * (rho >> 5) + 8 * ((rho >> 2) & 3) + 4 * ((rho >> 4) & 1) + (rho & 3);
        const int kcs = (DQK == 64) ? (cp ^ (rho & 7)) : ((cp & ~3) | ((cp & 3) ^ ((4 - ((rho >> 2) & 3)) & 3)));
        koffg[i] = key * ldk + kcs * 8; }
#pragma unroll
    for (int i = 0; i < VCPT; ++i) { const int idx = (wu + 8 * i) * 64 + lane, r = idx >> 3, cp = idx & 7; voffg[i] = r * TOK + ((cp ^ (r & 7)) * 8); }
    __syncthreads();
#define FDMA(t, st) do { const int key0_ = (t) < 4 ? (t) * 64 : seg2s + ((t) - 4) * 64; const bf16_t* kg_ = Kp + (size_t)key0_ * ldk; const bf16_t* vg_ = Vtp + key0_; \
        _Pragma("unroll") for (int i = 0; i < KCPT; ++i) if (wu + 8 * i < NKI) __builtin_amdgcn_global_load_lds((const unsigned*)(kg_ + koffg[i]), (LAS unsigned*)(smem + (st) * STG + (wu + 8 * i) * 1024), 16, 0, 0); \
        _Pragma("unroll") for (int i = 0; i < VCPT; ++i) __builtin_amdgcn_global_load_lds((const unsigned*)(vg_ + voffg[i]), (LAS unsigned*)(smem + (st) * STG + KB + (wu + 8 * i) * 1024), 16, 0, 0); } while (0)
    FDMA(0, 0);
    asm volatile("s_waitcnt vmcnt(0)" ::: "memory"); __syncthreads();
    const int ksw = (DQK == 64) ? (fr & 7) : ((4 - ((fr >> 2) & 3)) & 3);
    for (int t = 0; t < nt; ++t) {
        if (t + 1 < nt) FDMA(t + 1, (t + 1) & 1);
        const char* kb = smem + (t & 1) * STG; const char* vb = kb + KB;
        const int key0 = t < 4 ? t * 64 : seg2s + (t - 4) * 64;
        f32x4 s[4][2];
#pragma unroll
        for (int mk = 0; mk < 4; ++mk) { s[mk][0] = (f32x4){0.f, 0.f, 0.f, 0.f}; s[mk][1] = (f32x4){0.f, 0.f, 0.f, 0.f}; }
#pragma unroll
        for (int ks = 0; ks < NKS; ++ks) {
            const int co = (DQK == 64) ? (((ks * 4 + fq) ^ ksw) * 16) : ((ks * 4 + (fq ^ ksw)) * 16);
#pragma unroll
            for (int mk = 0; mk < 4; ++mk) {
                const bf16x8 kf = *(const bf16x8*)(kb + (mk * 16 + fr) * KROW + co);
                s[mk][0] = __builtin_amdgcn_mfma_f32_16x16x32_bf16(kf, qf[0][ks], s[mk][0], 0, 0, 0);
                s[mk][1] = __builtin_amdgcn_mfma_f32_16x16x32_bf16(kf, qf[1][ks], s[mk][1], 0, 0, 0);
            }
        }
        __builtin_amdgcn_sched_barrier(0);
        bf16x8 pf[2][2];
#pragma unroll
        for (int nq = 0; nq < 2; ++nq) {
            if (WINDOWED && key0 >= CTXL) {
                const int qpos = q_tok0 - CTXL + wq0 + nq * 16 + fr;
#pragma unroll
                for (int mk = 0; mk < 4; ++mk)
#pragma unroll
                    for (int j = 0; j < 4; ++j) { const int kpos = key0 - CTXL + 32 * (mk >> 1) + 8 * fq + 4 * (mk & 1) + j; const int d = qpos - kpos; if (d > 128 || d < -128) s[mk][nq][j] = -1e30f; }
            }
            float mx = fmaxf(fmaxf(s[0][nq][0], s[0][nq][1]), fmaxf(s[0][nq][2], s[0][nq][3]));
#pragma unroll
            for (int mk = 1; mk < 4; ++mk) mx = fmaxf(fmaxf(mx, fmaxf(s[mk][nq][0], s[mk][nq][1])), fmaxf(s[mk][nq][2], s[mk][nq][3]));
            mx = fmaxf(mx, __shfl_xor(mx, 16)); mx = fmaxf(mx, __shfl_xor(mx, 32));
            const bool need = mx > mref[nq] + thr;
            if (__any(need)) {
                const float mnew = need ? mx : mref[nq];
                const float alpha = fast_exp2((mref[nq] - mnew) * sc2);
                mref[nq] = mnew; lrun[nq] *= alpha;
#pragma unroll
                for (int md = 0; md < NMD; ++md) o[md][nq] = o[md][nq] * alpha;
            }
            const float nm = -mref[nq] * sc2;
            float ls = 0.f;
#pragma unroll
            for (int mk = 0; mk < 4; ++mk)
#pragma unroll
                for (int j = 0; j < 4; ++j) { const float pv = fast_exp2(fmaf(s[mk][nq][j], sc2, nm)); s[mk][nq][j] = pv; ls += pv; }
            lrun[nq] += ls;
#pragma unroll
            for (int kk = 0; kk < 2; ++kk) {
                u32x4 pk; pk.x = cvt_pk_bf16(s[2 * kk][nq][0], s[2 * kk][nq][1]); pk.y = cvt_pk_bf16(s[2 * kk][nq][2], s[2 * kk][nq][3]);
                pk.z = cvt_pk_bf16(s[2 * kk + 1][nq][0], s[2 * kk + 1][nq][1]); pk.w = cvt_pk_bf16(s[2 * kk + 1][nq][2], s[2 * kk + 1][nq][3]);
                pf[nq][kk] = __builtin_bit_cast(bf16x8, pk);
            }
        }
        __builtin_amdgcn_sched_barrier(0);
#pragma unroll
        for (int kk = 0; kk < 2; ++kk) {
            const int co = (((kk * 4 + fq) ^ (fr & 7)) * 16);
#pragma unroll
            for (int md = 0; md < NMD; ++md) {
                const bf16x8 vf = *(const bf16x8*)(vb + (md * 16 + fr) * VROW + co);
                o[md][0] = __builtin_amdgcn_mfma_f32_16x16x32_bf16(vf, pf[0][kk], o[md][0], 0, 0, 0);
                o[md][1] = __builtin_amdgcn_mfma_f32_16x16x32_bf16(vf, pf[1][kk], o[md][1], 0, 0, 0);
            }
        }
        asm volatile("s_waitcnt vmcnt(0)" ::: "memory");
        __syncthreads();
    }
#undef FDMA
#pragma unroll
    for (int nq = 0; nq < 2; ++nq) { float l = lrun[nq]; l += __shfl_xor(l, 16); l += __shfl_xor(l, 32); lrun[nq] = l; mrun[nq] = mref[nq] * sc2; }
}

template <int NMD>
__device__ __forceinline__ void store_o(bf16_t* Op, int ldo, const f32x4 (&o)[NMD][2], const float (&inv)[2]) {
    const int lane = threadIdx.x & 63, w = threadIdx.x >> 6, fr = lane & 15, fq = lane >> 4, wq0 = w * 32;
#pragma unroll
    for (int nq = 0; nq < 2; ++nq)
#pragma unroll
        for (int md = 0; md < NMD; ++md) {
            u32x2 v; v.x = cvt_pk_bf16(o[md][nq][0] * inv[nq], o[md][nq][1] * inv[nq]); v.y = cvt_pk_bf16(o[md][nq][2] * inv[nq], o[md][nq][3] * inv[nq]);
            *(u32x2*)(Op + (size_t)(wq0 + nq * 16 + fr) * ldo + md * 16 + fq * 4) = v;
        }
}

__device__ __forceinline__ void phase_attn0(const Params& p, char* smem) {
    const bf16_t* proj0 = p.big + BE_PROJ0; const bf16_t* vt_swa = p.big + BE_VT_SWA; const bf16_t* q_mla = p.big + BE_Q_MLA;
    const bf16_t* k_mla = p.big + BE_K_MLA; const bf16_t* vt_mla = p.big + BE_VT_MLA;
    for (int it = blockIdx.x; it < 1152; it += gridDim.x) {
        int kind, b, hh, qbl; bool lat;
        if (it < 1024) { lat = true; kind = it >> 9; const int r = it & 511; b = r >> 6; hh = (r >> 3) & 7; qbl = r & 7; }
        else { lat = false; const int r = it - 1024; kind = r >> 6; b = (r >> 3) & 7; hh = r & 7; qbl = 0; }
        const int qtok0 = lat ? CTXL + 256 * qbl : 0, row0 = b * TOK + qtok0;
        f32x4 o[4][2]; float m[2], l[2], inv[2];
        if (kind == 0) {
            flash_pass<96, 64, false>(smem, q_mla + (size_t)row0 * 768 + hh * 96, 768, k_mla + (size_t)b * TOK * 768 + hh * 96, 768,
                               vt_mla + (size_t)((b * 8 + hh) * 64) * TOK, CTXL, lat ? TOK : CTXL, qtok0, 0.10206207262f * LOG2E, o, m, l);
            inv[0] = 1.f / l[0]; inv[1] = 1.f / l[1];
            store_o<4>(p.o + (size_t)row0 * 1024 + hh * 64, 1024, o, inv);
        } else {
            int s2s = CTXL, s2e = CTXL;
            if (lat) { const int lo = 256 * qbl - 128, hi = 256 * qbl + 384; s2s = CTXL + (lo > 0 ? lo : 0); s2e = CTXL + (hi < SEQ ? hi : SEQ); }
            flash_pass<64, 64, true>(smem, proj0 + (size_t)row0 * 1024 + 256 + hh * 64, 1024, proj0 + (size_t)b * TOK * 1024 + 896 + (hh >> 2) * 64, 1024,
                               vt_swa + (size_t)((b * 2 + (hh >> 2)) * 64) * TOK, s2s, s2e, qtok0, 0.125f * LOG2E, o, m, l);
            const float sk = p.sink[hh] * LOG2E;
            inv[0] = 1.f / (l[0] + fast_exp2(sk - m[0])); inv[1] = 1.f / (l[1] + fast_exp2(sk - m[1]));
            store_o<4>(p.o + (size_t)row0 * 1024 + 512 + hh * 64, 1024, o, inv);
        }
    }
}

__device__ __forceinline__ void epi_plain(const float* Ct, bf16_t* out, int ldo, int mt, int nt) {
    const int tid = threadIdx.x;
#pragma unroll 1
    for (int i = 0; i < 4; ++i) {
        const int id = tid + NTHREADS * i, r = id >> 4, c0 = (id & 15) * 8;
        float v[8]; load8(Ct + r * LDC + c0, v);
        store8(out + (size_t)(mt * 128 + r) * ldo + nt * 128 + c0, v);
    }
}
__device__ __forceinline__ void phase_gemm_plain(char* smem, const bf16_t* zero16, const bf16_t* A, int lda, const bf16_t* Wt, int K, int ntn2, bf16_t* out, int ldo, bool lat_only) {
    float* Ct = (float*)smem;
    const int nmt2 = lat_only ? 64 : 72;
    TAIL_DECODE(nmt2 * ntn2);
    for (int it = blockIdx.x; it < total_; it += G_) {
        TAIL_ITEM(it, tile, half)
        int mt2 = tile / ntn2; const int nt2 = tile % ntn2;
        if (lat_only) mt2 = (mt2 >> 3) * 9 + 1 + (mt2 & 7);
        if (half < 0) {
            f32x4 acc[8][4];
            gemm_core(smem, A, lda, mt2 * 256, 0, ROWS, mt2 * 256 + 128, 0, ROWS, Wt + (size_t)nt2 * 256 * K, K, K, zero16, acc);
#pragma unroll 1
            for (int ai = 0; ai < 2; ++ai) {
                acc_to_ct(Ct, acc, ai);
                epi_plain(Ct, out, ldo, mt2 * 2 + ai, nt2 * 2);
                epi_plain(Ct + CT_FLOATS, out, ldo, mt2 * 2 + ai, nt2 * 2 + 1);
            }
        } else {
            const int nt = nt2 * 2 + half;
            f32x4 acc[4][4];
            gemm_core_h(smem, A, lda, mt2 * 256, 0, ROWS, mt2 * 256 + 128, 0, ROWS, Wt + (size_t)nt * 128 * K, K, K, zero16, acc);
#pragma unroll 1
            for (int ai = 0; ai < 2; ++ai) { acc_to_ct_h(Ct, acc, ai); epi_plain(Ct, out, ldo, mt2 * 2 + ai, nt); }
        }
    }
}

__device__ __forceinline__ void phase_ln(const Params& p, const float* res_lat, const float* res_ctx, int layer, int gate_idx, const float* lng, const float* lnb,
                                         float* out_lat, float* out_ctx, bool write_h, int hl, int sh_idx, int sc_idx, bool inc_ctx) {
    const int lane = threadIdx.x & 63, w = threadIdx.x >> 6;
    for (int row = blockIdx.x * NWAVES + w; row < ROWS; row += gridDim.x * NWAVES) {
        const int b = row / TOK, j = row % TOK; const bool isc = j < CTXL;
        if (isc && !inc_ctx) continue;
        const size_t ro = isc ? ((size_t)b * CTXL + j) * DM : ((size_t)b * SEQ + (j - CTXL)) * DM;
        const float* rp = (isc ? res_ctx : res_lat) + ro; float* op = (isc ? out_ctx : out_lat) + ro;
        const int bm = isc ? 8 : b;
        const float* gate = p.mod + (size_t)(layer * 9 + bm) * 6144 + gate_idx * 1024;
        bf16_t* fp = p.h + (size_t)row * DM;
        f32x4 y[4]; float sum = 0.f;
#pragma unroll
        for (int i = 0; i < 4; ++i) {
            const int col = i * 256 + lane * 4;
            const f32x4 r = *(const f32x4*)(rp + col), gt = *(const f32x4*)(gate + col); const u32x2 f = *(const u32x2*)(fp + col);
            y[i][0] = ALPHA_RES * r[0] + gt[0] * bflo(f.x); y[i][1] = ALPHA_RES * r[1] + gt[1] * bfhi(f.x);
            y[i][2] = ALPHA_RES * r[2] + gt[2] * bflo(f.y); y[i][3] = ALPHA_RES * r[3] + gt[3] * bfhi(f.y);
            sum += (y[i][0] + y[i][1]) + (y[i][2] + y[i][3]);
        }
        const float mean = wave_sum(sum) * (1.f / DM); float sq = 0.f;
#pragma unroll
        for (int i = 0; i < 4; ++i) { y[i] = y[i] - mean; sq += (y[i][0] * y[i][0] + y[i][1] * y[i][1]) + (y[i][2] * y[i][2] + y[i][3] * y[i][3]); }
        const float rstd = rsqrtf(wave_sum(sq) * (1.f / DM) + 1e-5f);
        const float* mh = p.mod + (size_t)(hl * 9 + bm) * 6144;
#pragma unroll
        for (int i = 0; i < 4; ++i) {
            const int col = i * 256 + lane * 4;
            const f32x4 g = *(const f32x4*)(lng + col), bb = *(const f32x4*)(lnb + col);
            const f32x4 xl = y[i] * rstd * g + bb;
            *(f32x4*)(op + col) = xl;
            if (write_h) {
                const f32x4 sh = *(const f32x4*)(mh + sh_idx * 1024 + col), sc = *(const f32x4*)(mh + sc_idx * 1024 + col);
                u32x2 hv; hv.x = cvt_pk_bf16(xl[0] * (1.f + sc[0]) + sh[0], xl[1] * (1.f + sc[1]) + sh[1]); hv.y = cvt_pk_bf16(xl[2] * (1.f + sc[2]) + sh[2], xl[3] * (1.f + sc[3]) + sh[3]);
                *(u32x2*)(fp + col) = hv;
            }
        }
    }
}

struct SubTile { int alo, ahi, ar0, jm, seg_len; bool valid; };
__device__ __forceinline__ SubTile ffn_subtile(int layer, int b, int sidx) {
    SubTile t; const int cnt = layer == 0 ? 20 : 17; t.valid = sidx < cnt;
    int jm = sidx, seg_off = CTXL, seg_len = SEQ;
    if (layer == 0) { if (sidx < 3) { seg_off = 0; seg_len = CTXL; } else jm = sidx - 3; }
    t.jm = jm; t.seg_len = seg_len; t.alo = b * TOK + seg_off; t.ahi = t.valid ? t.alo + seg_len : t.alo; t.ar0 = t.alo + 126 * jm - 1;
    return t;
}
__device__ __forceinline__ SubTile sel_subtile(const SubTile& a, const SubTile& b, int ai) {
    SubTile t; t.alo = ai ? b.alo : a.alo; t.ahi = ai ? b.ahi : a.ahi; t.ar0 = ai ? b.ar0 : a.ar0; t.jm = ai ? b.jm : a.jm; t.seg_len = ai ? b.seg_len : a.seg_len; t.valid = ai ? b.valid : a.valid; return t;
}
__device__ __forceinline__ void epi_ffn1(const Params& p, const float* Ct, int layer, const SubTile& t, int hc0) {
    if (!t.valid) return;
    const int tid = threadIdx.x; bf16_t* hid = p.big + BE_HID;
    const float* cw = p.conv_w + (size_t)layer * 3 * DFF; const float* cb = p.conv_b + (size_t)layer * DFF;
    const int c0 = (tid & 7) * 8, hc = hc0 + c0;
    float w0[8], w1[8], w2[8], bs[8];
    load8(cw + hc, w0); load8(cw + DFF + hc, w1); load8(cw + 2 * DFF + hc, w2); load8(cb + hc, bs);
#pragma unroll
    for (int i = 0; i < 2; ++i) {
        const int r = (tid + NTHREADS * i) >> 3;
        const int srow = 126 * t.jm - 1 + r;
        if (r < 1 || r > 126 || srow >= t.seg_len) continue;
        float gm[8], g0[8], gp[8], u[8], hv[8];
        load8(Ct + (r - 1) * LDC + c0, gm); load8(Ct + r * LDC + c0, g0); load8(Ct + (r + 1) * LDC + c0, gp); load8(Ct + r * LDC + 64 + c0, u);
#pragma unroll
        for (int e = 0; e < 8; ++e) { const float cv = gm[e] * w0[e] + g0[e] * w1[e] + gp[e] * w2[e] + bs[e]; hv[e] = cv / (1.f + __expf(-cv)) * u[e]; }
        store8(hid + (size_t)(t.alo + srow) * DFF + hc, hv);
    }
}
__device__ __forceinline__ void phase_ffn1(const Params& p, char* smem, int layer) {
    float* Ct = (float*)smem;
    const bf16_t* wgu = p.wt_gate + (size_t)layer * 5632 * 1024;
    const int npb = layer == 0 ? 10 : 9;
    NOTAIL_DECODE(8 * npb * 22);
    for (int it0 = blockIdx.x; it0 < total_; it0 += G_) {
        TAIL_ITEM(it0, it, half)
        int mt2, nt2; const int nfirst = 8 * npb * 16;
        if (it < nfirst) { mt2 = it >> 4; nt2 = it & 15; } else { const int r = it - nfirst; mt2 = r / 6; nt2 = 16 + r % 6; }
        const int b = mt2 / npb, J = mt2 % npb;
        const SubTile t0 = ffn_subtile(layer, b, 2 * J), t1 = ffn_subtile(layer, b, 2 * J + 1);
        if (half < 0) {
            f32x4 acc[8][4];
            gemm_core(smem, p.h, DM, t0.ar0, t0.alo, t0.ahi, t1.ar0, t1.alo, t1.ahi, wgu + (size_t)nt2 * 256 * DM, DM, DM, (const bf16_t*)p.bar, acc);
#pragma unroll 1
            for (int ai = 0; ai < 2; ++ai) {
                acc_to_ct(Ct, acc, ai);
                const SubTile t = sel_subtile(t0, t1, ai);
                epi_ffn1(p, Ct, layer, t, (nt2 * 2) * 64);
                epi_ffn1(p, Ct + CT_FLOATS, layer, t, (nt2 * 2 + 1) * 64);
            }
        } else {
            const int nt = nt2 * 2 + half;
            f32x4 acc[4][4];
            gemm_core_h(smem, p.h, DM, t0.ar0, t0.alo, t0.ahi, t1.ar0, t1.alo, t1.ahi, wgu + (size_t)nt * 128 * DM, DM, DM, (const bf16_t*)p.bar, acc);
#pragma unroll 1
            for (int ai = 0; ai < 2; ++ai) { acc_to_ct_h(Ct, acc, ai); epi_ffn1(p, Ct, layer, sel_subtile(t0, t1, ai), nt * 64); }
        }
    }
}

__device__ __forceinline__ void epi_proj1(const Params& p, const float* Ct, int mt, int nt) {
    const int tid = threadIdx.x;
    bf16_t* qd = p.big + BE_QD; bf16_t* kd = p.big + BE_KD; bf16_t* vt_d = p.big + BE_VT_D;
    extern __shared__ __attribute__((aligned(16))) char smem_dyn_[]; const float* lds_tab_ = (const float*)(smem_dyn_ + SMEM_BYTES);
    const float* rope64 = lds_tab_ + MISC_ROPE64;
    const int b = mt / 18, jt = mt % 18; const bool is_ctx = jt < 2; const int row0 = mt * 128, tok0 = jt * 128;
    if (nt >= 16) {
        const int hh = nt - 16;
#pragma unroll 1
        for (int i = 0; i < 4; ++i) { const int id = tid + NTHREADS * i, c = id & 127, rc = id >> 7;
            store_col8(Ct, c, rc, vt_d + (size_t)((b * 8 + hh) * 128 + c) * TOK + tok0 + rc * 8, nullptr); }
    } else {
        bf16_t* dst = nt < 8 ? qd : kd; const int dc = (nt & 7) * 128;
#pragma unroll 1
        for (int i = 0; i < 4; ++i) {
            const int id = tid + NTHREADS * i, r = id >> 4, c0 = (id & 15) * 8;
            const float* rowp = Ct + r * LDC; float v[8]; load8(rowp + c0, v);
            if (!is_ctx) rope8(rowp, c0, 64, tok0 + r - CTXL, rope64, v);
            store8(dst + (size_t)(row0 + r) * 1024 + dc + c0, v);
        }
    }
}
__device__ __forceinline__ void phase_proj1(const Params& p, char* smem) {
    float* Ct = (float*)smem;
    TAIL_DECODE(72 * 12);
    for (int it0 = blockIdx.x; it0 < total_; it0 += G_) {
        TAIL_ITEM(it0, it, half)
        int mt2, nt2;
        if (it < 72 * 8) { mt2 = it >> 3; nt2 = it & 7; } else { const int r = it - 72 * 8; mt2 = r >> 2; nt2 = 8 + (r & 3); }
        if ((mt2 % 9) == 0 && nt2 < 4) continue;
        if (half < 0) {
            f32x4 acc[8][4];
            gemm_core(smem, p.h, DM, mt2 * 256, 0, ROWS, mt2 * 256 + 128, 0, ROWS, p.wt_din + (size_t)nt2 * 256 * DM, DM, DM, (const bf16_t*)p.bar, acc);
#pragma unroll 1
            for (int ai = 0; ai < 2; ++ai) {
                acc_to_ct(Ct, acc, ai);
                epi_proj1(p, Ct, mt2 * 2 + ai, nt2 * 2);
                epi_proj1(p, Ct + CT_FLOATS, mt2 * 2 + ai, nt2 * 2 + 1);
            }
        } else {
            const int nt = nt2 * 2 + half;
            f32x4 acc[4][4];
            gemm_core_h(smem, p.h, DM, mt2 * 256, 0, ROWS, mt2 * 256 + 128, 0, ROWS, p.wt_din + (size_t)nt * 128 * DM, DM, DM, (const bf16_t*)p.bar, acc);
#pragma unroll 1
            for (int ai = 0; ai < 2; ++ai) { acc_to_ct_h(Ct, acc, ai); epi_proj1(p, Ct, mt2 * 2 + ai, nt); }
        }
    }
}

__device__ __forceinline__ void phase_attn1(const Params& p, char* smem) {
    const bf16_t* qd = p.big + BE_QD; const bf16_t* kd = p.big + BE_KD; const bf16_t* vt_d = p.big + BE_VT_D;
    const int lane = threadIdx.x & 63, w = threadIdx.x >> 6, fr = lane & 15, fq = lane >> 4, wq0 = w * 32;
    const float lam = p.misc[MISC_LAM];
    for (int it = blockIdx.x; it < 512; it += gridDim.x) {
        const int b = it >> 6, hh = (it >> 3) & 7, qbl = it & 7; const int qtok0 = CTXL + 256 * qbl, row0 = b * TOK + qtok0;
        const bf16_t* vt = vt_d + (size_t)((b * 8 + hh) * 128) * TOK;
        f32x4 o[8][2]; float m[2], l[2];
        flash_pass<64, 128, false>(smem, qd + (size_t)row0 * 1024 + hh * 128, 1024, kd + (size_t)b * TOK * 1024 + hh * 128, 1024, vt, CTXL, TOK, qtok0, 0.125f * LOG2E, o, m, l);
        {
            float inv[2]; inv[0] = 1.f / l[0]; inv[1] = 1.f / l[1];
            store_o<8>(p.o + (size_t)row0 * 1024 + hh * 128, 1024, o, inv);
        }
        flash_pass<64, 128, false>(smem, qd + (size_t)row0 * 1024 + hh * 128 + 64, 1024, kd + (size_t)b * TOK * 1024 + hh * 128 + 64, 1024, vt, CTXL, TOK, qtok0, 0.125f * LOG2E, o, m, l);
#pragma unroll
        for (int nq = 0; nq < 2; ++nq) {
            const float inv = lam / l[nq]; float ss = 0.f;
            const bf16_t* o1p = p.o + (size_t)(row0 + wq0 + nq * 16 + fr) * 1024 + hh * 128;
#pragma unroll
            for (int md = 0; md < 8; ++md) {
                const u32x2 o1 = *(const u32x2*)(o1p + md * 16 + fq * 4);
                o[md][nq][0] = bflo(o1.x) - o[md][nq][0] * inv; o[md][nq][1] = bfhi(o1.x) - o[md][nq][1] * inv;
                o[md][nq][2] = bflo(o1.y) - o[md][nq][2] * inv; o[md][nq][3] = bfhi(o1.y) - o[md][nq][3] * inv;
                ss += (o[md][nq][0] * o[md][nq][0] + o[md][nq][1] * o[md][nq][1]) + (o[md][nq][2] * o[md][nq][2] + o[md][nq][3] * o[md][nq][3]);
            }
            ss += __shfl_xor(ss, 16); ss += __shfl_xor(ss, 32);
            const float rstd = rsqrtf(ss * (1.f / 128.f) + 1e-6f) * (1.f - LAMBDA_INIT);
            bf16_t* op = p.o + (size_t)(row0 + wq0 + nq * 16 + fr) * 1024 + hh * 128;
#pragma unroll
            for (int md = 0; md < 8; ++md) {
                const f32x4 g = *(const f32x4*)(p.subln + md * 16 + fq * 4);
                u32x2 v; v.x = cvt_pk_bf16(o[md][nq][0] * rstd * g[0], o[md][nq][1] * rstd * g[1]); v.y = cvt_pk_bf16(o[md][nq][2] * rstd * g[2], o[md][nq][3] * rstd * g[3]);
                *(u32x2*)(op + md * 16 + fq * 4) = v;
            }
        }
    }
}

constexpr int N_PHASES = 17;
#ifndef ONLY_PHASE
#define ONLY_PHASE -1
#endif
#define PH_ON(k) (ONLY_PHASE < 0 || ONLY_PHASE == (k))
#ifndef DUP_MASK
#define DUP_MASK 0
#endif
#define RUN_PHASE(k, call) if constexpr (PH_ON(k)) { if (ph_lo <= (k) && (k) < ph_hi) { call; if ((k) + 1 < ph_hi) xcd_barrier(xb); } }
__global__ void __launch_bounds__(NTHREADS, 2) mega_fwd(Params p, int ph_lo, int ph_hi) {
    extern __shared__ __attribute__((aligned(16))) char smem[];
    __shared__ uint4 xb_words;
    if (threadIdx.x == 0) xb_words = make_uint4(0u, 0u, 0u, 0u);
    __syncthreads();
    const XcdBarrier xb = xcd_barrier_post(p.bar, (volatile LAS unsigned*)&xb_words);
    if (ph_lo < 0) cg::this_grid().sync();
    RUN_PHASE(0, phase_prologue(p, smem))
    { float* lt = (float*)(smem + SMEM_BYTES); for (int i = threadIdx.x; i < 3072; i += NTHREADS) lt[i] = p.misc[i]; __syncthreads(); }
    RUN_PHASE(1, phase_h0(p))
    RUN_PHASE(2, phase_proj0(p, smem))
    RUN_PHASE(3, phase_mla_up(p, smem))
    RUN_PHASE(4, phase_attn0(p, smem))
    RUN_PHASE(5, phase_gemm_plain(smem, (const bf16_t*)p.bar, p.o, 1024, p.wt_out0, 1024, 4, p.h, 1024, false))
    RUN_PHASE(6, phase_ln(p, p.x, p.ctx, 0, 2, p.ln1_g, p.ln1_b, p.out, p.xc, true, 0, 3, 4, true))
    RUN_PHASE(7, phase_ffn1(p, smem, 0))
    RUN_PHASE(8, phase_gemm_plain(smem, (const bf16_t*)p.bar, p.big + BE_HID, DFF, p.wt_down, DFF, 4, p.h, 1024, false))
    RUN_PHASE(9, phase_ln(p, p.out, p.xc, 0, 5, p.ln2_g, p.ln2_b, p.out, p.xc, true, 1, 0, 1, true))
    RUN_PHASE(10, phase_proj1(p, smem))
    RUN_PHASE(11, phase_attn1(p, smem))
    RUN_PHASE(12, phase_gemm_plain(smem, (const bf16_t*)p.bar, p.o, 1024, p.wt_dout, 1024, 4, p.h, 1024, true))
    RUN_PHASE(13, phase_ln(p, p.out, p.xc, 1, 2, p.ln1_g + DM, p.ln1_b + DM, p.out, p.xc, true, 1, 3, 4, false))
    RUN_PHASE(14, phase_ffn1(p, smem, 1))
    RUN_PHASE(15, phase_gemm_plain(smem, (const bf16_t*)p.bar, p.big + BE_HID, DFF, p.wt_down + (size_t)1024 * 2816, DFF, 4, p.h, 1024, true))
    RUN_PHASE(16, phase_ln(p, p.out, p.xc, 1, 5, p.ln2_g + DM, p.ln2_b + DM, p.out, p.xc, false, 1, 0, 1, false))
}

extern "C" void kernel_launch(void* const* d_in, const int* in_sizes, int n_in, void* d_out, int out_size, void* d_ws, size_t ws_size, hipStream_t stream) {
    static int grid = 0;
    if (grid == 0) {
        if (n_in != 29 || out_size != NBATCH * SEQ * DM || ws_size < WS_END) {
            fprintf(stderr, "kernel_launch: unexpected shapes (n_in %d, out %d, ws %zu, need %zu)\n", n_in, out_size, ws_size, (size_t)WS_END); grid = -1; return; }
        int dev = 0, cus = 0, per_cu = 0;
        hipGetDevice(&dev); hipDeviceGetAttribute(&cus, hipDeviceAttributeMultiprocessorCount, dev);
        if (hipFuncSetAttribute((const void*)mega_fwd, hipFuncAttributeMaxDynamicSharedMemorySize, SMEM_BYTES + SMEM_TABLES) != hipSuccess) { fprintf(stderr, "kernel_launch: hipFuncSetAttribute failed\n"); grid = -1; return; }
        if (hipOccupancyMaxActiveBlocksPerMultiprocessor(&per_cu, (const void*)mega_fwd, NTHREADS, SMEM_BYTES + SMEM_TABLES) != hipSuccess || per_cu < 1) { fprintf(stderr, "kernel_launch: occupancy query failed\n"); grid = -1; return; }
        if (per_cu > 1) per_cu = 1;
        grid = cus * per_cu;
        fprintf(stderr, "kernel_launch: grid %d (%d CUs x %d)\n", grid, cus, per_cu);
    }
    if (grid < 0) return;
    Params p{};
    const float* const* in = (const float* const*)d_in;
    p.x = in[0]; p.c = in[1]; p.ctx = in[2]; p.c_ctx = in[3]; p.w_mod = in[4]; p.b_mod = in[5]; p.ln1_g = in[6]; p.ln1_b = in[7]; p.ln2_g = in[8]; p.ln2_b = in[9];
    p.w_gate = in[10]; p.w_up = in[11]; p.conv_w = in[12]; p.conv_b = in[13]; p.w_down = in[14];
    p.ab_w_in = in[15]; p.q_norm = in[16]; p.w_qb = in[17]; p.kv_norm = in[18]; p.w_kvb = in[19]; p.sink = in[20]; p.ab_w_out = in[21];
    p.d_w_in = in[22]; p.lq1 = in[23]; p.lk1 = in[24]; p.lq2 = in[25]; p.lk2 = in[26]; p.subln = in[27]; p.d_w_out = in[28];
    p.out = (float*)d_out;
    char* ws = (char*)d_ws;
    p.wt_in0 = (bf16_t*)(ws + OFF_WT_IN0); p.wt_qb = (bf16_t*)(ws + OFF_WT_QB); p.wt_kvb = (bf16_t*)(ws + OFF_WT_KVB); p.wt_out0 = (bf16_t*)(ws + OFF_WT_OUT0);
    p.wt_din = (bf16_t*)(ws + OFF_WT_DIN); p.wt_dout = (bf16_t*)(ws + OFF_WT_DOUT); p.wt_gate = (bf16_t*)(ws + OFF_WT_GATE); p.wt_up = (bf16_t*)(ws + OFF_WT_UP);
    p.wt_down = (bf16_t*)(ws + OFF_WT_DOWN); p.mod = (float*)(ws + OFF_MOD); p.misc = (float*)(ws + OFF_MISC); p.bar = (unsigned*)(ws + OFF_BAR); p.xc = (float*)(ws + OFF_XC);
    p.h = (bf16_t*)(ws + OFF_H); p.o = (bf16_t*)(ws + OFF_O); p.big = (bf16_t*)(ws + OFF_BIG);
    if (hipMemsetAsync(ws + OFF_BAR, 0, 16384, stream) != hipSuccess) { fprintf(stderr, "kernel_launch: memset failed\n"); return; }
#if MULTI_LAUNCH
    for (int ph = 0; ph < N_PHASES; ++ph) hipLaunchKernelGGL(mega_fwd, dim3(grid), dim3(NTHREADS), SMEM_BYTES + SMEM_TABLES, stream, p, ph, ph + 1);
#else
    int lo = 0, hi = N_PHASES;
    void* args[] = {&p, &lo, &hi};
    hipError_t e = hipLaunchCooperativeKernel((const void*)mega_fwd, dim3(grid), dim3(NTHREADS), args, SMEM_BYTES + SMEM_TABLES, stream);
    if (e != hipSuccess) fprintf(stderr, "kernel_launch: cooperative launch failed: %s (grid %d)\n", hipGetErrorString(e), grid);
#if EXTRA_PHASE >= 0
    int lo2 = EXTRA_PHASE, hi2 = EXTRA_PHASE + 1;
    void* args2[] = {&p, &lo2, &hi2};
    (void)hipLaunchCooperativeKernel((const void*)mega_fwd, dim3(grid), dim3(NTHREADS), args2, SMEM_BYTES + SMEM_TABLES, stream);
#endif
#endif
}
```

```cpp
#include <hip/hip_runtime.h>
#include <hip/hip_cooperative_groups.h>
#include <cstdio>
#include <cstdint>
namespace cg = cooperative_groups;

#ifndef EXTRA_PHASE
#define EXTRA_PHASE -1
#endif
#ifndef EXTRA_SYNCS
#define EXTRA_SYNCS 0
#endif
#ifndef MULTI_LAUNCH
#define MULTI_LAUNCH 0
#endif

typedef unsigned short bf16_t;
typedef short bf16x8 __attribute__((ext_vector_type(8)));
typedef float f32x4 __attribute__((ext_vector_type(4)));
typedef unsigned u32x4 __attribute__((ext_vector_type(4)));
typedef unsigned u32x2 __attribute__((ext_vector_type(2)));

constexpr int NBATCH = 8, SEQ = 2048, CTXL = 256, TOK = 2304, ROWS = NBATCH * TOK, DM = 1024, DFF = 2816;
constexpr int NTHREADS = 512, NWAVES = 8;
constexpr int LDC = 132;
constexpr int CT_FLOATS = 128 * 132;
constexpr int SMEM_TABLES = 12288;
constexpr int SMEM_BYTES = 139264;
constexpr float ALPHA_RES = 1.41421356237f;
constexpr float LOG2E = 1.44269504089f;
constexpr float LAMBDA_INIT = 0.35550907f;

struct Params {
    const float *x, *c, *ctx, *c_ctx, *w_mod, *b_mod, *ln1_g, *ln1_b, *ln2_g, *ln2_b;
    const float *w_gate, *w_up, *conv_w, *conv_b, *w_down;
    const float *ab_w_in, *q_norm, *w_qb, *kv_norm, *w_kvb, *sink, *ab_w_out;
    const float *d_w_in, *lq1, *lk1, *lq2, *lk2, *subln, *d_w_out;
    float* out;
    bf16_t *wt_in0, *wt_qb, *wt_kvb, *wt_out0, *wt_din, *wt_dout, *wt_gate, *wt_up, *wt_down;
    float *mod, *misc, *xc;
    unsigned* bar;
    bf16_t *h, *o, *big;
};

constexpr size_t SZ_WT_IN0 = 1280ull * 1024 * 2, SZ_WT_QB = 768ull * 256 * 2, SZ_WT_KVB = 1024ull * 128 * 2, SZ_WT_SQ = 1024ull * 1024 * 2,
                 SZ_WT_DIN = 3072ull * 1024 * 2, SZ_WT_FF = 2ull * 2816 * 1024 * 2;
constexpr size_t OFF_WT_IN0 = 0, OFF_WT_QB = OFF_WT_IN0 + SZ_WT_IN0, OFF_WT_KVB = OFF_WT_QB + SZ_WT_QB, OFF_WT_OUT0 = OFF_WT_KVB + SZ_WT_KVB,
                 OFF_WT_DIN = OFF_WT_OUT0 + SZ_WT_SQ, OFF_WT_DOUT = OFF_WT_DIN + SZ_WT_DIN, OFF_WT_GATE = OFF_WT_DOUT + SZ_WT_SQ,
                 OFF_WT_UP = OFF_WT_GATE + SZ_WT_FF, OFF_WT_DOWN = OFF_WT_UP + SZ_WT_FF, OFF_MOD = OFF_WT_DOWN + SZ_WT_FF,
                 OFF_MISC = OFF_MOD + 2ull * 9 * 6144 * 4, OFF_BAR = OFF_MISC + 65536, OFF_XC = OFF_BAR + 16384, OFF_H = OFF_XC + 2048ull * 1024 * 4,
                 OFF_O = OFF_H + (size_t)ROWS * 1024 * 2, OFF_BIG = OFF_O + (size_t)ROWS * 1024 * 2;
constexpr size_t BE_PROJ0 = 0, BE_VT_SWA = BE_PROJ0 + (size_t)ROWS * 1024, BE_Q_MLA = BE_VT_SWA + 8ull * 2 * 64 * TOK,
                 BE_K_MLA = BE_Q_MLA + (size_t)ROWS * 768, BE_VT_MLA = BE_K_MLA + (size_t)ROWS * 768, BE_END0 = BE_VT_MLA + 8ull * 8 * 64 * TOK;
constexpr size_t BE_QD = 0, BE_KD = BE_QD + (size_t)ROWS * 1024, BE_VT_D = BE_KD + (size_t)ROWS * 1024, BE_END1 = BE_VT_D + 8ull * 8 * 128 * TOK;
constexpr size_t BE_HID = 0, BE_END2 = (size_t)ROWS * DFF;
constexpr size_t BIG_ELEMS = BE_END0 > BE_END1 ? (BE_END0 > BE_END2 ? BE_END0 : BE_END2) : (BE_END1 > BE_END2 ? BE_END1 : BE_END2);
constexpr size_t WS_END = OFF_BIG + BIG_ELEMS * 2;
constexpr int MISC_ROPE64 = 0, MISC_ROPE32 = 2048, MISC_LAM = 3072;

__device__ __forceinline__ unsigned cvt_pk_bf16(float lo, float hi) { unsigned r; asm("v_cvt_pk_bf16_f32 %0, %1, %2" : "=v"(r) : "v"(lo), "v"(hi)); return r; }
__device__ __forceinline__ float bf2f(unsigned short v) { return __uint_as_float((unsigned)v << 16); }
__device__ __forceinline__ float bflo(unsigned v) { return __uint_as_float(v << 16); }
__device__ __forceinline__ float bfhi(unsigned v) { return __uint_as_float(v & 0xffff0000u); }
__device__ __forceinline__ void store8(bf16_t* dst, const float (&v)[8]) {
    u32x4 w; w.x = cvt_pk_bf16(v[0], v[1]); w.y = cvt_pk_bf16(v[2], v[3]); w.z = cvt_pk_bf16(v[4], v[5]); w.w = cvt_pk_bf16(v[6], v[7]);
    *(u32x4*)dst = w;
}
__device__ __forceinline__ float wave_sum(float v) {
#pragma unroll
    for (int o = 1; o < 64; o <<= 1) v += __shfl_xor(v, o);
    return v;
}
__device__ __forceinline__ float fast_exp2(float x) { return __builtin_amdgcn_exp2f(x); }


#define XB_TMO      128
#define XB_XCNT(j)  (256  + 64 * (j))
#define XB_XSUB(j)  (1280 + 64 * (j))
#define XB_XGEN(j)  (2304 + 64 * (j))
#define XB_TOP      3328
#define XB_TOPGEN   3392
#define XCD_BAR_WORDS 3456
#define XB_SPIN_CAP (1u << 18)
#define LAS __attribute__((address_space(3)))
__device__ __forceinline__ unsigned xb_ld(unsigned* p)              { return __hip_atomic_load(p, __ATOMIC_RELAXED, __HIP_MEMORY_SCOPE_AGENT); }
__device__ __forceinline__ unsigned xb_add(unsigned* p, unsigned v) { return __hip_atomic_fetch_add(p, v, __ATOMIC_RELAXED, __HIP_MEMORY_SCOPE_AGENT); }
__device__ __forceinline__ unsigned xb_xcc_id() { return (unsigned)__builtin_amdgcn_s_getreg((3 << 11) | 20) & 0xFu; }
#define XB_SPIN(cond, bar) do { unsigned _sp = 0; while (cond) { __builtin_amdgcn_s_sleep(1); \
    if ((++_sp & 255u) == 0u) { if (xb_ld(&(bar)[XB_TMO])) break; if (_sp > XB_SPIN_CAP) { atomicAdd(&(bar)[XB_TMO], 1u); break; } } } } while (0)
struct XcdBarrier { unsigned* bar; unsigned x; volatile LAS unsigned* st; };
__device__ __forceinline__ XcdBarrier xcd_barrier_post(unsigned* bar, volatile LAS unsigned* st) {
    XcdBarrier b; b.bar = bar; b.x = xb_xcc_id(); b.st = st;
    if (threadIdx.x == 0) (void)xb_add(&bar[XB_XCNT(b.x)], 1u);
    return b;
}
__device__ __forceinline__ void xcd_barrier_complete(unsigned* bar, unsigned x, unsigned& nloc, unsigned& nx) {
    const unsigned G = gridDim.x * gridDim.y * gridDim.z;
    unsigned sum, cnt, mine, sp = 0u;
    for (;;) {
        sum = 0u; cnt = 0u; mine = 0u;
#pragma unroll
        for (unsigned j = 0; j < 16; ++j) { const unsigned c = xb_ld(&bar[XB_XCNT(j)]); sum += c; cnt += (c > 0u) ? 1u : 0u; mine = (j == x) ? c : mine; }
        if (sum == G) break;
        __builtin_amdgcn_s_sleep(1);
        if ((++sp & 255u) == 0u) { if (xb_ld(&bar[XB_TMO])) break; if (sp > XB_SPIN_CAP) { atomicAdd(&bar[XB_TMO], 1u); break; } }
    }
    nloc = mine > 0u ? mine : 1u; nx = cnt > 0u ? cnt : 1u;
}
__device__ __forceinline__ void xcd_barrier(const XcdBarrier& b) {
    asm volatile("s_waitcnt vmcnt(0)" ::: "memory");
    __syncthreads();
    if (threadIdx.x == 0) {
        unsigned* bar = b.bar;
        __builtin_amdgcn_s_waitcnt(0);
        unsigned nloc = b.st[0], nx = b.st[1];
        if (nloc == 0u) { xcd_barrier_complete(bar, b.x, nloc, nx); b.st[0] = nloc; b.st[1] = nx; }
        const unsigned old = xb_add(&bar[XB_XSUB(b.x)], 1u);
        const unsigned gen = old / nloc;
        if (old + 1u == (gen + 1u) * nloc) {
            __builtin_amdgcn_fence(__ATOMIC_RELEASE, "agent");
            asm volatile("s_waitcnt vmcnt(0)" ::: "memory");
            const unsigned og = xb_add(&bar[XB_TOP], 1u);
            const unsigned tg = og / nx;
            if (og + 1u == (tg + 1u) * nx) xb_add(&bar[XB_TOPGEN], 1u);
            else XB_SPIN(xb_ld(&bar[XB_TOPGEN]) == tg, bar);
            __builtin_amdgcn_fence(__ATOMIC_ACQUIRE, "agent");
            xb_add(&bar[XB_XGEN(b.x)], 1u);
            asm volatile("s_waitcnt vmcnt(0)" ::: "memory");
        } else {
            XB_SPIN(xb_ld(&bar[XB_XGEN(b.x)]) == gen, bar);
            __builtin_amdgcn_fence(__ATOMIC_ACQUIRE, "agent");
            asm volatile("s_waitcnt vmcnt(0)" ::: "memory");
        }
    }
    __syncthreads();
}

__device__ __forceinline__ void mod_item(const Params& p, char* smem, int it) {
    float* s_silu = (float*)smem;
    float* red = (float*)(smem + 9 * 1024 * 4);
    const int tid = threadIdx.x, lane = tid & 63, w = tid >> 6;
    const int layer = it / 96, col0 = (it % 96) * 64;
    for (int idx = tid; idx < 9 * 1024; idx += NTHREADS) {
        const int b = idx >> 10, k = idx & 1023;
        const float v = (b < 8) ? p.c[b * 1024 + k] : p.c_ctx[k];
        s_silu[idx] = v / (1.f + __expf(-v));
    }
    __syncthreads();
    float acc[9];
#pragma unroll
    for (int b = 0; b < 9; ++b) acc[b] = 0.f;
    const float* wp = p.w_mod + (size_t)layer * 1024 * 6144 + (size_t)(w * 128) * 6144 + col0 + lane;
    for (int kk = 0; kk < 128; kk += 8) {
        float wv[8];
#pragma unroll
        for (int u = 0; u < 8; ++u) wv[u] = wp[(size_t)(kk + u) * 6144];
#pragma unroll
        for (int b = 0; b < 9; ++b) {
            const f32x4 s0 = *(const f32x4*)(s_silu + b * 1024 + w * 128 + kk), s1 = *(const f32x4*)(s_silu + b * 1024 + w * 128 + kk + 4);
            acc[b] += s0[0] * wv[0] + s0[1] * wv[1] + s0[2] * wv[2] + s0[3] * wv[3] + s1[0] * wv[4] + s1[1] * wv[5] + s1[2] * wv[6] + s1[3] * wv[7];
        }
    }
#pragma unroll
    for (int b = 0; b < 9; ++b) red[(w * 9 + b) * 64 + lane] = acc[b];
    __syncthreads();
    for (int idx = tid; idx < 9 * 64; idx += NTHREADS) {
        const int b = idx >> 6, l = idx & 63;
        float s = 0.f;
#pragma unroll
        for (int ww = 0; ww < NWAVES; ++ww) s += red[(ww * 9 + b) * 64 + l];
        p.mod[(size_t)(layer * 9 + b) * 6144 + col0 + l] = s + p.b_mod[layer * 6144 + col0 + l];
    }
}

__device__ __forceinline__ void table_item(const Params& p) {
    const int tid = threadIdx.x;
    for (int idx = tid; idx < 64 * 16; idx += NTHREADS) {
        const int pi = idx >> 4, i = idx & 15;
        const float freq = exp2f(-(float)i * (13.28771238f / 16.f));
        const float ang = (float)pi * freq;
        p.misc[MISC_ROPE64 + idx * 2] = __cosf(ang); p.misc[MISC_ROPE64 + idx * 2 + 1] = __sinf(ang);
    }
    for (int idx = tid; idx < 64 * 8; idx += NTHREADS) {
        const int pi = idx >> 3, i = idx & 7;
        const float freq = exp2f(-(float)i * (13.28771238f / 8.f));
        const float ang = (float)pi * freq;
        p.misc[MISC_ROPE32 + idx * 2] = __cosf(ang); p.misc[MISC_ROPE32 + idx * 2 + 1] = __sinf(ang);
    }
    if (tid == 0) {
        float s1 = 0.f, s2 = 0.f;
        for (int i = 0; i < 64; ++i) { s1 += p.lq1[i] * p.lk1[i]; s2 += p.lq2[i] * p.lk2[i]; }
        p.misc[MISC_LAM] = __expf(s1) - __expf(s2) + LAMBDA_INIT;
    }
}

__device__ __forceinline__ void transpose_tile(char* smem, const float* src, int K, int Nsrc, bf16_t* dst, int ntn, int mode, const float* gain, int tile, int dmul = 1, int dadd = 0) {
    float* t = (float*)smem;
    const int tid = threadIdx.x, tx = tid & 63, ty = tid >> 6;
    const int kt = tile / ntn, nt = tile % ntn;
    const int np = nt * 64 + tx;
    int n = np;
    if (mode == 1) { n = np < 896 ? np : (np < 1024 ? 928 + (np - 896) : (np < 1152 ? 1056 + (np - 1024) : (np < 1184 ? 896 + (np - 1152) : -1))); }
    else if (mode == 2) { if (np < 512) n = (np >> 6) * 96 + (np & 63); else { const int m = np - 512; n = (m >> 5) * 96 + 64 + (m & 31); } }
#pragma unroll
    for (int i = 0; i < 8; ++i) {
        const int kl = ty + 8 * i, k = kt * 64 + kl;
        float v = 0.f;
        if (n >= 0) { v = src[(size_t)k * Nsrc + n]; if (gain) v *= gain[k]; }
        t[kl * 65 + tx] = v;
    }
    __syncthreads();
#pragma unroll
    for (int i = 0; i < 8; ++i) {
        const int nl = ty + 8 * i;
        dst[(size_t)((nt * dmul + dadd) * 64 + nl) * K + kt * 64 + tx] = (bf16_t)(cvt_pk_bf16(t[tx * 65 + nl], 0.f) & 0xffffu);
    }
}

__device__ __forceinline__ void transpose_item(const Params& p, char* smem, int r) {
    constexpr int T0 = 16 * 20, T1 = 4 * 12, T2 = 2 * 16, T3 = 16 * 16, T4 = 16 * 48, T5 = 16 * 16, TF = 16 * 44;
    if (r < T0) { transpose_tile(smem, p.ab_w_in, 1024, 1184, p.wt_in0, 20, 1, nullptr, r); return; } r -= T0;
    if (r < T1) { transpose_tile(smem, p.w_qb, 256, 768, p.wt_qb, 12, 2, p.q_norm, r); return; } r -= T1;
    if (r < T2) { transpose_tile(smem, p.w_kvb, 128, 1024, p.wt_kvb, 16, 0, p.kv_norm, r); return; } r -= T2;
    if (r < T3) { transpose_tile(smem, p.ab_w_out, 1024, 1024, p.wt_out0, 16, 0, nullptr, r); return; } r -= T3;
    if (r < T4) { transpose_tile(smem, p.d_w_in, 1024, 3072, p.wt_din, 48, 0, nullptr, r); return; } r -= T4;
    if (r < T5) { transpose_tile(smem, p.d_w_out, 1024, 1024, p.wt_dout, 16, 0, nullptr, r); return; } r -= T5;
    {
        const int j = r / TF, rr = r % TF;
        if (j < 2) transpose_tile(smem, p.w_gate + (size_t)j * 1024 * 2816, 1024, 2816, p.wt_gate + (size_t)j * 5632 * 1024, 44, 0, nullptr, rr, 2, 0);
        else if (j < 4) transpose_tile(smem, p.w_up + (size_t)(j - 2) * 1024 * 2816, 1024, 2816, p.wt_gate + (size_t)(j - 2) * 5632 * 1024, 44, 0, nullptr, rr, 2, 1);
        else transpose_tile(smem, p.w_down + (size_t)(j - 4) * 2816 * 1024, 2816, 1024, p.wt_down + (size_t)(j - 4) * 1024 * 2816, 16, 0, nullptr, rr);
    }
}
constexpr int N_TR_TILES = 16 * 20 + 4 * 12 + 2 * 16 + 16 * 16 + 16 * 48 + 16 * 16 + 6 * 16 * 44;

__device__ __forceinline__ void phase_prologue(const Params& p, char* smem) {
    const int total = 193 + N_TR_TILES;
    for (int it = blockIdx.x; it < total; it += gridDim.x) {
        if (it < 192) mod_item(p, smem, it);
        else if (it == 192) table_item(p);
        else transpose_item(p, smem, it - 193);
        __syncthreads();
    }
}

__device__ __forceinline__ void phase_h0(const Params& p) {
    const int lane = threadIdx.x & 63, w = threadIdx.x >> 6;
    for (int row = blockIdx.x * NWAVES + w; row < ROWS; row += gridDim.x * NWAVES) {
        const int b = row / TOK, j = row % TOK; const bool isc = j < CTXL;
        const float* rp = isc ? p.ctx + ((size_t)b * CTXL + j) * DM : p.x + ((size_t)b * SEQ + (j - CTXL)) * DM;
        const float* md = p.mod + (size_t)(0 * 9 + (isc ? 8 : b)) * 6144;
#pragma unroll 1
        for (int i = 0; i < 4; ++i) {
            const int col = i * 256 + lane * 4;
            const f32x4 v = *(const f32x4*)(rp + col), sh = *(const f32x4*)(md + col), sc = *(const f32x4*)(md + 1024 + col);
            u32x2 o; o.x = cvt_pk_bf16(v[0] * (1.f + sc[0]) + sh[0], v[1] * (1.f + sc[1]) + sh[1]); o.y = cvt_pk_bf16(v[2] * (1.f + sc[2]) + sh[2], v[3] * (1.f + sc[3]) + sh[3]);
            *(u32x2*)(p.h + (size_t)row * DM + col) = o;
        }
    }
}

__device__ __forceinline__ void gemm_core(char* smem, const bf16_t* __restrict__ A, int lda, int ar0a, int aloa, int ahia, int ar0b, int alob, int ahib,
                                          const bf16_t* __restrict__ B, int ldb, int K, const bf16_t* zero16, f32x4 (&acc)[8][4]) {
    constexpr int ROWB = 128, OPA = 256 * ROWB, STG = 2 * OPA, NI = 4;
    static_assert(2 * STG <= SMEM_BYTES, "LDS");
    const int tid = threadIdx.x, lane = tid & 63, w = __builtin_amdgcn_readfirstlane(tid >> 6), wr = w >> 2, wc = w & 3, fr = lane & 15, fq = lane >> 4;
    const int rl = lane >> 3, kcs = (lane & 7) ^ rl;
#pragma unroll
    for (int m = 0; m < 8; ++m)
#pragma unroll
        for (int n = 0; n < 4; ++n) acc[m][n] = (f32x4){0.f, 0.f, 0.f, 0.f};
    const int nk = K / 64;
    int aoff[NI], boff[NI];
#pragma unroll
    for (int i = 0; i < NI; ++i) {
        const int row = (w * NI + i) * 8 + rl, hf = row >> 7, gr = (hf ? ar0b : ar0a) + (row & 127);
        const bool ok = hf ? (gr >= alob && gr < ahib) : (gr >= aloa && gr < ahia);
        aoff[i] = ok ? gr * lda + kcs * 8 : -1;
        boff[i] = row * ldb + kcs * 8;
    }
    __syncthreads();
#pragma unroll
    for (int i = 0; i < NI; ++i) {
        __builtin_amdgcn_global_load_lds((const unsigned*)(aoff[i] >= 0 ? A + aoff[i] : zero16), (LAS unsigned*)(smem + (w * NI + i) * 1024), 16, 0, 0);
        __builtin_amdgcn_global_load_lds((const unsigned*)(B + boff[i]), (LAS unsigned*)(smem + OPA + (w * NI + i) * 1024), 16, 0, 0);
    }
    asm volatile("s_waitcnt vmcnt(0)" ::: "memory"); __syncthreads();
    const int sw = fr & 7;
    for (int kt = 0; kt < nk; ++kt) {
        const bool pf = kt + 1 < nk; const int nst = ((kt + 1) & 1) * STG;
        const char* base = smem + (kt & 1) * STG;
        bf16x8 bfr[2][4];
#pragma unroll
        for (int n = 0; n < 4; ++n) bfr[0][n] = *(const bf16x8*)(base + OPA + (wc * 64 + n * 16 + fr) * ROWB + ((fq ^ sw) * 16));
#pragma unroll
        for (int ks = 0; ks < 2; ++ks) {
            const int co = (((ks * 4 + fq) ^ sw) * 16);
#pragma unroll
            for (int m = 0; m < 8; ++m) {
                const bf16x8 af = *(const bf16x8*)(base + (wr * 128 + m * 16 + fr) * ROWB + co);
#pragma unroll
                for (int n = 0; n < 4; ++n) acc[m][n] = __builtin_amdgcn_mfma_f32_16x16x32_bf16(af, bfr[ks][n], acc[m][n], 0, 0, 0);
                if (ks == 0 && m == 5) {
#pragma unroll
                    for (int n = 0; n < 4; ++n) bfr[1][n] = *(const bf16x8*)(base + OPA + (wc * 64 + n * 16 + fr) * ROWB + (((4 + fq) ^ sw) * 16));
                }
                if (ks == 0 && pf) {
                    const int i = m & 3, lo_ = nst + (w * NI + i) * 1024;
                    if (m < 4) __builtin_amdgcn_global_load_lds((const unsigned*)(aoff[i] >= 0 ? A + aoff[i] + (kt + 1) * 64 : zero16), (LAS unsigned*)(smem + lo_), 16, 0, 0);
                    else __builtin_amdgcn_global_load_lds((const unsigned*)(B + boff[i] + (kt + 1) * 64), (LAS unsigned*)(smem + lo_ + OPA), 16, 0, 0);
                }
            }
        }
        asm volatile("s_waitcnt vmcnt(0)" ::: "memory");
        __syncthreads();
    }
}

__device__ __forceinline__ void acc_to_ct(float* Ct0, const f32x4 (&acc)[8][4], int ai) {
    const int tid = threadIdx.x, lane = tid & 63, w = tid >> 6, wr = w >> 2, wc = w & 3, fr = lane & 15, fq = lane >> 4;
    __syncthreads();
    if (wr == ai) {
        float* Ct = Ct0 + (wc >> 1) * CT_FLOATS + (wc & 1) * 64 + fr;
#pragma unroll
        for (int m = 0; m < 8; ++m)
#pragma unroll
            for (int n = 0; n < 4; ++n)
#pragma unroll
                for (int j = 0; j < 4; ++j) Ct[(m * 16 + fq * 4 + j) * LDC + n * 16] = acc[m][n][j];
    }
    __syncthreads();
}

__device__ __forceinline__ void gemm_core_h(char* smem, const bf16_t* __restrict__ A, int lda, int ar0a, int aloa, int ahia, int ar0b, int alob, int ahib,
                                            const bf16_t* __restrict__ B, int ldb, int K, const bf16_t* zero16, f32x4 (&acc)[4][4]) {
    constexpr int ROWB = 128, OPA = 256 * ROWB, STG = 2 * OPA, NI = 4, NIB = 2;
    const int tid = threadIdx.x, lane = tid & 63, w = __builtin_amdgcn_readfirstlane(tid >> 6), wr = w >> 1, wc = w & 1, fr = lane & 15, fq = lane >> 4;
    const int rl = lane >> 3, kcs = (lane & 7) ^ rl;
#pragma unroll
    for (int m = 0; m < 4; ++m)
#pragma unroll
        for (int n = 0; n < 4; ++n) acc[m][n] = (f32x4){0.f, 0.f, 0.f, 0.f};
    const int nk = K / 64;
    int aoff[NI], boff[NIB];
#pragma unroll
    for (int i = 0; i < NI; ++i) {
        const int row = (w * NI + i) * 8 + rl, hf = row >> 7, gr = (hf ? ar0b : ar0a) + (row & 127);
        const bool ok = hf ? (gr >= alob && gr < ahib) : (gr >= aloa && gr < ahia);
        aoff[i] = ok ? gr * lda + kcs * 8 : -1;
    }
#pragma unroll
    for (int i = 0; i < NIB; ++i) boff[i] = ((w * NIB + i) * 8 + rl) * ldb + kcs * 8;
    __syncthreads();
#pragma unroll
    for (int i = 0; i < NI; ++i) __builtin_amdgcn_global_load_lds((const unsigned*)(aoff[i] >= 0 ? A + aoff[i] : zero16), (LAS unsigned*)(smem + (w * NI + i) * 1024), 16, 0, 0);
#pragma unroll
    for (int i = 0; i < NIB; ++i) __builtin_amdgcn_global_load_lds((const unsigned*)(B + boff[i]), (LAS unsigned*)(smem + OPA + (w * NIB + i) * 1024), 16, 0, 0);
    asm volatile("s_waitcnt vmcnt(0)" ::: "memory"); __syncthreads();
    const int sw = fr & 7;
    for (int kt = 0; kt < nk; ++kt) {
        const bool pf = kt + 1 < nk; const int nst = ((kt + 1) & 1) * STG;
        const char* base = smem + (kt & 1) * STG;
#pragma unroll
        for (int ks = 0; ks < 2; ++ks) {
            const int co = (((ks * 4 + fq) ^ sw) * 16);
            bf16x8 bfr[4];
#pragma unroll
            for (int n = 0; n < 4; ++n) bfr[n] = *(const bf16x8*)(base + OPA + (wc * 64 + n * 16 + fr) * ROWB + co);
#pragma unroll
            for (int m = 0; m < 4; ++m) {
                const bf16x8 af = *(const bf16x8*)(base + (wr * 64 + m * 16 + fr) * ROWB + co);
#pragma unroll
                for (int n = 0; n < 4; ++n) acc[m][n] = __builtin_amdgcn_mfma_f32_16x16x32_bf16(af, bfr[n], acc[m][n], 0, 0, 0);
                if (pf) {
                    if (ks == 0) __builtin_amdgcn_global_load_lds((const unsigned*)(aoff[m] >= 0 ? A + aoff[m] + (kt + 1) * 64 : zero16), (LAS unsigned*)(smem + nst + (w * NI + m) * 1024), 16, 0, 0);
                    else if (m < NIB) __builtin_amdgcn_global_load_lds((const unsigned*)(B + boff[m & 1] + (kt + 1) * 64), (LAS unsigned*)(smem + nst + OPA + (w * NIB + (m & 1)) * 1024), 16, 0, 0);
                }
            }
        }
        asm volatile("s_waitcnt vmcnt(0)" ::: "memory");
        __syncthreads();
    }
}
__device__ __forceinline__ void acc_to_ct_h(float* Ct0, const f32x4 (&acc)[4][4], int ai) {
    const int tid = threadIdx.x, lane = tid & 63, w = tid >> 6, wr = w >> 1, wc = w & 1, fr = lane & 15, fq = lane >> 4;
    __syncthreads();
    if ((wr >> 1) == ai) {
        float* Ct = Ct0 + ((wr & 1) * 64 + fq * 4) * LDC + wc * 64 + fr;
#pragma unroll
        for (int m = 0; m < 4; ++m)
#pragma unroll
            for (int n = 0; n < 4; ++n)
#pragma unroll
                for (int j = 0; j < 4; ++j) Ct[(m * 16 + j) * LDC + n * 16] = acc[m][n][j];
    }
    __syncthreads();
}
#define TAIL_DECODE(T) const int G_ = gridDim.x, Tfull_ = ((T) / G_) * G_, total_ = Tfull_ + 2 * ((T) - Tfull_)
#define NOTAIL_DECODE(T) const int G_ = gridDim.x, Tfull_ = (T), total_ = (T)
#define TAIL_ITEM(it, tile, half) int tile, half; if ((it) < Tfull_) { tile = (it); half = -1; } else { const int r_ = (it) - Tfull_; tile = Tfull_ + (r_ >> 1); half = r_ & 1; }

__device__ __forceinline__ void load8(const float* src, float (&v)[8]) {
    const f32x4 a = *(const f32x4*)src, b = *(const f32x4*)(src + 4);
    v[0] = a[0]; v[1] = a[1]; v[2] = a[2]; v[3] = a[3]; v[4] = b[0]; v[5] = b[1]; v[6] = b[2]; v[7] = b[3];
}

__device__ __forceinline__ void rope8(const float* rowp, int c0, int hd, int pos, const float* tab, float (&v)[8]) {
    const int qs = hd >> 2, ch = c0 & (hd - 1), qd = ch / qs, i0 = ch & (qs - 1);
    const int idx = (qd < 2) ? (pos >> 6) : (pos & 63);
    const int pc = (qd & 1) ? c0 - qs : c0 + qs; const float sgn = (qd & 1) ? 1.f : -1.f;
    const float* t = tab + (idx * qs + i0) * 2;
#pragma unroll
    for (int e = 0; e < 8; ++e) v[e] = v[e] * t[2 * e] + sgn * rowp[pc + e] * t[2 * e + 1];
}

__device__ __forceinline__ void store_col8(const float* Ct, int c, int rc, bf16_t* dst, const float* rs) {
    float v[8];
#pragma unroll
    for (int e = 0; e < 8; ++e) { v[e] = Ct[(rc * 8 + e) * LDC + c]; if (rs) v[e] *= rs[rc * 8 + e]; }
    store8(dst, v);
}

__device__ __forceinline__ void epi_proj0(const Params& p, const float* Ct, int mt, int nt) {
    const int tid = threadIdx.x;
    bf16_t* proj0 = p.big + BE_PROJ0; bf16_t* vt_swa = p.big + BE_VT_SWA; bf16_t* k_mla = p.big + BE_K_MLA;
    extern __shared__ __attribute__((aligned(16))) char smem_dyn_[]; const float* lds_tab_ = (const float*)(smem_dyn_ + SMEM_BYTES);
    const float* rope64 = lds_tab_ + MISC_ROPE64; const float* rope32 = lds_tab_ + MISC_ROPE32;
    const int b = mt / 18, jt = mt % 18; const bool is_ctx = jt < 2; const int row0 = mt * 128, tok0 = jt * 128;
    if (nt == 8) {
#pragma unroll 1
        for (int i = 0; i < 4; ++i) { const int id = tid + NTHREADS * i, c = id & 127, rc = id >> 7;
            store_col8(Ct, c, rc, vt_swa + (size_t)((b * 2 + (c >> 6)) * 64 + (c & 63)) * TOK + tok0 + rc * 8, nullptr); }
    } else {
#pragma unroll 1
        for (int i = 0; i < 4; ++i) {
            const int id = tid + NTHREADS * i, r = id >> 4, c0 = (id & 15) * 8;
            const float* rowp = Ct + r * LDC; float v[8]; load8(rowp + c0, v);
            const int grow = row0 + r, pos = tok0 + r - CTXL;
            if (nt <= 1 || nt == 6) { store8(proj0 + (size_t)grow * 1024 + nt * 128 + c0, v); }
            else if (nt <= 5 || nt == 7) { if (!is_ctx) rope8(rowp, c0, 64, pos, rope64, v); store8(proj0 + (size_t)grow * 1024 + (nt == 7 ? 896 : nt * 128) + c0, v); }
            else if (c0 < 32) { if (!is_ctx) rope8(rowp, c0, 32, pos, rope32, v);
#pragma unroll
                for (int hh = 0; hh < 8; ++hh) store8(k_mla + (size_t)grow * 768 + hh * 96 + 64 + c0, v); }
        }
    }
}
__device__ __forceinline__ void phase_proj0(const Params& p, char* smem) {
    float* Ct = (float*)smem;
    TAIL_DECODE(72 * 5);
    for (int it = blockIdx.x; it < total_; it += G_) {
        TAIL_ITEM(it, tile, half)
        const int mt2 = tile / 5, nt2 = tile % 5;
        if (half < 0) {
            f32x4 acc[8][4];
            gemm_core(smem, p.h, DM, mt2 * 256, 0, ROWS, mt2 * 256 + 128, 0, ROWS, p.wt_in0 + (size_t)nt2 * 256 * DM, DM, DM, (const bf16_t*)p.bar, acc);
#pragma unroll 1
            for (int ai = 0; ai < 2; ++ai) {
                acc_to_ct(Ct, acc, ai);
                epi_proj0(p, Ct, mt2 * 2 + ai, nt2 * 2);
                epi_proj0(p, Ct + CT_FLOATS, mt2 * 2 + ai, nt2 * 2 + 1);
            }
        } else {
            const int nt = nt2 * 2 + half;
            f32x4 acc[4][4];
            gemm_core_h(smem, p.h, DM, mt2 * 256, 0, ROWS, mt2 * 256 + 128, 0, ROWS, p.wt_in0 + (size_t)nt * 128 * DM, DM, DM, (const bf16_t*)p.bar, acc);
#pragma unroll 1
            for (int ai = 0; ai < 2; ++ai) { acc_to_ct_h(Ct, acc, ai); epi_proj0(p, Ct, mt2 * 2 + ai, nt); }
        }
    }
}

__device__ __forceinline__ void row_rstd(const bf16_t* A, int lda, int row0, int K, float* rs) {
    const int tid = threadIdx.x;
    if (tid < 256) {
        const int r = tid >> 1, hf = tid & 1; const int n = K / 2;
        const bf16_t* ap = A + (size_t)(row0 + r) * lda + hf * n; float ss = 0.f;
        for (int k = 0; k < n; k += 8) { const u32x4 v = *(const u32x4*)(ap + k);
            ss += bflo(v.x) * bflo(v.x) + bfhi(v.x) * bfhi(v.x) + bflo(v.y) * bflo(v.y) + bfhi(v.y) * bfhi(v.y) + bflo(v.z) * bflo(v.z) + bfhi(v.z) * bfhi(v.z) + bflo(v.w) * bflo(v.w) + bfhi(v.w) * bfhi(v.w); }
        ss += __shfl_xor(ss, 1);
        if (hf == 0) rs[r] = rsqrtf(ss / (float)K + 1e-6f);
    }
    __syncthreads();
}
__device__ __forceinline__ void epi_mla_q(const Params& p, const float* Ct, const float* rs, int mt, int nt) {
    extern __shared__ __attribute__((aligned(16))) char smem_dyn_[]; const float* lds_tab_ = (const float*)(smem_dyn_ + SMEM_BYTES);
    const int tid = threadIdx.x; bf16_t* q_mla = p.big + BE_Q_MLA; const float* rope32 = lds_tab_ + MISC_ROPE32;
    const int jt = mt % 18; const bool is_ctx = jt < 2; const int row0 = mt * 128, tok0 = jt * 128;
#pragma unroll 1
    for (int i = 0; i < 4; ++i) {
        const int id = tid + NTHREADS * i, r = id >> 4, c0 = (id & 15) * 8;
        const float* rowp = Ct + r * LDC; float v[8]; load8(rowp + c0, v);
        const int grow = row0 + r, pos = tok0 + r - CTXL; const float sc = rs[r];
        int dcol;
        if (nt < 4) { const int cg = nt * 128 + c0; dcol = (cg >> 6) * 96 + (cg & 63); }
        else { const int cg = (nt - 4) * 128 + c0; dcol = (cg >> 5) * 96 + 64 + (cg & 31); if (!is_ctx) rope8(rowp, c0, 32, pos, rope32, v); }
#pragma unroll
        for (int e = 0; e < 8; ++e) v[e] *= sc;
        store8(q_mla + (size_t)grow * 768 + dcol, v);
    }
}
__device__ __forceinline__ void epi_mla_kv(const Params& p, const float* Ct, const float* rs, int mt, int hh) {
    const int tid = threadIdx.x; bf16_t* k_mla = p.big + BE_K_MLA; bf16_t* vt_mla = p.big + BE_VT_MLA;
    const int b = mt / 18, jt = mt % 18; const int row0 = mt * 128, tok0 = jt * 128;
#pragma unroll 1
    for (int i = 0; i < 2; ++i) {
        const int id = tid + NTHREADS * i, r = id >> 3, c0 = (id & 7) * 8;
        float v[8]; load8(Ct + r * LDC + c0, v); const float sc = rs[r];
#pragma unroll
        for (int e = 0; e < 8; ++e) v[e] *= sc;
        store8(k_mla + (size_t)(row0 + r) * 768 + hh * 96 + c0, v);
    }
#pragma unroll 1
    for (int i = 0; i < 2; ++i) { const int id = tid + NTHREADS * i, c = 64 + (id & 63), rc = id >> 6;
        store_col8(Ct, c, rc, vt_mla + (size_t)((b * 8 + hh) * 64 + (c - 64)) * TOK + tok0 + rc * 8, rs); }
}
__device__ __forceinline__ void phase_mla_up(const Params& p, char* smem) {
    float* Ct = (float*)smem; float* rs = (float*)(smem + 2 * CT_FLOATS * 4);
    bf16_t* proj0 = p.big + BE_PROJ0;
    for (int it = blockIdx.x; it < 72 * 7; it += gridDim.x) {
        const int mt2 = it / 7, nt2 = it % 7;
        f32x4 acc[8][4];
        if (nt2 < 3) gemm_core(smem, proj0, 1024, mt2 * 256, 0, ROWS, mt2 * 256 + 128, 0, ROWS, p.wt_qb + (size_t)nt2 * 256 * 256, 256, 256, (const bf16_t*)p.bar, acc);
        else gemm_core(smem, proj0 + 768, 1024, mt2 * 256, 0, ROWS, mt2 * 256 + 128, 0, ROWS, p.wt_kvb + (size_t)(nt2 - 3) * 256 * 128, 128, 128, (const bf16_t*)p.bar, acc);
#pragma unroll 1
        for (int ai = 0; ai < 2; ++ai) {
            acc_to_ct(Ct, acc, ai);
            const int mt = mt2 * 2 + ai;
            if (nt2 < 3) { row_rstd(proj0, 1024, mt * 128, 256, rs); epi_mla_q(p, Ct, rs, mt, nt2 * 2); epi_mla_q(p, Ct + CT_FLOATS, rs, mt, nt2 * 2 + 1); }
            else { row_rstd(proj0 + 768, 1024, mt * 128, 128, rs); epi_mla_kv(p, Ct, rs, mt, (nt2 - 3) * 2); epi_mla_kv(p, Ct + CT_FLOATS, rs, mt, (nt2 - 3) * 2 + 1); }
        }
    }
}

template <int DQK, int DV, bool WINDOWED>
__device__ __forceinline__ void flash_pass(char* smem, const bf16_t* __restrict__ Qp, int ldq, const bf16_t* __restrict__ Kp, int ldk,
                                           const bf16_t* __restrict__ Vtp, int seg2s, int seg2e, int q_tok0, float sc2,
                                           f32x4 (&o)[DV / 16][2], float (&mrun)[2], float (&lrun)[2]) {
    constexpr int KROW = DQK * 2, VROW = 128, KB = 64 * KROW, VB = DV * VROW, STG = KB + VB;
    constexpr int KCPR = DQK / 8, NKI = KCPR, NVI = DV / 8, KCPT = (NKI + 7) / 8, VCPT = NVI / 8, NKS = DQK / 32, NMD = DV / 16;
    static_assert(2 * STG <= SMEM_BYTES, "LDS");
    const int tid = threadIdx.x, lane = tid & 63, w = tid >> 6, fr = lane & 15, fq = lane >> 4, wq0 = w * 32;
    bf16x8 qf[2][NKS];
#pragma unroll
    for (int nq = 0; nq < 2; ++nq)
#pragma unroll
        for (int ks = 0; ks < NKS; ++ks) qf[nq][ks] = *(const bf16x8*)(Qp + (size_t)(wq0 + nq * 16 + fr) * ldq + ks * 32 + fq * 8);
#pragma unroll
    for (int md = 0; md < NMD; ++md) { o[md][0] = (f32x4){0.f, 0.f, 0.f, 0.f}; o[md][1] = (f32x4){0.f, 0.f, 0.f, 0.f}; }
    float mref[2]; mref[0] = mref[1] = -1e30f; lrun[0] = lrun[1] = 0.f;
    const float thr = 8.0f / sc2;
    const int nt = 4 + (seg2e > seg2s ? (seg2e - seg2s) / 64 : 0);
    const int wu = __builtin_amdgcn_readfirstlane(w);
    int koffg[KCPT], voffg[VCPT];
#pragma unroll
    for (int i = 0; i < KCPT; ++i) { const int idx = (wu + 8 * i) * 64 + lane, rho = (idx / KCPR) & 63, cp = idx % KCPR;
        const int key = 32 * (rho >> 5) + 8 * ((rho >> 2) & 3) + 4 * ((rho >> 4) & 1) + (rho & 3);
        const int kcs = (DQK == 64) ? (cp ^ (rho & 7)) : ((cp & ~3) | ((cp & 3) ^ ((4 - ((rho >> 2) & 3)) & 3)));
        koffg[i] = key * ldk + kcs * 8; }
#pragma unroll
    for (int i = 0; i < VCPT; ++i) { const int idx = (wu + 8 * i) * 64 + lane, r = idx >> 3, cp = idx & 7; voffg[i] = r * TOK + ((cp ^ (r & 7)) * 8); }
    __syncthreads();
#define FDMA(t, st) do { const int key0_ = (t) < 4 ? (t) * 64 : seg2s + ((t) - 4) * 64; const bf16_t* kg_ = Kp + (size_t)key0_ * ldk; const bf16_t* vg_ = Vtp + key0_; \
        _Pragma("unroll") for (int i = 0; i < KCPT; ++i) if (wu + 8 * i < NKI) __builtin_amdgcn_global_load_lds((const unsigned*)(kg_ + koffg[i]), (LAS unsigned*)(smem + (st) * STG + (wu + 8 * i) * 1024), 16, 0, 0); \
        _Pragma("unroll") for (int i = 0; i < VCPT; ++i) __builtin_amdgcn_global_load_lds((const unsigned*)(vg_ + voffg[i]), (LAS unsigned*)(smem + (st) * STG + KB + (wu + 8 * i) * 1024), 16, 0, 0); } while (0)
    FDMA(0, 0);
    asm volatile("s_waitcnt vmcnt(0)" ::: "memory"); __syncthreads();
    const int ksw = (DQK == 64) ? (fr & 7) : ((4 - ((fr >> 2) & 3)) & 3);
    for (int t = 0; t < nt; ++t) {
        if (t + 1 < nt) FDMA(t + 1, (t + 1) & 1);
        const char* kb = smem + (t & 1) * STG; const char* vb = kb + KB;
        const int key0 = t < 4 ? t * 64 : seg2s + (t - 4) * 64;
        f32x4 s[4][2];
#pragma unroll
        for (int mk = 0; mk < 4; ++mk) { s[mk][0] = (f32x4){0.f, 0.f, 0.f, 0.f}; s[mk][1] = (f32x4){0.f, 0.f, 0.f, 0.f}; }
#pragma unroll
        for (int ks = 0; ks < NKS; ++ks) {
            const int co = (DQK == 64) ? (((ks * 4 + fq) ^ ksw) * 16) : ((ks * 4 + (fq ^ ksw)) * 16);
#pragma unroll
            for (int mk = 0; mk < 4; ++mk) {
                const bf16x8 kf = *(const bf16x8*)(kb + (mk * 16 + fr) * KROW + co);
                s[mk][0] = __builtin_amdgcn_mfma_f32_16x16x32_bf16(kf, qf[0][ks], s[mk][0], 0, 0, 0);
                s[mk][1] = __builtin_amdgcn_mfma_f32_16x16x32_bf16(kf, qf[1][ks], s[mk][1], 0, 0, 0);
            }
        }
        __builtin_amdgcn_sched_barrier(0);
        bf16x8 pf[2][2];
#pragma unroll
        for (int nq = 0; nq < 2; ++nq) {
            if (WINDOWED && key0 >= CTXL) {
                const int qpos = q_tok0 - CTXL + wq0 + nq * 16 + fr;
#pragma unroll
                for (int mk = 0; mk < 4; ++mk)
#pragma unroll
                    for (int j = 0; j < 4; ++j) { const int kpos = key0 - CTXL + 32 * (mk >> 1) + 8 * fq + 4 * (mk & 1) + j; const int d = qpos - kpos; if (d > 128 || d < -128) s[mk][nq][j] = -1e30f; }
            }
            float mx = fmaxf(fmaxf(s[0][nq][0], s[0][nq][1]), fmaxf(s[0][nq][2], s[0][nq][3]));
#pragma unroll
            for (int mk = 1; mk < 4; ++mk) mx = fmaxf(fmaxf(mx, fmaxf(s[mk][nq][0], s[mk][nq][1])), fmaxf(s[mk][nq][2], s[mk][nq][3]));
            mx = fmaxf(mx, __shfl_xor(mx, 16)); mx = fmaxf(mx, __shfl_xor(mx, 32));
            const bool need = mx > mref[nq] + thr;
            if (__any(need)) {
                const float mnew = need ? mx : mref[nq];
                const float alpha = fast_exp2((mref[nq] - mnew) * sc2);
                mref[nq] = mnew; lrun[nq] *= alpha;
#pragma unroll
                for (int md = 0; md < NMD; ++md) o[md][nq] = o[md][nq] * alpha;
            }
            const float nm = -mref[nq] * sc2;
            float ls = 0.f;
#pragma unroll
            for (int mk = 0; mk < 4; ++mk)
#pragma unroll
                for (int j = 0; j < 4; ++j) { const float pv = fast_exp2(fmaf(s[mk][nq][j], sc2, nm)); s[mk][nq][j] = pv; ls += pv; }
            lrun[nq] += ls;
#pragma unroll
            for (int kk = 0; kk < 2; ++kk) {
                u32x4 pk; pk.x = cvt_pk_bf16(s[2 * kk][nq][0], s[2 * kk][nq][1]); pk.y = cvt_pk_bf16(s[2 * kk][nq][2], s[2 * kk][nq][3]);
                pk.z = cvt_pk_bf16(s[2 * kk + 1][nq][0], s[2 * kk + 1][nq][1]); pk.w = cvt_pk_bf16(s[2 * kk + 1][nq][2], s[2 * kk + 1][nq][3]);
                pf[nq][kk] = __builtin_bit_cast(bf16x8, pk);
            }
        }
        __builtin_amdgcn_sched_barrier(0);
#pragma unroll
        for (int kk = 0; kk < 2; ++kk) {
            const int co = (((kk * 4 + fq) ^ (fr & 7)) * 16);
#pragma unroll
            for (int md = 0; md < NMD; ++md) {
                const bf16x8 vf = *(const bf16x8*)(vb + (md * 16 + fr) * VROW + co);
                o[md][0] = __builtin_amdgcn_mfma_f32_16x16x32_bf16(vf, pf[0][kk], o[md][0], 0, 0, 0);
                o[md][1] = __builtin_amdgcn_mfma_f32_16x16x32_bf16(vf, pf[1][kk], o[md][1], 0, 0, 0);
            }
        }
        asm volatile("s_waitcnt vmcnt(0)" ::: "memory");
        __syncthreads();
    }
#undef FDMA
#pragma unroll
    for (int nq = 0; nq < 2; ++nq) { float l = lrun[nq]; l += __shfl_xor(l, 16); l += __shfl_xor(l, 32); lrun[nq] = l; mrun[nq] = mref[nq] * sc2; }
}

template <int NMD>
__device__ __forceinline__ void store_o(bf16_t* Op, int ldo, const f32x4 (&o)[NMD][2], const float (&inv)[2]) {
    const int lane = threadIdx.x & 63, w = threadIdx.x >> 6, fr = lane & 15, fq = lane >> 4, wq0 = w * 32;
#pragma unroll
    for (int nq = 0; nq < 2; ++nq)
#pragma unroll
        for (int md = 0; md < NMD; ++md) {
            u32x2 v; v.x = cvt_pk_bf16(o[md][nq][0] * inv[nq], o[md][nq][1] * inv[nq]); v.y = cvt_pk_bf16(o[md][nq][2] * inv[nq], o[md][nq][3] * inv[nq]);
            *(u32x2*)(Op + (size_t)(wq0 + nq * 16 + fr) * ldo + md * 16 + fq * 4) = v;
        }
}

__device__ __forceinline__ void phase_attn0(const Params& p, char* smem) {
    const bf16_t* proj0 = p.big + BE_PROJ0; const bf16_t* vt_swa = p.big + BE_VT_SWA; const bf16_t* q_mla = p.big + BE_Q_MLA;
    const bf16_t* k_mla = p.big + BE_K_MLA; const bf16_t* vt_mla = p.big + BE_VT_MLA;
    for (int it = blockIdx.x; it < 1152; it += gridDim.x) {
        int kind, b, hh, qbl; bool lat;
        if (it < 1024) { lat = true; kind = it >> 9; const int r = it & 511; b = r >> 6; hh = (r >> 3) & 7; qbl = r & 7; }
        else { lat = false; const int r = it - 1024; kind = r >> 6; b = (r >> 3) & 7; hh = r & 7; qbl = 0; }
        const int qtok0 = lat ? CTXL + 256 * qbl : 0, row0 = b * TOK + qtok0;
        f32x4 o[4][2]; float m[2], l[2], inv[2];
        if (kind == 0) {
            flash_pass<96, 64, false>(smem, q_mla + (size_t)row0 * 768 + hh * 96, 768, k_mla + (size_t)b * TOK * 768 + hh * 96, 768,
                               vt_mla + (size_t)((b * 8 + hh) * 64) * TOK, CTXL, lat ? TOK : CTXL, qtok0, 0.10206207262f * LOG2E, o, m, l);
            inv[0] = 1.f / l[0]; inv[1] = 1.f / l[1];
            store_o<4>(p.o + (size_t)row0 * 1024 + hh * 64, 1024, o, inv);
        } else {
            int s2s = CTXL, s2e = CTXL;
            if (lat) { const int lo = 256 * qbl - 128, hi = 256 * qbl + 384; s2s = CTXL + (lo > 0 ? lo : 0); s2e = CTXL + (hi < SEQ ? hi : SEQ); }
            flash_pass<64, 64, true>(smem, proj0 + (size_t)row0 * 1024 + 256 + hh * 64, 1024, proj0 + (size_t)b * TOK * 1024 + 896 + (hh >> 2) * 64, 1024,
                               vt_swa + (size_t)((b * 2 + (hh >> 2)) * 64) * TOK, s2s, s2e, qtok0, 0.125f * LOG2E, o, m, l);
            const float sk = p.sink[hh] * LOG2E;
            inv[0] = 1.f / (l[0] + fast_exp2(sk - m[0])); inv[1] = 1.f / (l[1] + fast_exp2(sk - m[1]));
            store_o<4>(p.o + (size_t)row0 * 1024 + 512 + hh * 64, 1024, o, inv);
        }
    }
}

__device__ __forceinline__ void epi_plain(const float* Ct, bf16_t* out, int ldo, int mt, int nt) {
    const int tid = threadIdx.x;
#pragma unroll 1
    for (int i = 0; i < 4; ++i) {
        const int id = tid + NTHREADS * i, r = id >> 4, c0 = (id & 15) * 8;
        float v[8]; load8(Ct + r * LDC + c0, v);
        store8(out + (size_t)(mt * 128 + r) * ldo + nt * 128 + c0, v);
    }
}
__device__ __forceinline__ void phase_gemm_plain(char* smem, const bf16_t* zero16, const bf16_t* A, int lda, const bf16_t* Wt, int K, int ntn2, bf16_t* out, int ldo, bool lat_only) {
    float* Ct = (float*)smem;
    const int nmt2 = lat_only ? 64 : 72;
    TAIL_DECODE(nmt2 * ntn2);
    for (int it = blockIdx.x; it < total_; it += G_) {
        TAIL_ITEM(it, tile, half)
        int mt2 = tile / ntn2; const int nt2 = tile % ntn2;
        if (lat_only) mt2 = (mt2 >> 3) * 9 + 1 + (mt2 & 7);
        if (half < 0) {
            f32x4 acc[8][4];
            gemm_core(smem, A, lda, mt2 * 256, 0, ROWS, mt2 * 256 + 128, 0, ROWS, Wt + (size_t)nt2 * 256 * K, K, K, zero16, acc);
#pragma unroll 1
            for (int ai = 0; ai < 2; ++ai) {
                acc_to_ct(Ct, acc, ai);
                epi_plain(Ct, out, ldo, mt2 * 2 + ai, nt2 * 2);
                epi_plain(Ct + CT_FLOATS, out, ldo, mt2 * 2 + ai, nt2 * 2 + 1);
            }
        } else {
            const int nt = nt2 * 2 + half;
            f32x4 acc[4][4];
            gemm_core_h(smem, A, lda, mt2 * 256, 0, ROWS, mt2 * 256 + 128, 0, ROWS, Wt + (size_t)nt * 128 * K, K, K, zero16, acc);
#pragma unroll 1
            for (int ai = 0; ai < 2; ++ai) { acc_to_ct_h(Ct, acc, ai); epi_plain(Ct, out, ldo, mt2 * 2 + ai, nt); }
        }
    }
}

__device__ __forceinline__ void phase_ln(const Params& p, const float* res_lat, const float* res_ctx, int layer, int gate_idx, const float* lng, const float* lnb,
                                         float* out_lat, float* out_ctx, bool write_h, int hl, int sh_idx, int sc_idx, bool inc_ctx) {
    const int lane = threadIdx.x & 63, w = threadIdx.x >> 6;
    for (int row = blockIdx.x * NWAVES + w; row < ROWS; row += gridDim.x * NWAVES) {
        const int b = row / TOK, j = row % TOK; const bool isc = j < CTXL;
        if (isc && !inc_ctx) continue;
        const size_t ro = isc ? ((size_t)b * CTXL + j) * DM : ((size_t)b * SEQ + (j - CTXL)) * DM;
        const float* rp = (isc ? res_ctx : res_lat) + ro; float* op = (isc ? out_ctx : out_lat) + ro;
        const int bm = isc ? 8 : b;
        const float* gate = p.mod + (size_t)(layer * 9 + bm) * 6144 + gate_idx * 1024;
        bf16_t* fp = p.h + (size_t)row * DM;
        f32x4 y[4]; float sum = 0.f;
#pragma unroll
        for (int i = 0; i < 4; ++i) {
            const int col = i * 256 + lane * 4;
            const f32x4 r = *(const f32x4*)(rp + col), gt = *(const f32x4*)(gate + col); const u32x2 f = *(const u32x2*)(fp + col);
            y[i][0] = ALPHA_RES * r[0] + gt[0] * bflo(f.x); y[i][1] = ALPHA_RES * r[1] + gt[1] * bfhi(f.x);
            y[i][2] = ALPHA_RES * r[2] + gt[2] * bflo(f.y); y[i][3] = ALPHA_RES * r[3] + gt[3] * bfhi(f.y);
            sum += (y[i][0] + y[i][1]) + (y[i][2] + y[i][3]);
        }
        const float mean = wave_sum(sum) * (1.f / DM); float sq = 0.f;
#pragma unroll
        for (int i = 0; i < 4; ++i) { y[i] = y[i] - mean; sq += (y[i][0] * y[i][0] + y[i][1] * y[i][1]) + (y[i][2] * y[i][2] + y[i][3] * y[i][3]); }
        const float rstd = rsqrtf(wave_sum(sq) * (1.f / DM) + 1e-5f);
        const float* mh = p.mod + (size_t)(hl * 9 + bm) * 6144;
#pragma unroll
        for (int i = 0; i < 4; ++i) {
            const int col = i * 256 + lane * 4;
            const f32x4 g = *(const f32x4*)(lng + col), bb = *(const f32x4*)(lnb + col);
            const f32x4 xl = y[i] * rstd * g + bb;
            *(f32x4*)(op + col) = xl;
            if (write_h) {
                const f32x4 sh = *(const f32x4*)(mh + sh_idx * 1024 + col), sc = *(const f32x4*)(mh + sc_idx * 1024 + col);
                u32x2 hv; hv.x = cvt_pk_bf16(xl[0] * (1.f + sc[0]) + sh[0], xl[1] * (1.f + sc[1]) + sh[1]); hv.y = cvt_pk_bf16(xl[2] * (1.f + sc[2]) + sh[2], xl[3] * (1.f + sc[3]) + sh[3]);
                *(u32x2*)(fp + col) = hv;
            }
        }
    }
}

struct SubTile { int alo, ahi, ar0, jm, seg_len; bool valid; };
__device__ __forceinline__ SubTile ffn_subtile(int layer, int b, int sidx) {
    SubTile t; const int cnt = layer == 0 ? 20 : 17; t.valid = sidx < cnt;
    int jm = sidx, seg_off = CTXL, seg_len = SEQ;
    if (layer == 0) { if (sidx < 3) { seg_off = 0; seg_len = CTXL; } else jm = sidx - 3; }
    t.jm = jm; t.seg_len = seg_len; t.alo = b * TOK + seg_off; t.ahi = t.valid ? t.alo + seg_len : t.alo; t.ar0 = t.alo + 126 * jm - 1;
    return t;
}
__device__ __forceinline__ SubTile sel_subtile(const SubTile& a, const SubTile& b, int ai) {
    SubTile t; t.alo = ai ? b.alo : a.alo; t.ahi = ai ? b.ahi : a.ahi; t.ar0 = ai ? b.ar0 : a.ar0; t.jm = ai ? b.jm : a.jm; t.seg_len = ai ? b.seg_len : a.seg_len; t.valid = ai ? b.valid : a.valid; return t;
}
__device__ __forceinline__ void epi_ffn1(const Params& p, const float* Ct, int layer, const SubTile& t, int hc0) {
    if (!t.valid) return;
    const int tid = threadIdx.x; bf16_t* hid = p.big + BE_HID;
    const float* cw = p.conv_w + (size_t)layer * 3 * DFF; const float* cb = p.conv_b + (size_t)layer * DFF;
    const int c0 = (tid & 7) * 8, hc = hc0 + c0;
    float w0[8], w1[8], w2[8], bs[8];
    load8(cw + hc, w0); load8(cw + DFF + hc, w1); load8(cw + 2 * DFF + hc, w2); load8(cb + hc, bs);
#pragma unroll
    for (int i = 0; i < 2; ++i) {
        const int r = (tid + NTHREADS * i) >> 3;
        const int srow = 126 * t.jm - 1 + r;
        if (r < 1 || r > 126 || srow >= t.seg_len) continue;
        float gm[8], g0[8], gp[8], u[8], hv[8];
        load8(Ct + (r - 1) * LDC + c0, gm); load8(Ct + r * LDC + c0, g0); load8(Ct + (r + 1) * LDC + c0, gp); load8(Ct + r * LDC + 64 + c0, u);
#pragma unroll
        for (int e = 0; e < 8; ++e) { const float cv = gm[e] * w0[e] + g0[e] * w1[e] + gp[e] * w2[e] + bs[e]; hv[e] = cv / (1.f + __expf(-cv)) * u[e]; }
        store8(hid + (size_t)(t.alo + srow) * DFF + hc, hv);
    }
}
__device__ __forceinline__ void phase_ffn1(const Params& p, char* smem, int layer) {
    float* Ct = (float*)smem;
    const bf16_t* wgu = p.wt_gate + (size_t)layer * 5632 * 1024;
    const int npb = layer == 0 ? 10 : 9;
    NOTAIL_DECODE(8 * npb * 22);
    for (int it0 = blockIdx.x; it0 < total_; it0 += G_) {
        TAIL_ITEM(it0, it, half)
        int mt2, nt2; const int nfirst = 8 * npb * 16;
        if (it < nfirst) { mt2 = it >> 4; nt2 = it & 15; } else { const int r = it - nfirst; mt2 = r / 6; nt2 = 16 + r % 6; }
        const int b = mt2 / npb, J = mt2 % npb;
        const SubTile t0 = ffn_subtile(layer, b, 2 * J), t1 = ffn_subtile(layer, b, 2 * J + 1);
        if (half < 0) {
            f32x4 acc[8][4];
            gemm_core(smem, p.h, DM, t0.ar0, t0.alo, t0.ahi, t1.ar0, t1.alo, t1.ahi, wgu + (size_t)nt2 * 256 * DM, DM, DM, (const bf16_t*)p.bar, acc);
#pragma unroll 1
            for (int ai = 0; ai < 2; ++ai) {
                acc_to_ct(Ct, acc, ai);
                const SubTile t = sel_subtile(t0, t1, ai);
                epi_ffn1(p, Ct, layer, t, (nt2 * 2) * 64);
                epi_ffn1(p, Ct + CT_FLOATS, layer, t, (nt2 * 2 + 1) * 64);
            }
        } else {
            const int nt = nt2 * 2 + half;
            f32x4 acc[4][4];
            gemm_core_h(smem, p.h, DM, t0.ar0, t0.alo, t0.ahi, t1.ar0, t1.alo, t1.ahi, wgu + (size_t)nt * 128 * DM, DM, DM, (const bf16_t*)p.bar, acc);
#pragma unroll 1
            for (int ai = 0; ai < 2; ++ai) { acc_to_ct_h(Ct, acc, ai); epi_ffn1(p, Ct, layer, sel_subtile(t0, t1, ai), nt * 64); }
        }
    }
}

__device__ __forceinline__ void epi_proj1(const Params& p, const float* Ct, int mt, int nt) {
    const int tid = threadIdx.x;
    bf16_t* qd = p.big + BE_QD; bf16_t* kd = p.big + BE_KD; bf16_t* vt_d = p.big + BE_VT_D;
    extern __shared__ __attribute__((aligned(16))) char smem_dyn_[]; const float* lds_tab_ = (const float*)(smem_dyn_ + SMEM_BYTES);
    const float* rope64 = lds_tab_ + MISC_ROPE64;
    const int b = mt / 18, jt = mt % 18; const bool is_ctx = jt < 2; const int row0 = mt * 128, tok0 = jt * 128;
    if (nt >= 16) {
        const int hh = nt - 16;
#pragma unroll 1
        for (int i = 0; i < 4; ++i) { const int id = tid + NTHREADS * i, c = id & 127, rc = id >> 7;
            store_col8(Ct, c, rc, vt_d + (size_t)((b * 8 + hh) * 128 + c) * TOK + tok0 + rc * 8, nullptr); }
    } else {
        bf16_t* dst = nt < 8 ? qd : kd; const int dc = (nt & 7) * 128;
#pragma unroll 1
        for (int i = 0; i < 4; ++i) {
            const int id = tid + NTHREADS * i, r = id >> 4, c0 = (id & 15) * 8;
            const float* rowp = Ct + r * LDC; float v[8]; load8(rowp + c0, v);
            if (!is_ctx) rope8(rowp, c0, 64, tok0 + r - CTXL, rope64, v);
            store8(dst + (size_t)(row0 + r) * 1024 + dc + c0, v);
        }
    }
}
__device__ __forceinline__ void phase_proj1(const Params& p, char* smem) {
    float* Ct = (float*)smem;
    TAIL_DECODE(72 * 12);
    for (int it0 = blockIdx.x; it0 < total_; it0 += G_) {
        TAIL_ITEM(it0, it, half)
        int mt2, nt2;
        if (it < 72 * 8) { mt2 = it >> 3; nt2 = it & 7; } else { const int r = it - 72 * 8; mt2 = r >> 2; nt2 = 8 + (r & 3); }
        if ((mt2 % 9) == 0 && nt2 < 4) continue;
        if (half < 0) {
            f32x4 acc[8][4];
            gemm_core(smem, p.h, DM, mt2 * 256, 0, ROWS, mt2 * 256 + 128, 0, ROWS, p.wt_din + (size_t)nt2 * 256 * DM, DM, DM, (const bf16_t*)p.bar, acc);
#pragma unroll 1
            for (int ai = 0; ai < 2; ++ai) {
                acc_to_ct(Ct, acc, ai);
                epi_proj1(p, Ct, mt2 * 2 + ai, nt2 * 2);
                epi_proj1(p, Ct + CT_FLOATS, mt2 * 2 + ai, nt2 * 2 + 1);
            }
        } else {
            const int nt = nt2 * 2 + half;
            f32x4 acc[4][4];
            gemm_core_h(smem, p.h, DM, mt2 * 256, 0, ROWS, mt2 * 256 + 128, 0, ROWS, p.wt_din + (size_t)nt * 128 * DM, DM, DM, (const bf16_t*)p.bar, acc);
#pragma unroll 1
            for (int ai = 0; ai < 2; ++ai) { acc_to_ct_h(Ct, acc, ai); epi_proj1(p, Ct, mt2 * 2 + ai, nt); }
        }
    }
}

__device__ __forceinline__ void phase_attn1(const Params& p, char* smem) {
    const bf16_t* qd = p.big + BE_QD; const bf16_t* kd = p.big + BE_KD; const bf16_t* vt_d = p.big + BE_VT_D;
    const int lane = threadIdx.x & 63, w = threadIdx.x >> 6, fr = lane & 15, fq = lane >> 4, wq0 = w * 32;
    const float lam = p.misc[MISC_LAM];
    for (int it = blockIdx.x; it < 512; it += gridDim.x) {
        const int b = it >> 6, hh = (it >> 3) & 7, qbl = it & 7; const int qtok0 = CTXL + 256 * qbl, row0 = b * TOK + qtok0;
        const bf16_t* vt = vt_d + (size_t)((b * 8 + hh) * 128) * TOK;
        f32x4 o[8][2]; float m[2], l[2];
        flash_pass<64, 128, false>(smem, qd + (size_t)row0 * 1024 + hh * 128, 1024, kd + (size_t)b * TOK * 1024 + hh * 128, 1024, vt, CTXL, TOK, qtok0, 0.125f * LOG2E, o, m, l);
        {
            float inv[2]; inv[0] = 1.f / l[0]; inv[1] = 1.f / l[1];
            store_o<8>(p.o + (size_t)row0 * 1024 + hh * 128, 1024, o, inv);
        }
        flash_pass<64, 128, false>(smem, qd + (size_t)row0 * 1024 + hh * 128 + 64, 1024, kd + (size_t)b * TOK * 1024 + hh * 128 + 64, 1024, vt, CTXL, TOK, qtok0, 0.125f * LOG2E, o, m, l);
#pragma unroll
        for (int nq = 0; nq < 2; ++nq) {
            const float inv = lam / l[nq]; float ss = 0.f;
            const bf16_t* o1p = p.o + (size_t)(row0 + wq0 + nq * 16 + fr) * 1024 + hh * 128;
#pragma unroll
            for (int md = 0; md < 8; ++md) {
                const u32x2 o1 = *(const u32x2*)(o1p + md * 16 + fq * 4);
                o[md][nq][0] = bflo(o1.x) - o[md][nq][0] * inv; o[md][nq][1] = bfhi(o1.x) - o[md][nq][1] * inv;
                o[md][nq][2] = bflo(o1.y) - o[md][nq][2] * inv; o[md][nq][3] = bfhi(o1.y) - o[md][nq][3] * inv;
                ss += (o[md][nq][0] * o[md][nq][0] + o[md][nq][1] * o[md][nq][1]) + (o[md][nq][2] * o[md][nq][2] + o[md][nq][3] * o[md][nq][3]);
            }
            ss += __shfl_xor(ss, 16); ss += __shfl_xor(ss, 32);
            const float rstd = rsqrtf(ss * (1.f / 128.f) + 1e-6f) * (1.f - LAMBDA_INIT);
            bf16_t* op = p.o + (size_t)(row0 + wq0 + nq * 16 + fr) * 1024 + hh * 128;
#pragma unroll
            for (int md = 0; md < 8; ++md) {
                const f32x4 g = *(const f32x4*)(p.subln + md * 16 + fq * 4);
                u32x2 v; v.x = cvt_pk_bf16(o[md][nq][0] * rstd * g[0], o[md][nq][1] * rstd * g[1]); v.y = cvt_pk_bf16(o[md][nq][2] * rstd * g[2], o[md][nq][3] * rstd * g[3]);
                *(u32x2*)(op + md * 16 + fq * 4) = v;
            }
        }
    }
}

constexpr int N_PHASES = 17;
#ifndef ONLY_PHASE
#define ONLY_PHASE -1
#endif
#define PH_ON(k) (ONLY_PHASE < 0 || ONLY_PHASE == (k))
#ifndef DUP_MASK
#define DUP_MASK 0
#endif
#define RUN_PHASE(k, call) if constexpr (PH_ON(k)) { if (ph_lo <= (k) && (k) < ph_hi) { call; if ((k) + 1 < ph_hi) xcd_barrier(xb); } }
__global__ void __launch_bounds__(NTHREADS, 2) mega_fwd(Params p, int ph_lo, int ph_hi) {
    extern __shared__ __attribute__((aligned(16))) char smem[];
    __shared__ uint4 xb_words;
    if (threadIdx.x == 0) xb_words = make_uint4(0u, 0u, 0u, 0u);
    __syncthreads();
    const XcdBarrier xb = xcd_barrier_post(p.bar, (volatile LAS unsigned*)&xb_words);
    if (ph_lo < 0) cg::this_grid().sync();
    RUN_PHASE(0, phase_prologue(p, smem))
    { float* lt = (float*)(smem + SMEM_BYTES); for (int i = threadIdx.x; i < 3072; i += NTHREADS) lt[i] = p.misc[i]; __syncthreads(); }
    RUN_PHASE(1, phase_h0(p))
    RUN_PHASE(2, phase_proj0(p, smem))
    RUN_PHASE(3, phase_mla_up(p, smem))
    RUN_PHASE(4, phase_attn0(p, smem))
    RUN_PHASE(5, phase_gemm_plain(smem, (const bf16_t*)p.bar, p.o, 1024, p.wt_out0, 1024, 4, p.h, 1024, false))
    RUN_PHASE(6, phase_ln(p, p.x, p.ctx, 0, 2, p.ln1_g, p.ln1_b, p.out, p.xc, true, 0, 3, 4, true))
    RUN_PHASE(7, phase_ffn1(p, smem, 0))
    RUN_PHASE(8, phase_gemm_plain(smem, (const bf16_t*)p.bar, p.big + BE_HID, DFF, p.wt_down, DFF, 4, p.h, 1024, false))
    RUN_PHASE(9, phase_ln(p, p.out, p.xc, 0, 5, p.ln2_g, p.ln2_b, p.out, p.xc, true, 1, 0, 1, true))
    RUN_PHASE(10, phase_proj1(p, smem))
    RUN_PHASE(11, phase_attn1(p, smem))
    RUN_PHASE(12, phase_gemm_plain(smem, (const bf16_t*)p.bar, p.o, 1024, p.wt_dout, 1024, 4, p.h, 1024, true))
    RUN_PHASE(13, phase_ln(p, p.out, p.xc, 1, 2, p.ln1_g + DM, p.ln1_b + DM, p.out, p.xc, true, 1, 3, 4, false))
    RUN_PHASE(14, phase_ffn1(p, smem, 1))
    RUN_PHASE(15, phase_gemm_plain(smem, (const bf16_t*)p.bar, p.big + BE_HID, DFF, p.wt_down + (size_t)1024 * 2816, DFF, 4, p.h, 1024, true))
    RUN_PHASE(16, phase_ln(p, p.out, p.xc, 1, 5, p.ln2_g + DM, p.ln2_b + DM, p.out, p.xc, false, 1, 0, 1, false))
}

extern "C" void kernel_launch(void* const* d_in, const int* in_sizes, int n_in, void* d_out, int out_size, void* d_ws, size_t ws_size, hipStream_t stream) {
    static int grid = 0;
    if (grid == 0) {
        if (n_in != 29 || out_size != NBATCH * SEQ * DM || ws_size < WS_END) {
            fprintf(stderr, "kernel_launch: unexpected shapes (n_in %d, out %d, ws %zu, need %zu)\n", n_in, out_size, ws_size, (size_t)WS_END); grid = -1; return; }
        int dev = 0, cus = 0, per_cu = 0;
        hipGetDevice(&dev); hipDeviceGetAttribute(&cus, hipDeviceAttributeMultiprocessorCount, dev);
        if (hipFuncSetAttribute((const void*)mega_fwd, hipFuncAttributeMaxDynamicSharedMemorySize, SMEM_BYTES + SMEM_TABLES) != hipSuccess) { fprintf(stderr, "kernel_launch: hipFuncSetAttribute failed\n"); grid = -1; return; }
        if (hipOccupancyMaxActiveBlocksPerMultiprocessor(&per_cu, (const void*)mega_fwd, NTHREADS, SMEM_BYTES + SMEM_TABLES) != hipSuccess || per_cu < 1) { fprintf(stderr, "kernel_launch: occupancy query failed\n"); grid = -1; return; }
        if (per_cu > 1) per_cu = 1;
        grid = cus * per_cu;
        fprintf(stderr, "kernel_launch: grid %d (%d CUs x %d)\n", grid, cus, per_cu);
    }
    if (grid < 0) return;
    Params p{};
    const float* const* in = (const float* const*)d_in;
    p.x = in[0]; p.c = in[1]; p.ctx = in[2]; p.c_ctx = in[3]; p.w_mod = in[4]; p.b_mod = in[5]; p.ln1_g = in[6]; p.ln1_b = in[7]; p.ln2_g = in[8]; p.ln2_b = in[9];
    p.w_gate = in[10]; p.w_up = in[11]; p.conv_w = in[12]; p.conv_b = in[13]; p.w_down = in[14];
    p.ab_w_in = in[15]; p.q_norm = in[16]; p.w_qb = in[17]; p.kv_norm = in[18]; p.w_kvb = in[19]; p.sink = in[20]; p.ab_w_out = in[21];
    p.d_w_in = in[22]; p.lq1 = in[23]; p.lk1 = in[24]; p.lq2 = in[25]; p.lk2 = in[26]; p.subln = in[27]; p.d_w_out = in[28];
    p.out = (float*)d_out;
    char* ws = (char*)d_ws;
    p.wt_in0 = (bf16_t*)(ws + OFF_WT_IN0); p.wt_qb = (bf16_t*)(ws + OFF_WT_QB); p.wt_kvb = (bf16_t*)(ws + OFF_WT_KVB); p.wt_out0 = (bf16_t*)(ws + OFF_WT_OUT0);
    p.wt_din = (bf16_t*)(ws + OFF_WT_DIN); p.wt_dout = (bf16_t*)(ws + OFF_WT_DOUT); p.wt_gate = (bf16_t*)(ws + OFF_WT_GATE); p.wt_up = (bf16_t*)(ws + OFF_WT_UP);
    p.wt_down = (bf16_t*)(ws + OFF_WT_DOWN); p.mod = (float*)(ws + OFF_MOD); p.misc = (float*)(ws + OFF_MISC); p.bar = (unsigned*)(ws + OFF_BAR); p.xc = (float*)(ws + OFF_XC);
    p.h = (bf16_t*)(ws + OFF_H); p.o = (bf16_t*)(ws + OFF_O); p.big = (bf16_t*)(ws + OFF_BIG);
    if (hipMemsetAsync(ws + OFF_BAR, 0, 16384, stream) != hipSuccess) { fprintf(stderr, "kernel_launch: memset failed\n"); return; }
#if MULTI_LAUNCH
    for (int ph = 0; ph < N_PHASES; ++ph) hipLaunchKernelGGL(mega_fwd, dim3(grid), dim3(NTHREADS), SMEM_BYTES + SMEM_TABLES, stream, p, ph, ph + 1);
#else
    int lo = 0, hi = N_PHASES;
    void* args[] = {&p, &lo, &hi};
    hipError_t e = hipLaunchCooperativeKernel((const void*)mega_fwd, dim3(grid), dim3(NTHREADS), args, SMEM_BYTES + SMEM_TABLES, stream);
    if (e != hipSuccess) fprintf(stderr, "kernel_launch: cooperative launch failed: %s (grid %d)\n", hipGetErrorString(e), grid);
#if EXTRA_PHASE >= 0
    int lo2 = EXTRA_PHASE, hi2 = EXTRA_PHASE + 1;
    void* args2[] = {&p, &lo2, &hi2};
    (void)hipLaunchCooperativeKernel((const void*)mega_fwd, dim3(grid), dim3(NTHREADS), args2, SMEM_BYTES + SMEM_TABLES, stream);
#endif
#endif
}
```

```cpp
#include <hip/hip_runtime.h>
#include <hip/hip_cooperative_groups.h>
#include <cstdio>
#include <cstdint>
namespace cg = cooperative_groups;

#ifndef EXTRA_PHASE
#define EXTRA_PHASE -1
#endif
#ifndef EXTRA_SYNCS
#define EXTRA_SYNCS 0
#endif
#ifndef MULTI_LAUNCH
#define MULTI_LAUNCH 0
#endif

typedef unsigned short bf16_t;
typedef short bf16x8 __attribute__((ext_vector_type(8)));
typedef float f32x4 __attribute__((ext_vector_type(4)));
typedef unsigned u32x4 __attribute__((ext_vector_type(4)));
typedef unsigned u32x2 __attribute__((ext_vector_type(2)));

constexpr int NBATCH = 8, SEQ = 2048, CTXL = 256, TOK = 2304, ROWS = NBATCH * TOK, DM = 1024, DFF = 2816;
constexpr int NTHREADS = 512, NWAVES = 8;
constexpr int LDC = 132;
constexpr int CT_FLOATS = 128 * 132;
constexpr int SMEM_TABLES = 12288;
constexpr int SMEM_BYTES = 139264;
constexpr float ALPHA_RES = 1.41421356237f;
constexpr float LOG2E = 1.44269504089f;
constexpr float LAMBDA_INIT = 0.35550907f;

struct Params {
    const float *x, *c, *ctx, *c_ctx, *w_mod, *b_mod, *ln1_g, *ln1_b, *ln2_g, *ln2_b;
    const float *w_gate, *w_up, *conv_w, *conv_b, *w_down;
    const float *ab_w_in, *q_norm, *w_qb, *kv_norm, *w_kvb, *sink, *ab_w_out;
    const float *d_w_in, *lq1, *lk1, *lq2, *lk2, *subln, *d_w_out;
    float* out;
    bf16_t *wt_in0, *wt_qb, *wt_kvb, *wt_out0, *wt_din, *wt_dout, *wt_gate, *wt_up, *wt_down;
    float *mod, *misc, *xc;
    unsigned* bar;
    bf16_t *h, *o, *big;
};

constexpr size_t SZ_WT_IN0 = 1280ull * 1024 * 2, SZ_WT_QB = 768ull * 256 * 2, SZ_WT_KVB = 1024ull * 128 * 2, SZ_WT_SQ = 1024ull * 1024 * 2,
                 SZ_WT_DIN = 3072ull * 1024 * 2, SZ_WT_FF = 2ull * 2816 * 1024 * 2;
constexpr size_t OFF_WT_IN0 = 0, OFF_WT_QB = OFF_WT_IN0 + SZ_WT_IN0, OFF_WT_KVB = OFF_WT_QB + SZ_WT_QB, OFF_WT_OUT0 = OFF_WT_KVB + SZ_WT_KVB,
                 OFF_WT_DIN = OFF_WT_OUT0 + SZ_WT_SQ, OFF_WT_DOUT = OFF_WT_DIN + SZ_WT_DIN, OFF_WT_GATE = OFF_WT_DOUT + SZ_WT_SQ,
                 OFF_WT_UP = OFF_WT_GATE + SZ_WT_FF, OFF_WT_DOWN = OFF_WT_UP + SZ_WT_FF, OFF_MOD = OFF_WT_DOWN + SZ_WT_FF,
                 OFF_MISC = OFF_MOD + 2ull * 9 * 6144 * 4, OFF_BAR = OFF_MISC + 65536, OFF_XC = OFF_BAR + 16384, OFF_H = OFF_XC + 2048ull * 1024 * 4,
                 OFF_O = OFF_H + (size_t)ROWS * 1024 * 2, OFF_BIG = OFF_O + (size_t)ROWS * 1024 * 2;
constexpr size_t BE_PROJ0 = 0, BE_VT_SWA = BE_PROJ0 + (size_t)ROWS * 1024, BE_Q_MLA = BE_VT_SWA + 8ull * 2 * 64 * TOK,
                 BE_K_MLA = BE_Q_MLA + (size_t)ROWS * 768, BE_VT_MLA = BE_K_MLA + (size_t)ROWS * 768, BE_END0 = BE_VT_MLA + 8ull * 8 * 64 * TOK;
constexpr size_t BE_QD = 0, BE_KD = BE_QD + (size_t)ROWS * 1024, BE_VT_D = BE_KD + (size_t)ROWS * 1024, BE_END1 = BE_VT_D + 8ull * 8 * 128 * TOK;
constexpr size_t BE_HID = 0, BE_END2 = (size_t)ROWS * DFF;
constexpr size_t BIG_ELEMS = BE_END0 > BE_END1 ? (BE_END0 > BE_END2 ? BE_END0 : BE_END2) : (BE_END1 > BE_END2 ? BE_END1 : BE_END2);
constexpr size_t WS_END = OFF_BIG + BIG_ELEMS * 2;
constexpr int MISC_ROPE64 = 0, MISC_ROPE32 = 2048, MISC_LAM = 3072;

__device__ __forceinline__ unsigned cvt_pk_bf16(float lo, float hi) { unsigned r; asm("v_cvt_pk_bf16_f32 %0, %1, %2" : "=v"(r) : "v"(lo), "v"(hi)); return r; }
__device__ __forceinline__ float bf2f(unsigned short v) { return __uint_as_float((unsigned)v << 16); }
__device__ __forceinline__ float bflo(unsigned v) { return __uint_as_float(v << 16); }
__device__ __forceinline__ float bfhi(unsigned v) { return __uint_as_float(v & 0xffff0000u); }
__device__ __forceinline__ void store8(bf16_t* dst, const float (&v)[8]) {
    u32x4 w; w.x = cvt_pk_bf16(v[0], v[1]); w.y = cvt_pk_bf16(v[2], v[3]); w.z = cvt_pk_bf16(v[4], v[5]); w.w = cvt_pk_bf16(v[6], v[7]);
    *(u32x4*)dst = w;
}
__device__ __forceinline__ float wave_sum(float v) {
#pragma unroll
    for (int o = 1; o < 64; o <<= 1) v += __shfl_xor(v, o);
    return v;
}
__device__ __forceinline__ float fast_exp2(float x) { return __builtin_amdgcn_exp2f(x); }


#define XB_TMO      128
#define XB_XCNT(j)  (256  + 64 * (j))
#define XB_XSUB(j)  (1280 + 64 * (j))
#define XB_XGEN(j)  (2304 + 64 * (j))
#define XB_TOP      3328
#define XB_TOPGEN   3392
#define XCD_BAR_WORDS 3456
#define XB_SPIN_CAP (1u << 18)
#define LAS __attribute__((address_space(3)))
__device__ __forceinline__ unsigned xb_ld(unsigned* p)              { return __hip_atomic_load(p, __ATOMIC_RELAXED, __HIP_MEMORY_SCOPE_AGENT); }
__device__ __forceinline__ unsigned xb_add(unsigned* p, unsigned v) { return __hip_atomic_fetch_add(p, v, __ATOMIC_RELAXED, __HIP_MEMORY_SCOPE_AGENT); }
__device__ __forceinline__ unsigned xb_xcc_id() { return (unsigned)__builtin_amdgcn_s_getreg((3 << 11) | 20) & 0xFu; }
#define XB_SPIN(cond, bar) do { unsigned _sp = 0; while (cond) { __builtin_amdgcn_s_sleep(1); \
    if ((++_sp & 255u) == 0u) { if (xb_ld(&(bar)[XB_TMO])) break; if (_sp > XB_SPIN_CAP) { atomicAdd(&(bar)[XB_TMO], 1u); break; } } } } while (0)
struct XcdBarrier { unsigned* bar; unsigned x; volatile LAS unsigned* st; };
__device__ __forceinline__ XcdBarrier xcd_barrier_post(unsigned* bar, volatile LAS unsigned* st) {
    XcdBarrier b; b.bar = bar; b.x = xb_xcc_id(); b.st = st;
    if (threadIdx.x == 0) (void)xb_add(&bar[XB_XCNT(b.x)], 1u);
    return b;
}
__device__ __forceinline__ void xcd_barrier_complete(unsigned* bar, unsigned x, unsigned& nloc, unsigned& nx) {
    const unsigned G = gridDim.x * gridDim.y * gridDim.z;
    unsigned sum, cnt, mine, sp = 0u;
    for (;;) {
        sum = 0u; cnt = 0u; mine = 0u;
#pragma unroll
        for (unsigned j = 0; j < 16; ++j) { const unsigned c = xb_ld(&bar[XB_XCNT(j)]); sum += c; cnt += (c > 0u) ? 1u : 0u; mine = (j == x) ? c : mine; }
        if (sum == G) break;
        __builtin_amdgcn_s_sleep(1);
        if ((++sp & 255u) == 0u) { if (xb_ld(&bar[XB_TMO])) break; if (sp > XB_SPIN_CAP) { atomicAdd(&bar[XB_TMO], 1u); break; } }
    }
    nloc = mine > 0u ? mine : 1u; nx = cnt > 0u ? cnt : 1u;
}
__device__ __forceinline__ void xcd_barrier(const XcdBarrier& b) {
    asm volatile("s_waitcnt vmcnt(0)" ::: "memory");
    __syncthreads();
    if (threadIdx.x == 0) {
        unsigned* bar = b.bar;
        __builtin_amdgcn_s_waitcnt(0);
        unsigned nloc = b.st[0], nx = b.st[1];
        if (nloc == 0u) { xcd_barrier_complete(bar, b.x, nloc, nx); b.st[0] = nloc; b.st[1] = nx; }
        const unsigned old = xb_add(&bar[XB_XSUB(b.x)], 1u);
        const unsigned gen = old / nloc;
        if (old + 1u == (gen + 1u) * nloc) {
            __builtin_amdgcn_fence(__ATOMIC_RELEASE, "agent");
            asm volatile("s_waitcnt vmcnt(0)" ::: "memory");
            const unsigned og = xb_add(&bar[XB_TOP], 1u);
            const unsigned tg = og / nx;
            if (og + 1u == (tg + 1u) * nx) xb_add(&bar[XB_TOPGEN], 1u);
            else XB_SPIN(xb_ld(&bar[XB_TOPGEN]) == tg, bar);
            __builtin_amdgcn_fence(__ATOMIC_ACQUIRE, "agent");
            xb_add(&bar[XB_XGEN(b.x)], 1u);
            asm volatile("s_waitcnt vmcnt(0)" ::: "memory");
        } else {
            XB_SPIN(xb_ld(&bar[XB_XGEN(b.x)]) == gen, bar);
            __builtin_amdgcn_fence(__ATOMIC_ACQUIRE, "agent");
            asm volatile("s_waitcnt vmcnt(0)" ::: "memory");
        }
    }
    __syncthreads();
}

__device__ __forceinline__ void mod_item(const Params& p, char* smem, int it) {
    float* s_silu = (float*)smem;
    float* red = (float*)(smem + 9 * 1024 * 4);
    const int tid = threadIdx.x, lane = tid & 63, w = tid >> 6;
    const int layer = it / 96, col0 = (it % 96) * 64;
    for (int idx = tid; idx < 9 * 1024; idx += NTHREADS) {
        const int b = idx >> 10, k = idx & 1023;
        const float v = (b < 8) ? p.c[b * 1024 + k] : p.c_ctx[k];
        s_silu[idx] = v / (1.f + __expf(-v));
    }
    __syncthreads();
    float acc[9];
#pragma unroll
    for (int b = 0; b < 9; ++b) acc[b] = 0.f;
    const float* wp = p.w_mod + (size_t)layer * 1024 * 6144 + (size_t)(w * 128) * 6144 + col0 + lane;
    for (int kk = 0; kk < 128; kk += 8) {
        float wv[8];
#pragma unroll
        for (int u = 0; u < 8; ++u) wv[u] = wp[(size_t)(kk + u) * 6144];
#pragma unroll
        for (int b = 0; b < 9; ++b) {
            const f32x4 s0 = *(const f32x4*)(s_silu + b * 1024 + w * 128 + kk), s1 = *(const f32x4*)(s_silu + b * 1024 + w * 128 + kk + 4);
            acc[b] += s0[0] * wv[0] + s0[1] * wv[1] + s0[2] * wv[2] + s0[3] * wv[3] + s1[0] * wv[4] + s1[1] * wv[5] + s1[2] * wv[6] + s1[3] * wv[7];
        }
    }
#pragma unroll
    for (int b = 0; b < 9; ++b) red[(w * 9 + b) * 64 + lane] = acc[b];
    __syncthreads();
    for (int idx = tid; idx < 9 * 64; idx += NTHREADS) {
        const int b = idx >> 6, l = idx & 63;
        float s = 0.f;
#pragma unroll
        for (int ww = 0; ww < NWAVES; ++ww) s += red[(ww * 9 + b) * 64 + l];
        p.mod[(size_t)(layer * 9 + b) * 6144 + col0 + l] = s + p.b_mod[layer * 6144 + col0 + l];
    }
}

__device__ __forceinline__ void table_item(const Params& p) {
    const int tid = threadIdx.x;
    for (int idx = tid; idx < 64 * 16; idx += NTHREADS) {
        const int pi = idx >> 4, i = idx & 15;
        const float freq = exp2f(-(float)i * (13.28771238f / 16.f));
        const float ang = (float)pi * freq;
        p.misc[MISC_ROPE64 + idx * 2] = __cosf(ang); p.misc[MISC_ROPE64 + idx * 2 + 1] = __sinf(ang);
    }
    for (int idx = tid; idx < 64 * 8; idx += NTHREADS) {
        const int pi = idx >> 3, i = idx & 7;
        const float freq = exp2f(-(float)i * (13.28771238f / 8.f));
        const float ang = (float)pi * freq;
        p.misc[MISC_ROPE32 + idx * 2] = __cosf(ang); p.misc[MISC_ROPE32 + idx * 2 + 1] = __sinf(ang);
    }
    if (tid == 0) {
        float s1 = 0.f, s2 = 0.f;
        for (int i = 0; i < 64; ++i) { s1 += p.lq1[i] * p.lk1[i]; s2 += p.lq2[i] * p.lk2[i]; }
        p.misc[MISC_LAM] = __expf(s1) - __expf(s2) + LAMBDA_INIT;
    }
}

__device__ __forceinline__ void transpose_tile(char* smem, const float* src, int K, int Nsrc, bf16_t* dst, int ntn, int mode, const float* gain, int tile, int dmul = 1, int dadd = 0) {
    float* t = (float*)smem;
    const int tid = threadIdx.x, tx = tid & 63, ty = tid >> 6;
    const int kt = tile / ntn, nt = tile % ntn;
    const int np = nt * 64 + tx;
    int n = np;
    if (mode == 1) { n = np < 896 ? np : (np < 1024 ? 928 + (np - 896) : (np < 1152 ? 1056 + (np - 1024) : (np < 1184 ? 896 + (np - 1152) : -1))); }
    else if (mode == 2) { if (np < 512) n = (np >> 6) * 96 + (np & 63); else { const int m = np - 512; n = (m >> 5) * 96 + 64 + (m & 31); } }
#pragma unroll
    for (int i = 0; i < 8; ++i) {
        const int kl = ty + 8 * i, k = kt * 64 + kl;
        float v = 0.f;
        if (n >= 0) { v = src[(size_t)k * Nsrc + n]; if (gain) v *= gain[k]; }
        t[kl * 65 + tx] = v;
    }
    __syncthreads();
#pragma unroll
    for (int i = 0; i < 8; ++i) {
        const int nl = ty + 8 * i;
        dst[(size_t)((nt * dmul + dadd) * 64 + nl) * K + kt * 64 + tx] = (bf16_t)(cvt_pk_bf16(t[tx * 65 + nl], 0.f) & 0xffffu);
    }
}

__device__ __forceinline__ void transpose_item(const Params& p, char* smem, int r) {
    constexpr int T0 = 16 * 20, T1 = 4 * 12, T2 = 2 * 16, T3 = 16 * 16, T4 = 16 * 48, T5 = 16 * 16, TF = 16 * 44;
    if (r < T0) { transpose_tile(smem, p.ab_w_in, 1024, 1184, p.wt_in0, 20, 1, nullptr, r); return; } r -= T0;
    if (r < T1) { transpose_tile(smem, p.w_qb, 256, 768, p.wt_qb, 12, 2, p.q_norm, r); return; } r -= T1;
    if (r < T2) { transpose_tile(smem, p.w_kvb, 128, 1024, p.wt_kvb, 16, 0, p.kv_norm, r); return; } r -= T2;
    if (r < T3) { transpose_tile(smem, p.ab_w_out, 1024, 1024, p.wt_out0, 16, 0, nullptr, r); return; } r -= T3;
    if (r < T4) { transpose_tile(smem, p.d_w_in, 1024, 3072, p.wt_din, 48, 0, nullptr, r); return; } r -= T4;
    if (r < T5) { transpose_tile(smem, p.d_w_out, 1024, 1024, p.wt_dout, 16, 0, nullptr, r); return; } r -= T5;
    {
        const int j = r / TF, rr = r % TF;
        if (j < 2) transpose_tile(smem, p.w_gate + (size_t)j * 1024 * 2816, 1024, 2816, p.wt_gate + (size_t)j * 5632 * 1024, 44, 0, nullptr, rr, 2, 0);
        else if (j < 4) transpose_tile(smem, p.w_up + (size_t)(j - 2) * 1024 * 2816, 1024, 2816, p.wt_gate + (size_t)(j - 2) * 5632 * 1024, 44, 0, nullptr, rr, 2, 1);
        else transpose_tile(smem, p.w_down + (size_t)(j - 4) * 2816 * 1024, 2816, 1024, p.wt_down + (size_t)(j - 4) * 1024 * 2816, 16, 0, nullptr, rr);
    }
}
constexpr int N_TR_TILES = 16 * 20 + 4 * 12 + 2 * 16 + 16 * 16 + 16 * 48 + 16 * 16 + 6 * 16 * 44;

__device__ __forceinline__ void phase_prologue(const Params& p, char* smem) {
    const int total = 193 + N_TR_TILES;
    for (int it = blockIdx.x; it < total; it += gridDim.x) {
        if (it < 192) mod_item(p, smem, it);
        else if (it == 192) table_item(p);
        else transpose_item(p, smem, it - 193);
        __syncthreads();
    }
}

__device__ __forceinline__ void phase_h0(const Params& p) {
    const int lane = threadIdx.x & 63, w = threadIdx.x >> 6;
    for (int row = blockIdx.x * NWAVES + w; row < ROWS; row += gridDim.x * NWAVES) {
        const int b = row / TOK, j = row % TOK; const bool isc = j < CTXL;
        const float* rp = isc ? p.ctx + ((size_t)b * CTXL + j) * DM : p.x + ((size_t)b * SEQ + (j - CTXL)) * DM;
        const float* md = p.mod + (size_t)(0 * 9 + (isc ? 8 : b)) * 6144;
#pragma unroll 1
        for (int i = 0; i < 4; ++i) {
            const int col = i * 256 + lane * 4;
            const f32x4 v = *(const f32x4*)(rp + col), sh = *(const f32x4*)(md + col), sc = *(const f32x4*)(md + 1024 + col);
            u32x2 o; o.x = cvt_pk_bf16(v[0] * (1.f + sc[0]) + sh[0], v[1] * (1.f + sc[1]) + sh[1]); o.y = cvt_pk_bf16(v[2] * (1.f + sc[2]) + sh[2], v[3] * (1.f + sc[3]) + sh[3]);
            *(u32x2*)(p.h + (size_t)row * DM + col) = o;
        }
    }
}

__device__ __forceinline__ void gemm_core(char* smem, const bf16_t* __restrict__ A, int lda, int ar0a, int aloa, int ahia, int ar0b, int alob, int ahib,
                                          const bf16_t* __restrict__ B, int ldb, int K, const bf16_t* zero16, f32x4 (&acc)[8][4]) {
    constexpr int ROWB = 128, OPA = 256 * ROWB, STG = 2 * OPA, NI = 4;
    static_assert(2 * STG <= SMEM_BYTES, "LDS");
    const int tid = threadIdx.x, lane = tid & 63, w = __builtin_amdgcn_readfirstlane(tid >> 6), wr = w >> 2, wc = w & 3, fr = lane & 15, fq = lane >> 4;
    const int rl = lane >> 3, kcs = (lane & 7) ^ rl;
#pragma unroll
    for (int m = 0; m < 8; ++m)
#pragma unroll
        for (int n = 0; n < 4; ++n) acc[m][n] = (f32x4){0.f, 0.f, 0.f, 0.f};
    const int nk = K / 64;
    int aoff[NI], boff[NI];
#pragma unroll
    for (int i = 0; i < NI; ++i) {
        const int row = (w * NI + i) * 8 + rl, hf = row >> 7, gr = (hf ? ar0b : ar0a) + (row & 127);
        const bool ok = hf ? (gr >= alob && gr < ahib) : (gr >= aloa && gr < ahia);
        aoff[i] = ok ? gr * lda + kcs * 8 : -1;
        boff[i] = row * ldb + kcs * 8;
    }
    __syncthreads();
#pragma unroll
    for (int i = 0; i < NI; ++i) {
        __builtin_amdgcn_global_load_lds((const unsigned*)(aoff[i] >= 0 ? A + aoff[i] : zero16), (LAS unsigned*)(smem + (w * NI + i) * 1024), 16, 0, 0);
        __builtin_amdgcn_global_load_lds((const unsigned*)(B + boff[i]), (LAS unsigned*)(smem + OPA + (w * NI + i) * 1024), 16, 0, 0);
    }
    asm volatile("s_waitcnt vmcnt(0)" ::: "memory"); __syncthreads();
    const int sw = fr & 7;
    for (int kt = 0; kt < nk; ++kt) {
        const bool pf = kt + 1 < nk; const int nst = ((kt + 1) & 1) * STG;
        const char* base = smem + (kt & 1) * STG;
        bf16x8 bfr[2][4];
#pragma unroll
        for (int n = 0; n < 4; ++n) bfr[0][n] = *(const bf16x8*)(base + OPA + (wc * 64 + n * 16 + fr) * ROWB + ((fq ^ sw) * 16));
#pragma unroll
        for (int ks = 0; ks < 2; ++ks) {
            const int co = (((ks * 4 + fq) ^ sw) * 16);
#pragma unroll
            for (int m = 0; m < 8; ++m) {
                const bf16x8 af = *(const bf16x8*)(base + (wr * 128 + m * 16 + fr) * ROWB + co);
#pragma unroll
                for (int n = 0; n < 4; ++n) acc[m][n] = __builtin_amdgcn_mfma_f32_16x16x32_bf16(af, bfr[ks][n], acc[m][n], 0, 0, 0);
                if (ks == 0 && m == 5) {
#pragma unroll
                    for (int n = 0; n < 4; ++n) bfr[1][n] = *(const bf16x8*)(base + OPA + (wc * 64 + n * 16 + fr) * ROWB + (((4 + fq) ^ sw) * 16));
                }
                if (ks == 0 && pf) {
                    const int i = m & 3, lo_ = nst + (w * NI + i) * 1024;
                    if (m < 4) __builtin_amdgcn_global_load_lds((const unsigned*)(aoff[i] >= 0 ? A + aoff[i] + (kt + 1) * 64 : zero16), (LAS unsigned*)(smem + lo_), 16, 0, 0);
                    else __builtin_amdgcn_global_load_lds((const unsigned*)(B + boff[i] + (kt + 1) * 64), (LAS unsigned*)(smem + lo_ + OPA), 16, 0, 0);
                }
            }
        }
        asm volatile("s_waitcnt vmcnt(0)" ::: "memory");
        __syncthreads();
    }
}

__device__ __forceinline__ void acc_to_ct(float* Ct0, const f32x4 (&acc)[8][4], int ai) {
    const int tid = threadIdx.x, lane = tid & 63, w = tid >> 6, wr = w >> 2, wc = w & 3, fr = lane & 15, fq = lane >> 4;
    __syncthreads();
    if (wr == ai) {
        float* Ct = Ct0 + (wc >> 1) * CT_FLOATS + (wc & 1) * 64 + fr;
#pragma unroll
        for (int m = 0; m < 8; ++m)
#pragma unroll
            for (int n = 0; n < 4; ++n)
#pragma unroll
                for (int j = 0; j < 4; ++j) Ct[(m * 16 + fq * 4 + j) * LDC + n * 16] = acc[m][n][j];
    }
    __syncthreads();
}

__device__ __forceinline__ void gemm_core_h(char* smem, const bf16_t* __restrict__ A, int lda, int ar0a, int aloa, int ahia, int ar0b, int alob, int ahib,
                                            const bf16_t* __restrict__ B, int ldb, int K, const bf16_t* zero16, f32x4 (&acc)[4][4]) {
    constexpr int ROWB = 128, OPA = 256 * ROWB, STG = 2 * OPA, NI = 4, NIB = 2;
    const int tid = threadIdx.x, lane = tid & 63, w = __builtin_amdgcn_readfirstlane(tid >> 6), wr = w >> 1, wc = w & 1, fr = lane & 15, fq = lane >> 4;
    const int rl = lane >> 3, kcs = (lane & 7) ^ rl;
#pragma unroll
    for (int m = 0; m < 4; ++m)
#pragma unroll
        for (int n = 0; n < 4; ++n) acc[m][n] = (f32x4){0.f, 0.f, 0.f, 0.f};
    const int nk = K / 64;
    int aoff[NI], boff[NIB];
#pragma unroll
    for (int i = 0; i < NI; ++i) {
        const int row = (w * NI + i) * 8 + rl, hf = row >> 7, gr = (hf ? ar0b : ar0a) + (row & 127);
        const bool ok = hf ? (gr >= alob && gr < ahib) : (gr >= aloa && gr < ahia);
        aoff[i] = ok ? gr * lda + kcs * 8 : -1;
    }
#pragma unroll
    for (int i = 0; i < NIB; ++i) boff[i] = ((w * NIB + i) * 8 + rl) * ldb + kcs * 8;
    __syncthreads();
#pragma unroll
    for (int i = 0; i < NI; ++i) __builtin_amdgcn_global_load_lds((const unsigned*)(aoff[i] >= 0 ? A + aoff[i] : zero16), (LAS unsigned*)(smem + (w * NI + i) * 1024), 16, 0, 0);
#pragma unroll
    for (int i = 0; i < NIB; ++i) __builtin_amdgcn_global_load_lds((const unsigned*)(B + boff[i]), (LAS unsigned*)(smem + OPA + (w * NIB + i) * 1024), 16, 0, 0);
    asm volatile("s_waitcnt vmcnt(0)" ::: "memory"); __syncthreads();
    const int sw = fr & 7;
    for (int kt = 0; kt < nk; ++kt) {
        const bool pf = kt + 1 < nk; const int nst = ((kt + 1) & 1) * STG;
        const char* base = smem + (kt & 1) * STG;
#pragma unroll
        for (int ks = 0; ks < 2; ++ks) {
            const int co = (((ks * 4 + fq) ^ sw) * 16);
            bf16x8 bfr[4];
#pragma unroll
            for (int n = 0; n < 4; ++n) bfr[n] = *(const bf16x8*)(base + OPA + (wc * 64 + n * 16 + fr) * ROWB + co);
#pragma unroll
            for (int m = 0; m < 4; ++m) {
                const bf16x8 af = *(const bf16x8*)(base + (wr * 64 + m * 16 + fr) * ROWB + co);
#pragma unroll
                for (int n = 0; n < 4; ++n) acc[m][n] = __builtin_amdgcn_mfma_f32_16x16x32_bf16(af, bfr[n], acc[m][n], 0, 0, 0);
                if (pf) {
                    if (ks == 0) __builtin_amdgcn_global_load_lds((const unsigned*)(aoff[m] >= 0 ? A + aoff[m] + (kt + 1) * 64 : zero16), (LAS unsigned*)(smem + nst + (w * NI + m) * 1024), 16, 0, 0);
                    else if (m < NIB) __builtin_amdgcn_global_load_lds((const unsigned*)(B + boff[m & 1] + (kt + 1) * 64), (LAS unsigned*)(smem + nst + OPA + (w * NIB + (m & 1)) * 1024), 16, 0, 0);
                }
            }
        }
        asm volatile("s_waitcnt vmcnt(0)" ::: "memory");
        __syncthreads();
    }
}
__device__ __forceinline__ void acc_to_ct_h(float* Ct0, const f32x4 (&acc)[4][4], int ai) {
    const int tid = threadIdx.x, lane = tid & 63, w = tid >> 6, wr = w >> 1, wc = w & 1, fr = lane & 15, fq = lane >> 4;
    __syncthreads();
    if ((wr >> 1) == ai) {
        float* Ct = Ct0 + ((wr & 1) * 64 + fq * 4) * LDC + wc * 64 + fr;
#pragma unroll
        for (int m = 0; m < 4; ++m)
#pragma unroll
            for (int n = 0; n < 4; ++n)
#pragma unroll
                for (int j = 0; j < 4; ++j) Ct[(m * 16 + j) * LDC + n * 16] = acc[m][n][j];
    }
    __syncthreads();
}
#define TAIL_DECODE(T) const int G_ = gridDim.x, Tfull_ = ((T) / G_) * G_, total_ = Tfull_ + 2 * ((T) - Tfull_)
#define NOTAIL_DECODE(T) const int G_ = gridDim.x, Tfull_ = (T), total_ = (T)
#define TAIL_ITEM(it, tile, half) int tile, half; if ((it) < Tfull_) { tile = (it); half = -1; } else { const int r_ = (it) - Tfull_; tile = Tfull_ + (r_ >> 1); half = r_ & 1; }

__device__ __forceinline__ void load8(const float* src, float (&v)[8]) {
    const f32x4 a = *(const f32x4*)src, b = *(const f32x4*)(src + 4);
    v[0] = a[0]; v[1] = a[1]; v[2] = a[2]; v[3] = a[3]; v[4] = b[0]; v[5] = b[1]; v[6] = b[2]; v[7] = b[3];
}

__device__ __forceinline__ void rope8(const float* rowp, int c0, int hd, int pos, const float* tab, float (&v)[8]) {
    const int qs = hd >> 2, ch = c0 & (hd - 1), qd = ch / qs, i0 = ch & (qs - 1);
    const int idx = (qd < 2) ? (pos >> 6) : (pos & 63);
    const int pc = (qd & 1) ? c0 - qs : c0 + qs; const float sgn = (qd & 1) ? 1.f : -1.f;
    const float* t = tab + (idx * qs + i0) * 2;
#pragma unroll
    for (int e = 0; e < 8; ++e) v[e] = v[e] * t[2 * e] + sgn * rowp[pc + e] * t[2 * e + 1];
}

__device__ __forceinline__ void store_col8(const float* Ct, int c, int rc, bf16_t* dst, const float* rs) {
    float v[8];
#pragma unroll
    for (int e = 0; e < 8; ++e) { v[e] = Ct[(rc * 8 + e) * LDC + c]; if (rs) v[e] *= rs[rc * 8 + e]; }
    store8(dst, v);
}

__device__ __forceinline__ void epi_proj0(const Params& p, const float* Ct, int mt, int nt) {
    const int tid = threadIdx.x;
    bf16_t* proj0 = p.big + BE_PROJ0; bf16_t* vt_swa = p.big + BE_VT_SWA; bf16_t* k_mla = p.big + BE_K_MLA;
    extern __shared__ __attribute__((aligned(16))) char smem_dyn_[]; const float* lds_tab_ = (const float*)(smem_dyn_ + SMEM_BYTES);
    const float* rope64 = lds_tab_ + MISC_ROPE64; const float* rope32 = lds_tab_ + MISC_ROPE32;
    const int b = mt / 18, jt = mt % 18; const bool is_ctx = jt < 2; const int row0 = mt * 128, tok0 = jt * 128;
    if (nt == 8) {
#pragma unroll 1
        for (int i = 0; i < 4; ++i) { const int id = tid + NTHREADS * i, c = id & 127, rc = id >> 7;
            store_col8(Ct, c, rc, vt_swa + (size_t)((b * 2 + (c >> 6)) * 64 + (c & 63)) * TOK + tok0 + rc * 8, nullptr); }
    } else {
#pragma unroll 1
        for (int i = 0; i < 4; ++i) {
            const int id = tid + NTHREADS * i, r = id >> 4, c0 = (id & 15) * 8;
            const float* rowp = Ct + r * LDC; float v[8]; load8(rowp + c0, v);
            const int grow = row0 + r, pos = tok0 + r - CTXL;
            if (nt <= 1 || nt == 6) { store8(proj0 + (size_t)grow * 1024 + nt * 128 + c0, v); }
            else if (nt <= 5 || nt == 7) { if (!is_ctx) rope8(rowp, c0, 64, pos, rope64, v); store8(proj0 + (size_t)grow * 1024 + (nt == 7 ? 896 : nt * 128) + c0, v); }
            else if (c0 < 32) { if (!is_ctx) rope8(rowp, c0, 32, pos, rope32, v);
#pragma unroll
                for (int hh = 0; hh < 8; ++hh) store8(k_mla + (size_t)grow * 768 + hh * 96 + 64 + c0, v); }
        }
    }
}
__device__ __forceinline__ void phase_proj0(const Params& p, char* smem) {
    float* Ct = (float*)smem;
    TAIL_DECODE(72 * 5);
    for (int it = blockIdx.x; it < total_; it += G_) {
        TAIL_ITEM(it, tile, half)
        const int mt2 = tile / 5, nt2 = tile % 5;
        if (half < 0) {
            f32x4 acc[8][4];
            gemm_core(smem, p.h, DM, mt2 * 256, 0, ROWS, mt2 * 256 + 128, 0, ROWS, p.wt_in0 + (size_t)nt2 * 256 * DM, DM, DM, (const bf16_t*)p.bar, acc);
#pragma unroll 1
            for (int ai = 0; ai < 2; ++ai) {
                acc_to_ct(Ct, acc, ai);
                epi_proj0(p, Ct, mt2 * 2 + ai, nt2 * 2);
                epi_proj0(p, Ct + CT_FLOATS, mt2 * 2 + ai, nt2 * 2 + 1);
            }
        } else {
            const int nt = nt2 * 2 + half;
            f32x4 acc[4][4];
            gemm_core_h(smem, p.h, DM, mt2 * 256, 0, ROWS, mt2 * 256 + 128, 0, ROWS, p.wt_in0 + (size_t)nt * 128 * DM, DM, DM, (const bf16_t*)p.bar, acc);
#pragma unroll 1
            for (int ai = 0; ai < 2; ++ai) { acc_to_ct_h(Ct, acc, ai); epi_proj0(p, Ct, mt2 * 2 + ai, nt); }
        }
    }
}

__device__ __forceinline__ void row_rstd(const bf16_t* A, int lda, int row0, int K, float* rs) {
    const int tid = threadIdx.x;
    if (tid < 256) {
        const int r = tid >> 1, hf = tid & 1; const int n = K / 2;
        const bf16_t* ap = A + (size_t)(row0 + r) * lda + hf * n; float ss = 0.f;
        for (int k = 0; k < n; k += 8) { const u32x4 v = *(const u32x4*)(ap + k);
            ss += bflo(v.x) * bflo(v.x) + bfhi(v.x) * bfhi(v.x) + bflo(v.y) * bflo(v.y) + bfhi(v.y) * bfhi(v.y) + bflo(v.z) * bflo(v.z) + bfhi(v.z) * bfhi(v.z) + bflo(v.w) * bflo(v.w) + bfhi(v.w) * bfhi(v.w); }
        ss += __shfl_xor(ss, 1);
        if (hf == 0) rs[r] = rsqrtf(ss / (float)K + 1e-6f);
    }
    __syncthreads();
}
__device__ __forceinline__ void epi_mla_q(const Params& p, const float* Ct, const float* rs, int mt, int nt) {
    extern __shared__ __attribute__((aligned(16))) char smem_dyn_[]; const float* lds_tab_ = (const float*)(smem_dyn_ + SMEM_BYTES);
    const int tid = threadIdx.x; bf16_t* q_mla = p.big + BE_Q_MLA; const float* rope32 = lds_tab_ + MISC_ROPE32;
    const int jt = mt % 18; const bool is_ctx = jt < 2; const int row0 = mt * 128, tok0 = jt * 128;
#pragma unroll 1
    for (int i = 0; i < 4; ++i) {
        const int id = tid + NTHREADS * i, r = id >> 4, c0 = (id & 15) * 8;
        const float* rowp = Ct + r * LDC; float v[8]; load8(rowp + c0, v);
        const int grow = row0 + r, pos = tok0 + r - CTXL; const float sc = rs[r];
        int dcol;
        if (nt < 4) { const int cg = nt * 128 + c0; dcol = (cg >> 6) * 96 + (cg & 63); }
        else { const int cg = (nt - 4) * 128 + c0; dcol = (cg >> 5) * 96 + 64 + (cg & 31); if (!is_ctx) rope8(rowp, c0, 32, pos, rope32, v); }
#pragma unroll
        for (int e = 0; e < 8; ++e) v[e] *= sc;
        store8(q_mla + (size_t)grow * 768 + dcol, v);
    }
}
__device__ __forceinline__ void epi_mla_kv(const Params& p, const float* Ct, const float* rs, int mt, int hh) {
    const int tid = threadIdx.x; bf16_t* k_mla = p.big + BE_K_MLA; bf16_t* vt_mla = p.big + BE_VT_MLA;
    const int b = mt / 18, jt = mt % 18; const int row0 = mt * 128, tok0 = jt * 128;
#pragma unroll 1
    for (int i = 0; i < 2; ++i) {
        const int id = tid + NTHREADS * i, r = id >> 3, c0 = (id & 7) * 8;
        float v[8]; load8(Ct + r * LDC + c0, v); const float sc = rs[r];
#pragma unroll
        for (int e = 0; e < 8; ++e) v[e] *= sc;
        store8(k_mla + (size_t)(row0 + r) * 768 + hh * 96 + c0, v);
    }
#pragma unroll 1
    for (int i = 0; i < 2; ++i) { const int id = tid + NTHREADS * i, c = 64 + (id & 63), rc = id >> 6;
        store_col8(Ct, c, rc, vt_mla + (size_t)((b * 8 + hh) * 64 + (c - 64)) * TOK + tok0 + rc * 8, rs); }
}
__device__ __forceinline__ void phase_mla_up(const Params& p, char* smem) {
    float* Ct = (float*)smem; float* rs = (float*)(smem + 2 * CT_FLOATS * 4);
    bf16_t* proj0 = p.big + BE_PROJ0;
    for (int it = blockIdx.x; it < 72 * 7; it += gridDim.x) {
        const int mt2 = it / 7, nt2 = it % 7;
        f32x4 acc[8][4];
        if (nt2 < 3) gemm_core(smem, proj0, 1024, mt2 * 256, 0, ROWS, mt2 * 256 + 128, 0, ROWS, p.wt_qb + (size_t)nt2 * 256 * 256, 256, 256, (const bf16_t*)p.bar, acc);
        else gemm_core(smem, proj0 + 768, 1024, mt2 * 256, 0, ROWS, mt2 * 256 + 128, 0, ROWS, p.wt_kvb + (size_t)(nt2 - 3) * 256 * 128, 128, 128, (const bf16_t*)p.bar, acc);
#pragma unroll 1
        for (int ai = 0; ai < 2; ++ai) {
            acc_to_ct(Ct, acc, ai);
            const int mt = mt2 * 2 + ai;
            if (nt2 < 3) { row_rstd(proj0, 1024, mt * 128, 256, rs); epi_mla_q(p, Ct, rs, mt, nt2 * 2); epi_mla_q(p, Ct + CT_FLOATS, rs, mt, nt2 * 2 + 1); }
            else { row_rstd(proj0 + 768, 1024, mt * 128, 128, rs); epi_mla_kv(p, Ct, rs, mt, (nt2 - 3) * 2); epi_mla_kv(p, Ct + CT_FLOATS, rs, mt, (nt2 - 3) * 2 + 1); }
        }
    }
}

template <int DQK, int DV, bool WINDOWED>
__device__ __forceinline__ void flash_pass(char* smem, const bf16_t* __restrict__ Qp, int ldq, const bf16_t* __restrict__ Kp, int ldk,
                                           const bf16_t* __restrict__ Vtp, int seg2s, int seg2e, int q_tok0, float sc2,
                                           f32x4 (&o)[DV / 16][2], float (&mrun)[2], float (&lrun)[2]) {
    constexpr int KROW = DQK * 2, VROW = 128, KB = 64 * KROW, VB = DV * VROW, STG = KB + VB;
    constexpr int KCPR = DQK / 8, NKI = KCPR, NVI = DV / 8, KCPT = (NKI + 7) / 8, VCPT = NVI / 8, NKS = DQK / 32, NMD = DV / 16;
    static_assert(2 * STG <= SMEM_BYTES, "LDS");
    const int tid = threadIdx.x, lane = tid & 63, w = tid >> 6, fr = lane & 15, fq = lane >> 4, wq0 = w * 32;
    bf16x8 qf[2][NKS];
#pragma unroll
    for (int nq = 0; nq < 2; ++nq)
#pragma unroll
        for (int ks = 0; ks < NKS; ++ks) qf[nq][ks] = *(const bf16x8*)(Qp + (size_t)(wq0 + nq * 16 + fr) * ldq + ks * 32 + fq * 8);
#pragma unroll
    for (int md = 0; md < NMD; ++md) { o[md][0] = (f32x4){0.f, 0.f, 0.f, 0.f}; o[md][1] = (f32x4){0.f, 0.f, 0.f, 0.f}; }
    float mref[2]; mref[0] = mref[1] = -1e30f; lrun[0] = lrun[1] = 0.f;
    const float thr = 8.0f / sc2;
    const int nt = 4 + (seg2e > seg2s ? (seg2e - seg2s) / 64 : 0);
    const int wu = __builtin_amdgcn_readfirstlane(w);
    int koffg[KCPT], voffg[VCPT];
#pragma unroll
    for (int i = 0; i < KCPT; ++i) { const int idx = (wu + 8 * i) * 64 + lane, rho = (idx / KCPR) & 63, cp = idx % KCPR;
        const int key = 32 * (rho >> 5) + 8 * ((rho >> 2) & 3) + 4 * ((rho >> 4) & 1) + (rho & 3);
        const int kcs = (DQK == 64) ? (cp ^ (rho & 7)) : ((cp & ~3) | ((cp & 3) ^ ((4 - ((rho >> 2) & 3)) & 3)));
        koffg[i] = key * ldk + kcs * 8; }
#pragma unroll
    for (int i = 0; i < VCPT; ++i) { const int idx = (wu + 8 * i) * 64 + lane, r = idx >> 3, cp = idx & 7; voffg[i] = r * TOK + ((cp ^ (r & 7)) * 8); }
    __syncthreads();
#define FDMA(t, st) do { const int key0_ = (t) < 4 ? (t) * 64 : seg2s + ((t) - 4) * 64; const bf16_t* kg_ = Kp + (size_t)key0_ * ldk; const bf16_t* vg_ = Vtp + key0_; \
        _Pragma("unroll") for (int i = 0; i < KCPT; ++i) if (wu + 8 * i < NKI) __builtin_amdgcn_global_load_lds((const unsigned*)(kg_ + koffg[i]), (LAS unsigned*)(smem + (st) * STG + (wu + 8 * i) * 1024), 16, 0, 0); \
        _Pragma("unroll") for (int i = 0; i < VCPT; ++i) __builtin_amdgcn_global_load_lds((const unsigned*)(vg_ + voffg[i]), (LAS unsigned*)(smem + (st) * STG + KB + (wu + 8 * i) * 1024), 16, 0, 0); } while (0)
    FDMA(0, 0);
    asm volatile("s_waitcnt vmcnt(0)" ::: "memory"); __syncthreads();
    const int ksw = (DQK == 64) ? (fr & 7) : ((4 - ((fr >> 2) & 3)) & 3);
    for (int t = 0; t < nt; ++t) {
        if (t + 1 < nt) FDMA(t + 1, (t + 1) & 1);
        const char* kb = smem + (t & 1) * STG; const char* vb = kb + KB;
        const int key0 = t < 4 ? t * 64 : seg2s + (t - 4) * 64;
        f32x4 s[4][2];
#pragma unroll
        for (int mk = 0; mk < 4; ++mk) { s[mk][0] = (f32x4){0.f, 0.f, 0.f, 0.f}; s[mk][1] = (f32x4){0.f, 0.f, 0.f, 0.f}; }
#pragma unroll
        for (int ks = 0; ks < NKS; ++ks) {
            const int co = (DQK == 64) ? (((ks * 4 + fq) ^ ksw) * 16) : ((ks * 4 + (fq ^ ksw)) * 16);
#pragma unroll
            for (int mk = 0; mk < 4; ++mk) {
                const bf16x8 kf = *(const bf16x8*)(kb + (mk * 16 + fr) * KROW + co);
                s[mk][0] = __builtin_amdgcn_mfma_f32_16x16x32_bf16(kf, qf[0][ks], s[mk][0], 0, 0, 0);
                s[mk][1] = __builtin_amdgcn_mfma_f32_16x16x32_bf16(kf, qf[1][ks], s[mk][1], 0, 0, 0);
            }
        }
        __builtin_amdgcn_sched_barrier(0);
        bf16x8 vf0[4];
#pragma unroll
        for (int md = 0; md < 4; ++md) vf0[md] = *(const bf16x8*)(vb + (md * 16 + fr) * VROW + ((fq ^ (fr & 7)) * 16));
        bf16x8 pf[2][2];
#pragma unroll
        for (int nq = 0; nq < 2; ++nq) {
            if (WINDOWED && key0 >= CTXL) {
                const int qpos = q_tok0 - CTXL + wq0 + nq * 16 + fr;
#pragma unroll
                for (int mk = 0; mk < 4; ++mk)
#pragma unroll
                    for (int j = 0; j < 4; ++j) { const int kpos = key0 - CTXL + 32 * (mk >> 1) + 8 * fq + 4 * (mk & 1) + j; const int d = qpos - kpos; if (d > 128 || d < -128) s[mk][nq][j] = -1e30f; }
            }
            float mx = fmaxf(fmaxf(s[0][nq][0], s[0][nq][1]), fmaxf(s[0][nq][2], s[0][nq][3]));
#pragma unroll
            for (int mk = 1; mk < 4; ++mk) mx = fmaxf(fmaxf(mx, fmaxf(s[mk][nq][0], s[mk][nq][1])), fmaxf(s[mk][nq][2], s[mk][nq][3]));
            mx = fmaxf(mx, __shfl_xor(mx, 16)); mx = fmaxf(mx, __shfl_xor(mx, 32));
            const bool need = mx > mref[nq] + thr;
            if (__any(need)) {
                const float mnew = need ? mx : mref[nq];
                const float alpha = fast_exp2((mref[nq] - mnew) * sc2);
                mref[nq] = mnew; lrun[nq] *= alpha;
#pragma unroll
                for (int md = 0; md < NMD; ++md) o[md][nq] = o[md][nq] * alpha;
            }
            const float nm = -mref[nq] * sc2;
            float ls = 0.f;
#pragma unroll
            for (int mk = 0; mk < 4; ++mk)
#pragma unroll
                for (int j = 0; j < 4; ++j) { const float pv = fast_exp2(fmaf(s[mk][nq][j], sc2, nm)); s[mk][nq][j] = pv; ls += pv; }
            lrun[nq] += ls;
#pragma unroll
            for (int kk = 0; kk < 2; ++kk) {
                u32x4 pk; pk.x = cvt_pk_bf16(s[2 * kk][nq][0], s[2 * kk][nq][1]); pk.y = cvt_pk_bf16(s[2 * kk][nq][2], s[2 * kk][nq][3]);
                pk.z = cvt_pk_bf16(s[2 * kk + 1][nq][0], s[2 * kk + 1][nq][1]); pk.w = cvt_pk_bf16(s[2 * kk + 1][nq][2], s[2 * kk + 1][nq][3]);
                pf[nq][kk] = __builtin_bit_cast(bf16x8, pk);
            }
        }
        __builtin_amdgcn_sched_barrier(0);
#pragma unroll
        for (int kk = 0; kk < 2; ++kk) {
            const int co = (((kk * 4 + fq) ^ (fr & 7)) * 16);
#pragma unroll
            for (int md = 0; md < NMD; ++md) {
                const bf16x8 vf = (kk == 0 && md < 4) ? vf0[md & 3] : *(const bf16x8*)(vb + (md * 16 + fr) * VROW + co);
                o[md][0] = __builtin_amdgcn_mfma_f32_16x16x32_bf16(vf, pf[0][kk], o[md][0], 0, 0, 0);
                o[md][1] = __builtin_amdgcn_mfma_f32_16x16x32_bf16(vf, pf[1][kk], o[md][1], 0, 0, 0);
            }
        }
        asm volatile("s_waitcnt vmcnt(0)" ::: "memory");
        __syncthreads();
    }
#undef FDMA
#pragma unroll
    for (int nq = 0; nq < 2; ++nq) { float l = lrun[nq]; l += __shfl_xor(l, 16); l += __shfl_xor(l, 32); lrun[nq] = l; mrun[nq] = mref[nq] * sc2; }
}

template <int NMD>
__device__ __forceinline__ void store_o(bf16_t* Op, int ldo, const f32x4 (&o)[NMD][2], const float (&inv)[2]) {
    const int lane = threadIdx.x & 63, w = threadIdx.x >> 6, fr = lane & 15, fq = lane >> 4, wq0 = w * 32;
#pragma unroll
    for (int nq = 0; nq < 2; ++nq)
#pragma unroll
        for (int md = 0; md < NMD; ++md) {
            u32x2 v; v.x = cvt_pk_bf16(o[md][nq][0] * inv[nq], o[md][nq][1] * inv[nq]); v.y = cvt_pk_bf16(o[md][nq][2] * inv[nq], o[md][nq][3] * inv[nq]);
            *(u32x2*)(Op + (size_t)(wq0 + nq * 16 + fr) * ldo + md * 16 + fq * 4) = v;
        }
}

__device__ __forceinline__ void phase_attn0(const Params& p, char* smem) {
    const bf16_t* proj0 = p.big + BE_PROJ0; const bf16_t* vt_swa = p.big + BE_VT_SWA; const bf16_t* q_mla = p.big + BE_Q_MLA;
    const bf16_t* k_mla = p.big + BE_K_MLA; const bf16_t* vt_mla = p.big + BE_VT_MLA;
    for (int it = blockIdx.x; it < 1152; it += gridDim.x) {
        int kind, b, hh, qbl; bool lat;
        if (it < 1024) { lat = true; kind = it >> 9; const int r = it & 511; b = r >> 6; hh = (r >> 3) & 7; qbl = r & 7; }
        else { lat = false; const int r = it - 1024; kind = r >> 6; b = (r >> 3) & 7; hh = r & 7; qbl = 0; }
        const int qtok0 = lat ? CTXL + 256 * qbl : 0, row0 = b * TOK + qtok0;
        f32x4 o[4][2]; float m[2], l[2], inv[2];
        if (kind == 0) {
            flash_pass<96, 64, false>(smem, q_mla + (size_t)row0 * 768 + hh * 96, 768, k_mla + (size_t)b * TOK * 768 + hh * 96, 768,
                               vt_mla + (size_t)((b * 8 + hh) * 64) * TOK, CTXL, lat ? TOK : CTXL, qtok0, 0.10206207262f * LOG2E, o, m, l);
            inv[0] = 1.f / l[0]; inv[1] = 1.f / l[1];
            store_o<4>(p.o + (size_t)row0 * 1024 + hh * 64, 1024, o, inv);
        } else {
            int s2s = CTXL, s2e = CTXL;
            if (lat) { const int lo = 256 * qbl - 128, hi = 256 * qbl + 384; s2s = CTXL + (lo > 0 ? lo : 0); s2e = CTXL + (hi < SEQ ? hi : SEQ); }
            flash_pass<64, 64, true>(smem, proj0 + (size_t)row0 * 1024 + 256 + hh * 64, 1024, proj0 + (size_t)b * TOK * 1024 + 896 + (hh >> 2) * 64, 1024,
                               vt_swa + (size_t)((b * 2 + (hh >> 2)) * 64) * TOK, s2s, s2e, qtok0, 0.125f * LOG2E, o, m, l);
            const float sk = p.sink[hh] * LOG2E;
            inv[0] = 1.f / (l[0] + fast_exp2(sk - m[0])); inv[1] = 1.f / (l[1] + fast_exp2(sk - m[1]));
            store_o<4>(p.o + (size_t)row0 * 1024 + 512 + hh * 64, 1024, o, inv);
        }
    }
}

__device__ __forceinline__ void epi_plain(const float* Ct, bf16_t* out, int ldo, int mt, int nt) {
    const int tid = threadIdx.x;
#pragma unroll 1
    for (int i = 0; i < 4; ++i) {
        const int id = tid + NTHREADS * i, r = id >> 4, c0 = (id & 15) * 8;
        float v[8]; load8(Ct + r * LDC + c0, v);
        store8(out + (size_t)(mt * 128 + r) * ldo + nt * 128 + c0, v);
    }
}
__device__ __forceinline__ void phase_gemm_plain(char* smem, const bf16_t* zero16, const bf16_t* A, int lda, const bf16_t* Wt, int K, int ntn2, bf16_t* out, int ldo, bool lat_only) {
    float* Ct = (float*)smem;
    const int nmt2 = lat_only ? 64 : 72;
    TAIL_DECODE(nmt2 * ntn2);
    for (int it = blockIdx.x; it < total_; it += G_) {
        TAIL_ITEM(it, tile, half)
        int mt2 = tile / ntn2; const int nt2 = tile % ntn2;
        if (lat_only) mt2 = (mt2 >> 3) * 9 + 1 + (mt2 & 7);
        if (half < 0) {
            f32x4 acc[8][4];
            gemm_core(smem, A, lda, mt2 * 256, 0, ROWS, mt2 * 256 + 128, 0, ROWS, Wt + (size_t)nt2 * 256 * K, K, K, zero16, acc);
#pragma unroll 1
            for (int ai = 0; ai < 2; ++ai) {
                acc_to_ct(Ct, acc, ai);
                epi_plain(Ct, out, ldo, mt2 * 2 + ai, nt2 * 2);
                epi_plain(Ct + CT_FLOATS, out, ldo, mt2 * 2 + ai, nt2 * 2 + 1);
            }
        } else {
            const int nt = nt2 * 2 + half;
            f32x4 acc[4][4];
            gemm_core_h(smem, A, lda, mt2 * 256, 0, ROWS, mt2 * 256 + 128, 0, ROWS, Wt + (size_t)nt * 128 * K, K, K, zero16, acc);
#pragma unroll 1
            for (int ai = 0; ai < 2; ++ai) { acc_to_ct_h(Ct, acc, ai); epi_plain(Ct, out, ldo, mt2 * 2 + ai, nt); }
        }
    }
}

__device__ __forceinline__ void phase_ln(const Params& p, const float* res_lat, const float* res_ctx, int layer, int gate_idx, const float* lng, const float* lnb,
                                         float* out_lat, float* out_ctx, bool write_h, int hl, int sh_idx, int sc_idx, bool inc_ctx) {
    const int lane = threadIdx.x & 63, w = threadIdx.x >> 6;
    for (int row = blockIdx.x * NWAVES + w; row < ROWS; row += gridDim.x * NWAVES) {
        const int b = row / TOK, j = row % TOK; const bool isc = j < CTXL;
        if (isc && !inc_ctx) continue;
        const size_t ro = isc ? ((size_t)b * CTXL + j) * DM : ((size_t)b * SEQ + (j - CTXL)) * DM;
        const float* rp = (isc ? res_ctx : res_lat) + ro; float* op = (isc ? out_ctx : out_lat) + ro;
        const int bm = isc ? 8 : b;
        const float* gate = p.mod + (size_t)(layer * 9 + bm) * 6144 + gate_idx * 1024;
        bf16_t* fp = p.h + (size_t)row * DM;
        f32x4 y[4]; float sum = 0.f;
#pragma unroll
        for (int i = 0; i < 4; ++i) {
            const int col = i * 256 + lane * 4;
            const f32x4 r = *(const f32x4*)(rp + col), gt = *(const f32x4*)(gate + col); const u32x2 f = *(const u32x2*)(fp + col);
            y[i][0] = ALPHA_RES * r[0] + gt[0] * bflo(f.x); y[i][1] = ALPHA_RES * r[1] + gt[1] * bfhi(f.x);
            y[i][2] = ALPHA_RES * r[2] + gt[2] * bflo(f.y); y[i][3] = ALPHA_RES * r[3] + gt[3] * bfhi(f.y);
            sum += (y[i][0] + y[i][1]) + (y[i][2] + y[i][3]);
        }
        const float mean = wave_sum(sum) * (1.f / DM); float sq = 0.f;
#pragma unroll
        for (int i = 0; i < 4; ++i) { y[i] = y[i] - mean; sq += (y[i][0] * y[i][0] + y[i][1] * y[i][1]) + (y[i][2] * y[i][2] + y[i][3] * y[i][3]); }
        const float rstd = rsqrtf(wave_sum(sq) * (1.f / DM) + 1e-5f);
        const float* mh = p.mod + (size_t)(hl * 9 + bm) * 6144;
#pragma unroll
        for (int i = 0; i < 4; ++i) {
            const int col = i * 256 + lane * 4;
            const f32x4 g = *(const f32x4*)(lng + col), bb = *(const f32x4*)(lnb + col);
            const f32x4 xl = y[i] * rstd * g + bb;
            *(f32x4*)(op + col) = xl;
            if (write_h) {
                const f32x4 sh = *(const f32x4*)(mh + sh_idx * 1024 + col), sc = *(const f32x4*)(mh + sc_idx * 1024 + col);
                u32x2 hv; hv.x = cvt_pk_bf16(xl[0] * (1.f + sc[0]) + sh[0], xl[1] * (1.f + sc[1]) + sh[1]); hv.y = cvt_pk_bf16(xl[2] * (1.f + sc[2]) + sh[2], xl[3] * (1.f + sc[3]) + sh[3]);
                *(u32x2*)(fp + col) = hv;
            }
        }
    }
}

struct SubTile { int alo, ahi, ar0, jm, seg_len; bool valid; };
__device__ __forceinline__ SubTile ffn_subtile(int layer, int b, int sidx) {
    SubTile t; const int cnt = layer == 0 ? 20 : 17; t.valid = sidx < cnt;
    int jm = sidx, seg_off = CTXL, seg_len = SEQ;
    if (layer == 0) { if (sidx < 3) { seg_off = 0; seg_len = CTXL; } else jm = sidx - 3; }
    t.jm = jm; t.seg_len = seg_len; t.alo = b * TOK + seg_off; t.ahi = t.valid ? t.alo + seg_len : t.alo; t.ar0 = t.alo + 126 * jm - 1;
    return t;
}
__device__ __forceinline__ SubTile sel_subtile(const SubTile& a, const SubTile& b, int ai) {
    SubTile t; t.alo = ai ? b.alo : a.alo; t.ahi = ai ? b.ahi : a.ahi; t.ar0 = ai ? b.ar0 : a.ar0; t.jm = ai ? b.jm : a.jm; t.seg_len = ai ? b.seg_len : a.seg_len; t.valid = ai ? b.valid : a.valid; return t;
}
__device__ __forceinline__ void epi_ffn1(const Params& p, const float* Ct, int layer, const SubTile& t, int hc0) {
    if (!t.valid) return;
    const int tid = threadIdx.x; bf16_t* hid = p.big + BE_HID;
    const float* cw = p.conv_w + (size_t)layer * 3 * DFF; const float* cb = p.conv_b + (size_t)layer * DFF;
    const int c0 = (tid & 7) * 8, hc = hc0 + c0;
    float w0[8], w1[8], w2[8], bs[8];
    load8(cw + hc, w0); load8(cw + DFF + hc, w1); load8(cw + 2 * DFF + hc, w2); load8(cb + hc, bs);
#pragma unroll
    for (int i = 0; i < 2; ++i) {
        const int r = (tid + NTHREADS * i) >> 3;
        const int srow = 126 * t.jm - 1 + r;
        if (r < 1 || r > 126 || srow >= t.seg_len) continue;
        float gm[8], g0[8], gp[8], u[8], hv[8];
        load8(Ct + (r - 1) * LDC + c0, gm); load8(Ct + r * LDC + c0, g0); load8(Ct + (r + 1) * LDC + c0, gp); load8(Ct + r * LDC + 64 + c0, u);
#pragma unroll
        for (int e = 0; e < 8; ++e) { const float cv = gm[e] * w0[e] + g0[e] * w1[e] + gp[e] * w2[e] + bs[e]; hv[e] = cv / (1.f + __expf(-cv)) * u[e]; }
        store8(hid + (size_t)(t.alo + srow) * DFF + hc, hv);
    }
}
__device__ __forceinline__ void phase_ffn1(const Params& p, char* smem, int layer) {
    float* Ct = (float*)smem;
    const bf16_t* wgu = p.wt_gate + (size_t)layer * 5632 * 1024;
    const int npb = layer == 0 ? 10 : 9;
    NOTAIL_DECODE(8 * npb * 22);
    for (int it0 = blockIdx.x; it0 < total_; it0 += G_) {
        TAIL_ITEM(it0, it, half)
        int mt2, nt2; const int nfirst = 8 * npb * 16;
        if (it < nfirst) { mt2 = it >> 4; nt2 = it & 15; } else { const int r = it - nfirst; mt2 = r / 6; nt2 = 16 + r % 6; }
        const int b = mt2 / npb, J = mt2 % npb;
        const SubTile t0 = ffn_subtile(layer, b, 2 * J), t1 = ffn_subtile(layer, b, 2 * J + 1);
        if (half < 0) {
            f32x4 acc[8][4];
            gemm_core(smem, p.h, DM, t0.ar0, t0.alo, t0.ahi, t1.ar0, t1.alo, t1.ahi, wgu + (size_t)nt2 * 256 * DM, DM, DM, (const bf16_t*)p.bar, acc);
#pragma unroll 1
            for (int ai = 0; ai < 2; ++ai) {
                acc_to_ct(Ct, acc, ai);
                const SubTile t = sel_subtile(t0, t1, ai);
                epi_ffn1(p, Ct, layer, t, (nt2 * 2) * 64);
                epi_ffn1(p, Ct + CT_FLOATS, layer, t, (nt2 * 2 + 1) * 64);
            }
        } else {
            const int nt = nt2 * 2 + half;
            f32x4 acc[4][4];
            gemm_core_h(smem, p.h, DM, t0.ar0, t0.alo, t0.ahi, t1.ar0, t1.alo, t1.ahi, wgu + (size_t)nt * 128 * DM, DM, DM, (const bf16_t*)p.bar, acc);
#pragma unroll 1
            for (int ai = 0; ai < 2; ++ai) { acc_to_ct_h(Ct, acc, ai); epi_ffn1(p, Ct, layer, sel_subtile(t0, t1, ai), nt * 64); }
        }
    }
}

__device__ __forceinline__ void epi_proj1(const Params& p, const float* Ct, int mt, int nt) {
    const int tid = threadIdx.x;
    bf16_t* qd = p.big + BE_QD; bf16_t* kd = p.big + BE_KD; bf16_t* vt_d = p.big + BE_VT_D;
    extern __shared__ __attribute__((aligned(16))) char smem_dyn_[]; const float* lds_tab_ = (const float*)(smem_dyn_ + SMEM_BYTES);
    const float* rope64 = lds_tab_ + MISC_ROPE64;
    const int b = mt / 18, jt = mt % 18; const bool is_ctx = jt < 2; const int row0 = mt * 128, tok0 = jt * 128;
    if (nt >= 16) {
        const int hh = nt - 16;
#pragma unroll 1
        for (int i = 0; i < 4; ++i) { const int id = tid + NTHREADS * i, c = id & 127, rc = id >> 7;
            store_col8(Ct, c, rc, vt_d + (size_t)((b * 8 + hh) * 128 + c) * TOK + tok0 + rc * 8, nullptr); }
    } else {
        bf16_t* dst = nt < 8 ? qd : kd; const int dc = (nt & 7) * 128;
#pragma unroll 1
        for (int i = 0; i < 4; ++i) {
            const int id = tid + NTHREADS * i, r = id >> 4, c0 = (id & 15) * 8;
            const float* rowp = Ct + r * LDC; float v[8]; load8(rowp + c0, v);
            if (!is_ctx) rope8(rowp, c0, 64, tok0 + r - CTXL, rope64, v);
            store8(dst + (size_t)(row0 + r) * 1024 + dc + c0, v);
        }
    }
}
__device__ __forceinline__ void phase_proj1(const Params& p, char* smem) {
    float* Ct = (float*)smem;
    TAIL_DECODE(72 * 12);
    for (int it0 = blockIdx.x; it0 < total_; it0 += G_) {
        TAIL_ITEM(it0, it, half)
        int mt2, nt2;
        if (it < 72 * 8) { mt2 = it >> 3; nt2 = it & 7; } else { const int r = it - 72 * 8; mt2 = r >> 2; nt2 = 8 + (r & 3); }
        if ((mt2 % 9) == 0 && nt2 < 4) continue;
        if (half < 0) {
            f32x4 acc[8][4];
            gemm_core(smem, p.h, DM, mt2 * 256, 0, ROWS, mt2 * 256 + 128, 0, ROWS, p.wt_din + (size_t)nt2 * 256 * DM, DM, DM, (const bf16_t*)p.bar, acc);
#pragma unroll 1
            for (int ai = 0; ai < 2; ++ai) {
                acc_to_ct(Ct, acc, ai);
                epi_proj1(p, Ct, mt2 * 2 + ai, nt2 * 2);
                epi_proj1(p, Ct + CT_FLOATS, mt2 * 2 + ai, nt2 * 2 + 1);
            }
        } else {
            const int nt = nt2 * 2 + half;
            f32x4 acc[4][4];
            gemm_core_h(smem, p.h, DM, mt2 * 256, 0, ROWS, mt2 * 256 + 128, 0, ROWS, p.wt_din + (size_t)nt * 128 * DM, DM, DM, (const bf16_t*)p.bar, acc);
#pragma unroll 1
            for (int ai = 0; ai < 2; ++ai) { acc_to_ct_h(Ct, acc, ai); epi_proj1(p, Ct, mt2 * 2 + ai, nt); }
        }
    }
}

__device__ __forceinline__ void phase_attn1(const Params& p, char* smem) {
    const bf16_t* qd = p.big + BE_QD; const bf16_t* kd = p.big + BE_KD; const bf16_t* vt_d = p.big + BE_VT_D;
    const int lane = threadIdx.x & 63, w = threadIdx.x >> 6, fr = lane & 15, fq = lane >> 4, wq0 = w * 32;
    const float lam = p.misc[MISC_LAM];
    for (int it = blockIdx.x; it < 512; it += gridDim.x) {
        const int b = it >> 6, hh = (it >> 3) & 7, qbl = it & 7; const int qtok0 = CTXL + 256 * qbl, row0 = b * TOK + qtok0;
        const bf16_t* vt = vt_d + (size_t)((b * 8 + hh) * 128) * TOK;
        f32x4 o[8][2]; float m[2], l[2];
        flash_pass<64, 128, false>(smem, qd + (size_t)row0 * 1024 + hh * 128, 1024, kd + (size_t)b * TOK * 1024 + hh * 128, 1024, vt, CTXL, TOK, qtok0, 0.125f * LOG2E, o, m, l);
        {
            float inv[2]; inv[0] = 1.f / l[0]; inv[1] = 1.f / l[1];
            store_o<8>(p.o + (size_t)row0 * 1024 + hh * 128, 1024, o, inv);
        }
        flash_pass<64, 128, false>(smem, qd + (size_t)row0 * 1024 + hh * 128 + 64, 1024, kd + (size_t)b * TOK * 1024 + hh * 128 + 64, 1024, vt, CTXL, TOK, qtok0, 0.125f * LOG2E, o, m, l);
#pragma unroll
        for (int nq = 0; nq < 2; ++nq) {
            const float inv = lam / l[nq]; float ss = 0.f;
            const bf16_t* o1p = p.o + (size_t)(row0 + wq0 + nq * 16 + fr) * 1024 + hh * 128;
#pragma unroll
            for (int md = 0; md < 8; ++md) {
                const u32x2 o1 = *(const u32x2*)(o1p + md * 16 + fq * 4);
                o[md][nq][0] = bflo(o1.x) - o[md][nq][0] * inv; o[md][nq][1] = bfhi(o1.x) - o[md][nq][1] * inv;
                o[md][nq][2] = bflo(o1.y) - o[md][nq][2] * inv; o[md][nq][3] = bfhi(o1.y) - o[md][nq][3] * inv;
                ss += (o[md][nq][0] * o[md][nq][0] + o[md][nq][1] * o[md][nq][1]) + (o[md][nq][2] * o[md][nq][2] + o[md][nq][3] * o[md][nq][3]);
            }
            ss += __shfl_xor(ss, 16); ss += __shfl_xor(ss, 32);
            const float rstd = rsqrtf(ss * (1.f / 128.f) + 1e-6f) * (1.f - LAMBDA_INIT);
            bf16_t* op = p.o + (size_t)(row0 + wq0 + nq * 16 + fr) * 1024 + hh * 128;
#pragma unroll
            for (int md = 0; md < 8; ++md) {
                const f32x4 g = *(const f32x4*)(p.subln + md * 16 + fq * 4);
                u32x2 v; v.x = cvt_pk_bf16(o[md][nq][0] * rstd * g[0], o[md][nq][1] * rstd * g[1]); v.y = cvt_pk_bf16(o[md][nq][2] * rstd * g[2], o[md][nq][3] * rstd * g[3]);
                *(u32x2*)(op + md * 16 + fq * 4) = v;
            }
        }
    }
}

constexpr int N_PHASES = 17;
#ifndef ONLY_PHASE
#define ONLY_PHASE -1
#endif
#define PH_ON(k) (ONLY_PHASE < 0 || ONLY_PHASE == (k))
#ifndef DUP_MASK
#define DUP_MASK 0
#endif
#define RUN_PHASE(k, call) if constexpr (PH_ON(k)) { if (ph_lo <= (k) && (k) < ph_hi) { call; if ((k) + 1 < ph_hi) xcd_barrier(xb); } }
__global__ void __launch_bounds__(NTHREADS, 2) mega_fwd(Params p, int ph_lo, int ph_hi) {
    extern __shared__ __attribute__((aligned(16))) char smem[];
    __shared__ uint4 xb_words;
    if (threadIdx.x == 0) xb_words = make_uint4(0u, 0u, 0u, 0u);
    __syncthreads();
    const XcdBarrier xb = xcd_barrier_post(p.bar, (volatile LAS unsigned*)&xb_words);
    if (ph_lo < 0) cg::this_grid().sync();
    RUN_PHASE(0, phase_prologue(p, smem))
    { float* lt = (float*)(smem + SMEM_BYTES); for (int i = threadIdx.x; i < 3072; i += NTHREADS) lt[i] = p.misc[i]; __syncthreads(); }
    RUN_PHASE(1, phase_h0(p))
    RUN_PHASE(2, phase_proj0(p, smem))
    RUN_PHASE(3, phase_mla_up(p, smem))
    RUN_PHASE(4, phase_attn0(p, smem))
    RUN_PHASE(5, phase_gemm_plain(smem, (const bf16_t*)p.bar, p.o, 1024, p.wt_out0, 1024, 4, p.h, 1024, false))
    RUN_PHASE(6, phase_ln(p, p.x, p.ctx, 0, 2, p.ln1_g, p.ln1_b, p.out, p.xc, true, 0, 3, 4, true))
    RUN_PHASE(7, phase_ffn1(p, smem, 0))
    RUN_PHASE(8, phase_gemm_plain(smem, (const bf16_t*)p.bar, p.big + BE_HID, DFF, p.wt_down, DFF, 4, p.h, 1024, false))
    RUN_PHASE(9, phase_ln(p, p.out, p.xc, 0, 5, p.ln2_g, p.ln2_b, p.out, p.xc, true, 1, 0, 1, true))
    RUN_PHASE(10, phase_proj1(p, smem))
    RUN_PHASE(11, phase_attn1(p, smem))
    RUN_PHASE(12, phase_gemm_plain(smem, (const bf16_t*)p.bar, p.o, 1024, p.wt_dout, 1024, 4, p.h, 1024, true))
    RUN_PHASE(13, phase_ln(p, p.out, p.xc, 1, 2, p.ln1_g + DM, p.ln1_b + DM, p.out, p.xc, true, 1, 3, 4, false))
    RUN_PHASE(14, phase_ffn1(p, smem, 1))
    RUN_PHASE(15, phase_gemm_plain(smem, (const bf16_t*)p.bar, p.big + BE_HID, DFF, p.wt_down + (size_t)1024 * 2816, DFF, 4, p.h, 1024, true))
    RUN_PHASE(16, phase_ln(p, p.out, p.xc, 1, 5, p.ln2_g + DM, p.ln2_b + DM, p.out, p.xc, false, 1, 0, 1, false))
}

extern "C" void kernel_launch(void* const* d_in, const int* in_sizes, int n_in, void* d_out, int out_size, void* d_ws, size_t ws_size, hipStream_t stream) {
    static int grid = 0;
    if (grid == 0) {
        if (n_in != 29 || out_size != NBATCH * SEQ * DM || ws_size < WS_END) {
            fprintf(stderr, "kernel_launch: unexpected shapes (n_in %d, out %d, ws %zu, need %zu)\n", n_in, out_size, ws_size, (size_t)WS_END); grid = -1; return; }
        int dev = 0, cus = 0, per_cu = 0;
        hipGetDevice(&dev); hipDeviceGetAttribute(&cus, hipDeviceAttributeMultiprocessorCount, dev);
        if (hipFuncSetAttribute((const void*)mega_fwd, hipFuncAttributeMaxDynamicSharedMemorySize, SMEM_BYTES + SMEM_TABLES) != hipSuccess) { fprintf(stderr, "kernel_launch: hipFuncSetAttribute failed\n"); grid = -1; return; }
        if (hipOccupancyMaxActiveBlocksPerMultiprocessor(&per_cu, (const void*)mega_fwd, NTHREADS, SMEM_BYTES + SMEM_TABLES) != hipSuccess || per_cu < 1) { fprintf(stderr, "kernel_launch: occupancy query failed\n"); grid = -1; return; }
        if (per_cu > 1) per_cu = 1;
        grid = cus * per_cu;
        fprintf(stderr, "kernel_launch: grid %d (%d CUs x %d)\n", grid, cus, per_cu);
    }
    if (grid < 0) return;
    Params p{};
    const float* const* in = (const float* const*)d_in;
    p.x = in[0]; p.c = in[1]; p.ctx = in[2]; p.c_ctx = in[3]; p.w_mod = in[4]; p.b_mod = in[5]; p.ln1_g = in[6]; p.ln1_b = in[7]; p.ln2_g = in[8]; p.ln2_b = in[9];
    p.w_gate = in[10]; p.w_up = in[11]; p.conv_w = in[12]; p.conv_b = in[13]; p.w_down = in[14];
    p.ab_w_in = in[15]; p.q_norm = in[16]; p.w_qb = in[17]; p.kv_norm = in[18]; p.w_kvb = in[19]; p.sink = in[20]; p.ab_w_out = in[21];
    p.d_w_in = in[22]; p.lq1 = in[23]; p.lk1 = in[24]; p.lq2 = in[25]; p.lk2 = in[26]; p.subln = in[27]; p.d_w_out = in[28];
    p.out = (float*)d_out;
    char* ws = (char*)d_ws;
    p.wt_in0 = (bf16_t*)(ws + OFF_WT_IN0); p.wt_qb = (bf16_t*)(ws + OFF_WT_QB); p.wt_kvb = (bf16_t*)(ws + OFF_WT_KVB); p.wt_out0 = (bf16_t*)(ws + OFF_WT_OUT0);
    p.wt_din = (bf16_t*)(ws + OFF_WT_DIN); p.wt_dout = (bf16_t*)(ws + OFF_WT_DOUT); p.wt_gate = (bf16_t*)(ws + OFF_WT_GATE); p.wt_up = (bf16_t*)(ws + OFF_WT_UP);
    p.wt_down = (bf16_t*)(ws + OFF_WT_DOWN); p.mod = (float*)(ws + OFF_MOD); p.misc = (float*)(ws + OFF_MISC); p.bar = (unsigned*)(ws + OFF_BAR); p.xc = (float*)(ws + OFF_XC);
    p.h = (bf16_t*)(ws + OFF_H); p.o = (bf16_t*)(ws + OFF_O); p.big = (bf16_t*)(ws + OFF_BIG);
    if (hipMemsetAsync(ws + OFF_BAR, 0, 16384, stream) != hipSuccess) { fprintf(stderr, "kernel_launch: memset failed\n"); return; }
#if MULTI_LAUNCH
    for (int ph = 0; ph < N_PHASES; ++ph) hipLaunchKernelGGL(mega_fwd, dim3(grid), dim3(NTHREADS), SMEM_BYTES + SMEM_TABLES, stream, p, ph, ph + 1);
#else
    int lo = 0, hi = N_PHASES;
    void* args[] = {&p, &lo, &hi};
    hipError_t e = hipLaunchCooperativeKernel((const void*)mega_fwd, dim3(grid), dim3(NTHREADS), args, SMEM_BYTES + SMEM_TABLES, stream);
    if (e != hipSuccess) fprintf(stderr, "kernel_launch: cooperative launch failed: %s (grid %d)\n", hipGetErrorString(e), grid);
#if EXTRA_PHASE >= 0
    int lo2 = EXTRA_PHASE, hi2 = EXTRA_PHASE + 1;
    void* args2[] = {&p, &lo2, &hi2};
    (void)hipLaunchCooperativeKernel((const void*)mega_fwd, dim3(grid), dim3(NTHREADS), args2, SMEM_BYTES + SMEM_TABLES, stream);
#endif
#endif
}
```

```cpp
#include <hip/hip_runtime.h>
#include <hip/hip_cooperative_groups.h>
#include <cstdio>
#include <cstdint>
namespace cg = cooperative_groups;

#ifndef EXTRA_PHASE
#define EXTRA_PHASE -1
#endif
#ifndef EXTRA_SYNCS
#define EXTRA_SYNCS 0
#endif
#ifndef MULTI_LAUNCH
#define MULTI_LAUNCH 0
#endif

typedef unsigned short bf16_t;
typedef short bf16x8 __attribute__((ext_vector_type(8)));
typedef float f32x4 __attribute__((ext_vector_type(4)));
typedef unsigned u32x4 __attribute__((ext_vector_type(4)));
typedef unsigned u32x2 __attribute__((ext_vector_type(2)));

constexpr int NBATCH = 8, SEQ = 2048, CTXL = 256, TOK = 2304, ROWS = NBATCH * TOK, DM = 1024, DFF = 2816;
constexpr int NTHREADS = 512, NWAVES = 8;
constexpr int LDC = 132;
constexpr int CT_FLOATS = 128 * 132;
constexpr int SMEM_TABLES = 12288;
constexpr int SMEM_BYTES = 139264;
constexpr float ALPHA_RES = 1.41421356237f;
constexpr float LOG2E = 1.44269504089f;
constexpr float LAMBDA_INIT = 0.35550907f;

struct Params {
    const float *x, *c, *ctx, *c_ctx, *w_mod, *b_mod, *ln1_g, *ln1_b, *ln2_g, *ln2_b;
    const float *w_gate, *w_up, *conv_w, *conv_b, *w_down;
    const float *ab_w_in, *q_norm, *w_qb, *kv_norm, *w_kvb, *sink, *ab_w_out;
    const float *d_w_in, *lq1, *lk1, *lq2, *lk2, *subln, *d_w_out;
    float* out;
    bf16_t *wt_in0, *wt_qb, *wt_kvb, *wt_out0, *wt_din, *wt_dout, *wt_gate, *wt_up, *wt_down;
    float *mod, *misc, *xc;
    unsigned* bar;
    bf16_t *h, *o, *big;
};

constexpr size_t SZ_WT_IN0 = 1280ull * 1024 * 2, SZ_WT_QB = 768ull * 256 * 2, SZ_WT_KVB = 1024ull * 128 * 2, SZ_WT_SQ = 1024ull * 1024 * 2,
                 SZ_WT_DIN = 3072ull * 1024 * 2, SZ_WT_FF = 2ull * 2816 * 1024 * 2;
constexpr size_t OFF_WT_IN0 = 0, OFF_WT_QB = OFF_WT_IN0 + SZ_WT_IN0, OFF_WT_KVB = OFF_WT_QB + SZ_WT_QB, OFF_WT_OUT0 = OFF_WT_KVB + SZ_WT_KVB,
                 OFF_WT_DIN = OFF_WT_OUT0 + SZ_WT_SQ, OFF_WT_DOUT = OFF_WT_DIN + SZ_WT_DIN, OFF_WT_GATE = OFF_WT_DOUT + SZ_WT_SQ,
                 OFF_WT_UP = OFF_WT_GATE + SZ_WT_FF, OFF_WT_DOWN = OFF_WT_UP + SZ_WT_FF, OFF_MOD = OFF_WT_DOWN + SZ_WT_FF,
                 OFF_MISC = OFF_MOD + 2ull * 9 * 6144 * 4, OFF_BAR = OFF_MISC + 65536, OFF_XC = OFF_BAR + 16384, OFF_H = OFF_XC + 2048ull * 1024 * 4,
                 OFF_O = OFF_H + (size_t)ROWS * 1024 * 2, OFF_BIG = OFF_O + (size_t)ROWS * 1024 * 2;
constexpr size_t BE_PROJ0 = 0, BE_VT_SWA = BE_PROJ0 + (size_t)ROWS * 1024, BE_Q_MLA = BE_VT_SWA + 8ull * 2 * 64 * TOK,
                 BE_K_MLA = BE_Q_MLA + (size_t)ROWS * 768, BE_VT_MLA = BE_K_MLA + (size_t)ROWS * 768, BE_END0 = BE_VT_MLA + 8ull * 8 * 64 * TOK;
constexpr size_t BE_QD = 0, BE_KD = BE_QD + (size_t)ROWS * 1024, BE_VT_D = BE_KD + (size_t)ROWS * 1024, BE_END1 = BE_VT_D + 8ull * 8 * 128 * TOK;
constexpr size_t BE_HID = 0, BE_END2 = (size_t)ROWS * DFF;
constexpr size_t BIG_ELEMS = BE_END0 > BE_END1 ? (BE_END0 > BE_END2 ? BE_END0 : BE_END2) : (BE_END1 > BE_END2 ? BE_END1 : BE_END2);
constexpr size_t WS_END = OFF_BIG + BIG_ELEMS * 2;
constexpr int MISC_ROPE64 = 0, MISC_ROPE32 = 2048, MISC_LAM = 3072;

__device__ __forceinline__ unsigned cvt_pk_bf16(float lo, float hi) { unsigned r; asm("v_cvt_pk_bf16_f32 %0, %1, %2" : "=v"(r) : "v"(lo), "v"(hi)); return r; }
__device__ __forceinline__ float bf2f(unsigned short v) { return __uint_as_float((unsigned)v << 16); }
__device__ __forceinline__ float bflo(unsigned v) { return __uint_as_float(v << 16); }
__device__ __forceinline__ float bfhi(unsigned v) { return __uint_as_float(v & 0xffff0000u); }
__device__ __forceinline__ void store8(bf16_t* dst, const float (&v)[8]) {
    u32x4 w; w.x = cvt_pk_bf16(v[0], v[1]); w.y = cvt_pk_bf16(v[2], v[3]); w.z = cvt_pk_bf16(v[4], v[5]); w.w = cvt_pk_bf16(v[6], v[7]);
    *(u32x4*)dst = w;
}
__device__ __forceinline__ float wave_sum(float v) {
#pragma unroll
    for (int o = 1; o < 64; o <<= 1) v += __shfl_xor(v, o);
    return v;
}
__device__ __forceinline__ float fast_exp2(float x) { return __builtin_amdgcn_exp2f(x); }


#define XB_TMO      128
#define XB_XCNT(j)  (256  + 64 * (j))
#define XB_XSUB(j)  (1280 + 64 * (j))
#define XB_XGEN(j)  (2304 + 64 * (j))
#define XB_TOP      3328
#define XB_TOPGEN   3392
#define XCD_BAR_WORDS 3456
#define XB_SPIN_CAP (1u << 18)
#define LAS __attribute__((address_space(3)))
__device__ __forceinline__ unsigned xb_ld(unsigned* p)              { return __hip_atomic_load(p, __ATOMIC_RELAXED, __HIP_MEMORY_SCOPE_AGENT); }
__device__ __forceinline__ unsigned xb_add(unsigned* p, unsigned v) { return __hip_atomic_fetch_add(p, v, __ATOMIC_RELAXED, __HIP_MEMORY_SCOPE_AGENT); }
__device__ __forceinline__ unsigned xb_xcc_id() { return (unsigned)__builtin_amdgcn_s_getreg((3 << 11) | 20) & 0xFu; }
#define XB_SPIN(cond, bar) do { unsigned _sp = 0; while (cond) { __builtin_amdgcn_s_sleep(1); \
    if ((++_sp & 255u) == 0u) { if (xb_ld(&(bar)[XB_TMO])) break; if (_sp > XB_SPIN_CAP) { atomicAdd(&(bar)[XB_TMO], 1u); break; } } } } while (0)
struct XcdBarrier { unsigned* bar; unsigned x; volatile LAS unsigned* st; };
__device__ __forceinline__ XcdBarrier xcd_barrier_post(unsigned* bar, volatile LAS unsigned* st) {
    XcdBarrier b; b.bar = bar; b.x = xb_xcc_id(); b.st = st;
    if (threadIdx.x == 0) (void)xb_add(&bar[XB_XCNT(b.x)], 1u);
    return b;
}
__device__ __forceinline__ void xcd_barrier_complete(unsigned* bar, unsigned x, unsigned& nloc, unsigned& nx) {
    const unsigned G = gridDim.x * gridDim.y * gridDim.z;
    unsigned sum, cnt, mine, sp = 0u;
    for (;;) {
        sum = 0u; cnt = 0u; mine = 0u;
#pragma unroll
        for (unsigned j = 0; j < 16; ++j) { const unsigned c = xb_ld(&bar[XB_XCNT(j)]); sum += c; cnt += (c > 0u) ? 1u : 0u; mine = (j == x) ? c : mine; }
        if (sum == G) break;
        __builtin_amdgcn_s_sleep(1);
        if ((++sp & 255u) == 0u) { if (xb_ld(&bar[XB_TMO])) break; if (sp > XB_SPIN_CAP) { atomicAdd(&bar[XB_TMO], 1u); break; } }
    }
    nloc = mine > 0u ? mine : 1u; nx = cnt > 0u ? cnt : 1u;
}
__device__ __forceinline__ void xcd_barrier(const XcdBarrier& b) {
    asm volatile("s_waitcnt vmcnt(0)" ::: "memory");
    __syncthreads();
    if (threadIdx.x == 0) {
        unsigned* bar = b.bar;
        __builtin_amdgcn_s_waitcnt(0);
        unsigned nloc = b.st[0], nx = b.st[1];
        if (nloc == 0u) { xcd_barrier_complete(bar, b.x, nloc, nx); b.st[0] = nloc; b.st[1] = nx; }
        const unsigned old = xb_add(&bar[XB_XSUB(b.x)], 1u);
        const unsigned gen = old / nloc;
        if (old + 1u == (gen + 1u) * nloc) {
            __builtin_amdgcn_fence(__ATOMIC_RELEASE, "agent");
            asm volatile("s_waitcnt vmcnt(0)" ::: "memory");
            const unsigned og = xb_add(&bar[XB_TOP], 1u);
            const unsigned tg = og / nx;
            if (og + 1u == (tg + 1u) * nx) xb_add(&bar[XB_TOPGEN], 1u);
            else XB_SPIN(xb_ld(&bar[XB_TOPGEN]) == tg, bar);
            __builtin_amdgcn_fence(__ATOMIC_ACQUIRE, "agent");
            xb_add(&bar[XB_XGEN(b.x)], 1u);
            asm volatile("s_waitcnt vmcnt(0)" ::: "memory");
        } else {
            XB_SPIN(xb_ld(&bar[XB_XGEN(b.x)]) == gen, bar);
            __builtin_amdgcn_fence(__ATOMIC_ACQUIRE, "agent");
            asm volatile("s_waitcnt vmcnt(0)" ::: "memory");
        }
    }
    __syncthreads();
}

__device__ __forceinline__ void mod_item(const Params& p, char* smem, int it) {
    float* s_silu = (float*)smem;
    float* red = (float*)(smem + 9 * 1024 * 4);
    const int tid = threadIdx.x, lane = tid & 63, w = tid >> 6;
    const int layer = it / 96, col0 = (it % 96) * 64;
    for (int idx = tid; idx < 9 * 1024; idx += NTHREADS) {
        const int b = idx >> 10, k = idx & 1023;
        const float v = (b < 8) ? p.c[b * 1024 + k] : p.c_ctx[k];
        s_silu[idx] = v / (1.f + __expf(-v));
    }
    __syncthreads();
    float acc[9];
#pragma unroll
    for (int b = 0; b < 9; ++b) acc[b] = 0.f;
    const float* wp = p.w_mod + (size_t)layer * 1024 * 6144 + (size_t)(w * 128) * 6144 + col0 + lane;
    for (int kk = 0; kk < 128; kk += 8) {
        float wv[8];
#pragma unroll
        for (int u = 0; u < 8; ++u) wv[u] = wp[(size_t)(kk + u) * 6144];
#pragma unroll
        for (int b = 0; b < 9; ++b) {
            const f32x4 s0 = *(const f32x4*)(s_silu + b * 1024 + w * 128 + kk), s1 = *(const f32x4*)(s_silu + b * 1024 + w * 128 + kk + 4);
            acc[b] += s0[0] * wv[0] + s0[1] * wv[1] + s0[2] * wv[2] + s0[3] * wv[3] + s1[0] * wv[4] + s1[1] * wv[5] + s1[2] * wv[6] + s1[3] * wv[7];
        }
    }
#pragma unroll
    for (int b = 0; b < 9; ++b) red[(w * 9 + b) * 64 + lane] = acc[b];
    __syncthreads();
    for (int idx = tid; idx < 9 * 64; idx += NTHREADS) {
        const int b = idx >> 6, l = idx & 63;
        float s = 0.f;
#pragma unroll
        for (int ww = 0; ww < NWAVES; ++ww) s += red[(ww * 9 + b) * 64 + l];
        p.mod[(size_t)(layer * 9 + b) * 6144 + col0 + l] = s + p.b_mod[layer * 6144 + col0 + l];
    }
}

__device__ __forceinline__ void table_item(const Params& p) {
    const int tid = threadIdx.x;
    for (int idx = tid; idx < 64 * 16; idx += NTHREADS) {
        const int pi = idx >> 4, i = idx & 15;
        const float freq = exp2f(-(float)i * (13.28771238f / 16.f));
        const float ang = (float)pi * freq;
        p.misc[MISC_ROPE64 + idx * 2] = __cosf(ang); p.misc[MISC_ROPE64 + idx * 2 + 1] = __sinf(ang);
    }
    for (int idx = tid; idx < 64 * 8; idx += NTHREADS) {
        const int pi = idx >> 3, i = idx & 7;
        const float freq = exp2f(-(float)i * (13.28771238f / 8.f));
        const float ang = (float)pi * freq;
        p.misc[MISC_ROPE32 + idx * 2] = __cosf(ang); p.misc[MISC_ROPE32 + idx * 2 + 1] = __sinf(ang);
    }
    if (tid == 0) {
        float s1 = 0.f, s2 = 0.f;
        for (int i = 0; i < 64; ++i) { s1 += p.lq1[i] * p.lk1[i]; s2 += p.lq2[i] * p.lk2[i]; }
        p.misc[MISC_LAM] = __expf(s1) - __expf(s2) + LAMBDA_INIT;
    }
}

__device__ __forceinline__ void transpose_tile(char* smem, const float* src, int K, int Nsrc, bf16_t* dst, int ntn, int mode, const float* gain, int tile, int dmul = 1, int dadd = 0) {
    float* t = (float*)smem;
    const int tid = threadIdx.x, tx = tid & 63, ty = tid >> 6;
    const int kt = tile / ntn, nt = tile % ntn;
    const int np = nt * 64 + tx;
    int n = np;
    if (mode == 1) { n = np < 896 ? np : (np < 1024 ? 928 + (np - 896) : (np < 1152 ? 1056 + (np - 1024) : (np < 1184 ? 896 + (np - 1152) : -1))); }
    else if (mode == 2) { if (np < 512) n = (np >> 6) * 96 + (np & 63); else { const int m = np - 512; n = (m >> 5) * 96 + 64 + (m & 31); } }
#pragma unroll
    for (int i = 0; i < 8; ++i) {
        const int kl = ty + 8 * i, k = kt * 64 + kl;
        float v = 0.f;
        if (n >= 0) { v = src[(size_t)k * Nsrc + n]; if (gain) v *= gain[k]; }
        t[kl * 65 + tx] = v;
    }
    __syncthreads();
#pragma unroll
    for (int i = 0; i < 8; ++i) {
        const int nl = ty + 8 * i;
        dst[(size_t)((nt * dmul + dadd) * 64 + nl) * K + kt * 64 + tx] = (bf16_t)(cvt_pk_bf16(t[tx * 65 + nl], 0.f) & 0xffffu);
    }
}

__device__ __forceinline__ void transpose_item(const Params& p, char* smem, int r) {
    constexpr int T0 = 16 * 20, T1 = 4 * 12, T2 = 2 * 16, T3 = 16 * 16, T4 = 16 * 48, T5 = 16 * 16, TF = 16 * 44;
    if (r < T0) { transpose_tile(smem, p.ab_w_in, 1024, 1184, p.wt_in0, 20, 1, nullptr, r); return; } r -= T0;
    if (r < T1) { transpose_tile(smem, p.w_qb, 256, 768, p.wt_qb, 12, 2, p.q_norm, r); return; } r -= T1;
    if (r < T2) { transpose_tile(smem, p.w_kvb, 128, 1024, p.wt_kvb, 16, 0, p.kv_norm, r); return; } r -= T2;
    if (r < T3) { transpose_tile(smem, p.ab_w_out, 1024, 1024, p.wt_out0, 16, 0, nullptr, r); return; } r -= T3;
    if (r < T4) { transpose_tile(smem, p.d_w_in, 1024, 3072, p.wt_din, 48, 0, nullptr, r); return; } r -= T4;
    if (r < T5) { transpose_tile(smem, p.d_w_out, 1024, 1024, p.wt_dout, 16, 0, nullptr, r); return; } r -= T5;
    {
        const int j = r / TF, rr = r % TF;
        if (j < 2) transpose_tile(smem, p.w_gate + (size_t)j * 1024 * 2816, 1024, 2816, p.wt_gate + (size_t)j * 5632 * 1024, 44, 0, nullptr, rr, 2, 0);
        else if (j < 4) transpose_tile(smem, p.w_up + (size_t)(j - 2) * 1024 * 2816, 1024, 2816, p.wt_gate + (size_t)(j - 2) * 5632 * 1024, 44, 0, nullptr, rr, 2, 1);
        else transpose_tile(smem, p.w_down + (size_t)(j - 4) * 2816 * 1024, 2816, 1024, p.wt_down + (size_t)(j - 4) * 1024 * 2816, 16, 0, nullptr, rr);
    }
}
constexpr int N_TR_TILES = 16 * 20 + 4 * 12 + 2 * 16 + 16 * 16 + 16 * 48 + 16 * 16 + 6 * 16 * 44;

__device__ __forceinline__ void phase_prologue(const Params& p, char* smem) {
    const int total = 193 + N_TR_TILES;
    for (int it = blockIdx.x; it < total; it += gridDim.x) {
        if (it < 192) mod_item(p, smem, it);
        else if (it == 192) table_item(p);
        else transpose_item(p, smem, it - 193);
        __syncthreads();
    }
}

__device__ __forceinline__ void phase_h0(const Params& p) {
    const int lane = threadIdx.x & 63, w = threadIdx.x >> 6;
    for (int row = blockIdx.x * NWAVES + w; row < ROWS; row += gridDim.x * NWAVES) {
        const int b = row / TOK, j = row % TOK; const bool isc = j < CTXL;
        const float* rp = isc ? p.ctx + ((size_t)b * CTXL + j) * DM : p.x + ((size_t)b * SEQ + (j - CTXL)) * DM;
        const float* md = p.mod + (size_t)(0 * 9 + (isc ? 8 : b)) * 6144;
#pragma unroll 1
        for (int i = 0; i < 4; ++i) {
            const int col = i * 256 + lane * 4;
            const f32x4 v = *(const f32x4*)(rp + col), sh = *(const f32x4*)(md + col), sc = *(const f32x4*)(md + 1024 + col);
            u32x2 o; o.x = cvt_pk_bf16(v[0] * (1.f + sc[0]) + sh[0], v[1] * (1.f + sc[1]) + sh[1]); o.y = cvt_pk_bf16(v[2] * (1.f + sc[2]) + sh[2], v[3] * (1.f + sc[3]) + sh[3]);
            *(u32x2*)(p.h + (size_t)row * DM + col) = o;
        }
    }
}

__device__ __forceinline__ void gemm_core(char* smem, const bf16_t* __restrict__ A, int lda, int ar0a, int aloa, int ahia, int ar0b, int alob, int ahib,
                                          const bf16_t* __restrict__ B, int ldb, int K, const bf16_t* zero16, f32x4 (&acc)[8][4]) {
    constexpr int ROWB = 128, OPA = 256 * ROWB, STG = 2 * OPA, NI = 4;
    static_assert(2 * STG <= SMEM_BYTES, "LDS");
    const int tid = threadIdx.x, lane = tid & 63, w = __builtin_amdgcn_readfirstlane(tid >> 6), wr = w >> 2, wc = w & 3, fr = lane & 15, fq = lane >> 4;
    const int rl = lane >> 3, kcs = (lane & 7) ^ rl;
#pragma unroll
    for (int m = 0; m < 8; ++m)
#pragma unroll
        for (int n = 0; n < 4; ++n) acc[m][n] = (f32x4){0.f, 0.f, 0.f, 0.f};
    const int nk = K / 64;
    int aoff[NI], boff[NI];
#pragma unroll
    for (int i = 0; i < NI; ++i) {
        const int row = (w * NI + i) * 8 + rl, hf = row >> 7, gr = (hf ? ar0b : ar0a) + (row & 127);
        const bool ok = hf ? (gr >= alob && gr < ahib) : (gr >= aloa && gr < ahia);
        aoff[i] = ok ? gr * lda + kcs * 8 : -1;
        boff[i] = row * ldb + kcs * 8;
    }
    __syncthreads();
#pragma unroll
    for (int i = 0; i < NI; ++i) {
        __builtin_amdgcn_global_load_lds((const unsigned*)(aoff[i] >= 0 ? A + aoff[i] : zero16), (LAS unsigned*)(smem + (w * NI + i) * 1024), 16, 0, 0);
        __builtin_amdgcn_global_load_lds((const unsigned*)(B + boff[i]), (LAS unsigned*)(smem + OPA + (w * NI + i) * 1024), 16, 0, 0);
    }
    asm volatile("s_waitcnt vmcnt(0)" ::: "memory"); __syncthreads();
    const int sw = fr & 7;
    for (int kt = 0; kt < nk; ++kt) {
        const bool pf = kt + 1 < nk; const int nst = ((kt + 1) & 1) * STG;
        const char* base = smem + (kt & 1) * STG;
        bf16x8 bfr[2][4];
#pragma unroll
        for (int n = 0; n < 4; ++n) bfr[0][n] = *(const bf16x8*)(base + OPA + (wc * 64 + n * 16 + fr) * ROWB + ((fq ^ sw) * 16));
#pragma unroll
        for (int ks = 0; ks < 2; ++ks) {
            const int co = (((ks * 4 + fq) ^ sw) * 16);
#pragma unroll
            for (int m = 0; m < 8; ++m) {
                const bf16x8 af = *(const bf16x8*)(base + (wr * 128 + m * 16 + fr) * ROWB + co);
#pragma unroll
                for (int n = 0; n < 4; ++n) acc[m][n] = __builtin_amdgcn_mfma_f32_16x16x32_bf16(af, bfr[ks][n], acc[m][n], 0, 0, 0);
                if (ks == 0 && m == 5) {
#pragma unroll
                    for (int n = 0; n < 4; ++n) bfr[1][n] = *(const bf16x8*)(base + OPA + (wc * 64 + n * 16 + fr) * ROWB + (((4 + fq) ^ sw) * 16));
                }
                if (ks == 0 && pf) {
                    const int i = m & 3, lo_ = nst + (w * NI + i) * 1024;
                    if (m < 4) __builtin_amdgcn_global_load_lds((const unsigned*)(aoff[i] >= 0 ? A + aoff[i] + (kt + 1) * 64 : zero16), (LAS unsigned*)(smem + lo_), 16, 0, 0);
                    else __builtin_amdgcn_global_load_lds((const unsigned*)(B + boff[i] + (kt + 1) * 64), (LAS unsigned*)(smem + lo_ + OPA), 16, 0, 0);
                }
            }
        }
        asm volatile("s_waitcnt vmcnt(0)" ::: "memory");
        __syncthreads();
    }
}

__device__ __forceinline__ void acc_to_ct(float* Ct0, const f32x4 (&acc)[8][4], int ai) {
    const int tid = threadIdx.x, lane = tid & 63, w = tid >> 6, wr = w >> 2, wc = w & 3, fr = lane & 15, fq = lane >> 4;
    __syncthreads();
    if (wr == ai) {
        float* Ct = Ct0 + (wc >> 1) * CT_FLOATS + (wc & 1) * 64 + fr;
#pragma unroll
        for (int m = 0; m < 8; ++m)
#pragma unroll
            for (int n = 0; n < 4; ++n)
#pragma unroll
                for (int j = 0; j < 4; ++j) Ct[(m * 16 + fq * 4 + j) * LDC + n * 16] = acc[m][n][j];
    }
    __syncthreads();
}

__device__ __forceinline__ void gemm_core_h(char* smem, const bf16_t* __restrict__ A, int lda, int ar0a, int aloa, int ahia, int ar0b, int alob, int ahib,
                                            const bf16_t* __restrict__ B, int ldb, int K, const bf16_t* zero16, f32x4 (&acc)[4][4]) {
    constexpr int ROWB = 128, OPA = 256 * ROWB, STG = 2 * OPA, NI = 4, NIB = 2;
    const int tid = threadIdx.x, lane = tid & 63, w = __builtin_amdgcn_readfirstlane(tid >> 6), wr = w >> 1, wc = w & 1, fr = lane & 15, fq = lane >> 4;
    const int rl = lane >> 3, kcs = (lane & 7) ^ rl;
#pragma unroll
    for (int m = 0; m < 4; ++m)
#pragma unroll
        for (int n = 0; n < 4; ++n) acc[m][n] = (f32x4){0.f, 0.f, 0.f, 0.f};
    const int nk = K / 64;
    int aoff[NI], boff[NIB];
#pragma unroll
    for (int i = 0; i < NI; ++i) {
        const int row = (w * NI + i) * 8 + rl, hf = row >> 7, gr = (hf ? ar0b : ar0a) + (row & 127);
        const bool ok = hf ? (gr >= alob && gr < ahib) : (gr >= aloa && gr < ahia);
        aoff[i] = ok ? gr * lda + kcs * 8 : -1;
    }
#pragma unroll
    for (int i = 0; i < NIB; ++i) boff[i] = ((w * NIB + i) * 8 + rl) * ldb + kcs * 8;
    __syncthreads();
#pragma unroll
    for (int i = 0; i < NI; ++i) __builtin_amdgcn_global_load_lds((const unsigned*)(aoff[i] >= 0 ? A + aoff[i] : zero16), (LAS unsigned*)(smem + (w * NI + i) * 1024), 16, 0, 0);
#pragma unroll
    for (int i = 0; i < NIB; ++i) __builtin_amdgcn_global_load_lds((const unsigned*)(B + boff[i]), (LAS unsigned*)(smem + OPA + (w * NIB + i) * 1024), 16, 0, 0);
    asm volatile("s_waitcnt vmcnt(0)" ::: "memory"); __syncthreads();
    const int sw = fr & 7;
    for (int kt = 0; kt < nk; ++kt) {
        const bool pf = kt + 1 < nk; const int nst = ((kt + 1) & 1) * STG;
        const char* base = smem + (kt & 1) * STG;
#pragma unroll
        for (int ks = 0; ks < 2; ++ks) {
            const int co = (((ks * 4 + fq) ^ sw) * 16);
            bf16x8 bfr[4];
#pragma unroll
            for (int n = 0; n < 4; ++n) bfr[n] = *(const bf16x8*)(base + OPA + (wc * 64 + n * 16 + fr) * ROWB + co);
#pragma unroll
            for (int m = 0; m < 4; ++m) {
                const bf16x8 af = *(const bf16x8*)(base + (wr * 64 + m * 16 + fr) * ROWB + co);
#pragma unroll
                for (int n = 0; n < 4; ++n) acc[m][n] = __builtin_amdgcn_mfma_f32_16x16x32_bf16(af, bfr[n], acc[m][n], 0, 0, 0);
                if (pf) {
                    if (ks == 0) __builtin_amdgcn_global_load_lds((const unsigned*)(aoff[m] >= 0 ? A + aoff[m] + (kt + 1) * 64 : zero16), (LAS unsigned*)(smem + nst + (w * NI + m) * 1024), 16, 0, 0);
                    else if (m < NIB) __builtin_amdgcn_global_load_lds((const unsigned*)(B + boff[m & 1] + (kt + 1) * 64), (LAS unsigned*)(smem + nst + OPA + (w * NIB + (m & 1)) * 1024), 16, 0, 0);
                }
            }
        }
        asm volatile("s_waitcnt vmcnt(0)" ::: "memory");
        __syncthreads();
    }
}
__device__ __forceinline__ void acc_to_ct_h(float* Ct0, const f32x4 (&acc)[4][4], int ai) {
    const int tid = threadIdx.x, lane = tid & 63, w = tid >> 6, wr = w >> 1, wc = w & 1, fr = lane & 15, fq = lane >> 4;
    __syncthreads();
    if ((wr >> 1) == ai) {
        float* Ct = Ct0 + ((wr & 1) * 64 + fq * 4) * LDC + wc * 64 + fr;
#pragma unroll
        for (int m = 0; m < 4; ++m)
#pragma unroll
            for (int n = 0; n < 4; ++n)
#pragma unroll
                for (int j = 0; j < 4; ++j) Ct[(m * 16 + j) * LDC + n * 16] = acc[m][n][j];
    }
    __syncthreads();
}
#define TAIL_DECODE(T) const int G_ = gridDim.x, Tfull_ = ((T) / G_) * G_, total_ = Tfull_ + 2 * ((T) - Tfull_)
#define NOTAIL_DECODE(T) const int G_ = gridDim.x, Tfull_ = (T), total_ = (T)
#define TAIL_ITEM(it, tile, half) int tile, half; if ((it) < Tfull_) { tile = (it); half = -1; } else { const int r_ = (it) - Tfull_; tile = Tfull_ + (r_ >> 1); half = r_ & 1; }

__device__ __forceinline__ void load8(const float* src, float (&v)[8]) {
    const f32x4 a = *(const f32x4*)src, b = *(const f32x4*)(src + 4);
    v[0] = a[0]; v[1] = a[1]; v[2] = a[2]; v[3] = a[3]; v[4] = b[0]; v[5] = b[1]; v[6] = b[2]; v[7] = b[3];
}

__device__ __forceinline__ void rope8(const float* rowp, int c0, int hd, int pos, const float* tab, float (&v)[8]) {
    const int qs = hd >> 2, ch = c0 & (hd - 1), qd = ch / qs, i0 = ch & (qs - 1);
    const int idx = (qd < 2) ? (pos >> 6) : (pos & 63);
    const int pc = (qd & 1) ? c0 - qs : c0 + qs; const float sgn = (qd & 1) ? 1.f : -1.f;
    const float* t = tab + (idx * qs + i0) * 2;
#pragma unroll
    for (int e = 0; e < 8; ++e) v[e] = v[e] * t[2 * e] + sgn * rowp[pc + e] * t[2 * e + 1];
}

__device__ __forceinline__ void store_col8(const float* Ct, int c, int rc, bf16_t* dst, const float* rs) {
    float v[8];
#pragma unroll
    for (int e = 0; e < 8; ++e) { v[e] = Ct[(rc * 8 + e) * LDC + c]; if (rs) v[e] *= rs[rc * 8 + e]; }
    store8(dst, v);
}

__device__ __forceinline__ void epi_proj0(const Params& p, const float* Ct, int mt, int nt) {
    const int tid = threadIdx.x;
    bf16_t* proj0 = p.big + BE_PROJ0; bf16_t* vt_swa = p.big + BE_VT_SWA; bf16_t* k_mla = p.big + BE_K_MLA;
    extern __shared__ __attribute__((aligned(16))) char smem_dyn_[]; const float* lds_tab_ = (const float*)(smem_dyn_ + SMEM_BYTES);
    const float* rope64 = lds_tab_ + MISC_ROPE64; const float* rope32 = lds_tab_ + MISC_ROPE32;
    const int b = mt / 18, jt = mt % 18; const bool is_ctx = jt < 2; const int row0 = mt * 128, tok0 = jt * 128;
    if (nt == 8) {
#pragma unroll 1
        for (int i = 0; i < 4; ++i) { const int id = tid + NTHREADS * i, c = id & 127, rc = id >> 7;
            store_col8(Ct, c, rc, vt_swa + (size_t)((b * 2 + (c >> 6)) * 64 + (c & 63)) * TOK + tok0 + rc * 8, nullptr); }
    } else {
#pragma unroll 1
        for (int i = 0; i < 4; ++i) {
            const int id = tid + NTHREADS * i, r = id >> 4, c0 = (id & 15) * 8;
            const float* rowp = Ct + r * LDC; float v[8]; load8(rowp + c0, v);
            const int grow = row0 + r, pos = tok0 + r - CTXL;
            if (nt <= 1 || nt == 6) { store8(proj0 + (size_t)grow * 1024 + nt * 128 + c0, v); }
            else if (nt <= 5 || nt == 7) { if (!is_ctx) rope8(rowp, c0, 64, pos, rope64, v); store8(proj0 + (size_t)grow * 1024 + (nt == 7 ? 896 : nt * 128) + c0, v); }
            else if (c0 < 32) { if (!is_ctx) rope8(rowp, c0, 32, pos, rope32, v);
#pragma unroll
                for (int hh = 0; hh < 8; ++hh) store8(k_mla + (size_t)grow * 768 + hh * 96 + 64 + c0, v); }
        }
    }
}
__device__ __forceinline__ void phase_proj0(const Params& p, char* smem) {
    float* Ct = (float*)smem;
    TAIL_DECODE(72 * 5);
    for (int it = blockIdx.x; it < total_; it += G_) {
        TAIL_ITEM(it, tile, half)
        const int mt2 = tile / 5, nt2 = tile % 5;
        if (half < 0) {
            f32x4 acc[8][4];
            gemm_core(smem, p.h, DM, mt2 * 256, 0, ROWS, mt2 * 256 + 128, 0, ROWS, p.wt_in0 + (size_t)nt2 * 256 * DM, DM, DM, (const bf16_t*)p.bar, acc);
#pragma unroll 1
            for (int ai = 0; ai < 2; ++ai) {
                acc_to_ct(Ct, acc, ai);
                epi_proj0(p, Ct, mt2 * 2 + ai, nt2 * 2);
                epi_proj0(p, Ct + CT_FLOATS, mt2 * 2 + ai, nt2 * 2 + 1);
            }
        } else {
            const int nt = nt2 * 2 + half;
            f32x4 acc[4][4];
            gemm_core_h(smem, p.h, DM, mt2 * 256, 0, ROWS, mt2 * 256 + 128, 0, ROWS, p.wt_in0 + (size_t)nt * 128 * DM, DM, DM, (const bf16_t*)p.bar, acc);
#pragma unroll 1
            for (int ai = 0; ai < 2; ++ai) { acc_to_ct_h(Ct, acc, ai); epi_proj0(p, Ct, mt2 * 2 + ai, nt); }
        }
    }
}

__device__ __forceinline__ void row_rstd(const bf16_t* A, int lda, int row0, int K, float* rs) {
    const int tid = threadIdx.x;
    if (tid < 256) {
        const int r = tid >> 1, hf = tid & 1; const int n = K / 2;
        const bf16_t* ap = A + (size_t)(row0 + r) * lda + hf * n; float ss = 0.f;
        for (int k = 0; k < n; k += 8) { const u32x4 v = *(const u32x4*)(ap + k);
            ss += bflo(v.x) * bflo(v.x) + bfhi(v.x) * bfhi(v.x) + bflo(v.y) * bflo(v.y) + bfhi(v.y) * bfhi(v.y) + bflo(v.z) * bflo(v.z) + bfhi(v.z) * bfhi(v.z) + bflo(v.w) * bflo(v.w) + bfhi(v.w) * bfhi(v.w); }
        ss += __shfl_xor(ss, 1);
        if (hf == 0) rs[r] = rsqrtf(ss / (float)K + 1e-6f);
    }
    __syncthreads();
}
__device__ __forceinline__ void epi_mla_q(const Params& p, const float* Ct, const float* rs, int mt, int nt) {
    extern __shared__ __attribute__((aligned(16))) char smem_dyn_[]; const float* lds_tab_ = (const float*)(smem_dyn_ + SMEM_BYTES);
    const int tid = threadIdx.x; bf16_t* q_mla = p.big + BE_Q_MLA; const float* rope32 = lds_tab_ + MISC_ROPE32;
    const int jt = mt % 18; const bool is_ctx = jt < 2; const int row0 = mt * 128, tok0 = jt * 128;
#pragma unroll 1
    for (int i = 0; i < 4; ++i) {
        const int id = tid + NTHREADS * i, r = id >> 4, c0 = (id & 15) * 8;
        const float* rowp = Ct + r * LDC; float v[8]; load8(rowp + c0, v);
        const int grow = row0 + r, pos = tok0 + r - CTXL; const float sc = rs[r];
        int dcol;
        if (nt < 4) { const int cg = nt * 128 + c0; dcol = (cg >> 6) * 96 + (cg & 63); }
        else { const int cg = (nt - 4) * 128 + c0; dcol = (cg >> 5) * 96 + 64 + (cg & 31); if (!is_ctx) rope8(rowp, c0, 32, pos, rope32, v); }
#pragma unroll
        for (int e = 0; e < 8; ++e) v[e] *= sc;
        store8(q_mla + (size_t)grow * 768 + dcol, v);
    }
}
__device__ __forceinline__ void epi_mla_kv(const Params& p, const float* Ct, const float* rs, int mt, int hh) {
    const int tid = threadIdx.x; bf16_t* k_mla = p.big + BE_K_MLA; bf16_t* vt_mla = p.big + BE_VT_MLA;
    const int b = mt / 18, jt = mt % 18; const int row0 = mt * 128, tok0 = jt * 128;
#pragma unroll 1
    for (int i = 0; i < 2; ++i) {
        const int id = tid + NTHREADS * i, r = id >> 3, c0 = (id & 7) * 8;
        float v[8]; load8(Ct + r * LDC + c0, v); const float sc = rs[r];
#pragma unroll
        for (int e = 0; e < 8; ++e) v[e] *= sc;
        store8(k_mla + (size_t)(row0 + r) * 768 + hh * 96 + c0, v);
    }
#pragma unroll 1
    for (int i = 0; i < 2; ++i) { const int id = tid + NTHREADS * i, c = 64 + (id & 63), rc = id >> 6;
        store_col8(Ct, c, rc, vt_mla + (size_t)((b * 8 + hh) * 64 + (c - 64)) * TOK + tok0 + rc * 8, rs); }
}
__device__ __forceinline__ void phase_mla_up(const Params& p, char* smem) {
    float* Ct = (float*)smem; float* rs = (float*)(smem + 2 * CT_FLOATS * 4);
    bf16_t* proj0 = p.big + BE_PROJ0;
    for (int it = blockIdx.x; it < 72 * 7; it += gridDim.x) {
        const int mt2 = it / 7, nt2 = it % 7;
        f32x4 acc[8][4];
        if (nt2 < 3) gemm_core(smem, proj0, 1024, mt2 * 256, 0, ROWS, mt2 * 256 + 128, 0, ROWS, p.wt_qb + (size_t)nt2 * 256 * 256, 256, 256, (const bf16_t*)p.bar, acc);
        else gemm_core(smem, proj0 + 768, 1024, mt2 * 256, 0, ROWS, mt2 * 256 + 128, 0, ROWS, p.wt_kvb + (size_t)(nt2 - 3) * 256 * 128, 128, 128, (const bf16_t*)p.bar, acc);
#pragma unroll 1
        for (int ai = 0; ai < 2; ++ai) {
            acc_to_ct(Ct, acc, ai);
            const int mt = mt2 * 2 + ai;
            if (nt2 < 3) { row_rstd(proj0, 1024, mt * 128, 256, rs); epi_mla_q(p, Ct, rs, mt, nt2 * 2); epi_mla_q(p, Ct + CT_FLOATS, rs, mt, nt2 * 2 + 1); }
            else { row_rstd(proj0 + 768, 1024, mt * 128, 128, rs); epi_mla_kv(p, Ct, rs, mt, (nt2 - 3) * 2); epi_mla_kv(p, Ct + CT_FLOATS, rs, mt, (nt2 - 3) * 2 + 1); }
        }
    }
}

template <int DQK, int DV, bool WINDOWED>
__device__ __forceinline__ void flash_pass(char* smem, const bf16_t* __restrict__ Qp, int ldq, const bf16_t* __restrict__ Kp, int ldk,
                                           const bf16_t* __restrict__ Vtp, int seg2s, int seg2e, int q_tok0, float sc2,
                                           f32x4 (&o)[DV / 16][2], float (&mrun)[2], float (&lrun)[2]) {
    constexpr int KROW = DQK * 2, VROW = 128, KB = 64 * KROW, VB = DV * VROW, STG = KB + VB;
    constexpr int KCPR = DQK / 8, NKI = KCPR, NVI = DV / 8, KCPT = (NKI + 7) / 8, VCPT = NVI / 8, NKS = DQK / 32, NMD = DV / 16;
    static_assert(2 * STG <= SMEM_BYTES, "LDS");
    const int tid = threadIdx.x, lane = tid & 63, w = tid >> 6, fr = lane & 15, fq = lane >> 4, wq0 = w * 32;
    bf16x8 qf[2][NKS];
#pragma unroll
    for (int nq = 0; nq < 2; ++nq)
#pragma unroll
        for (int ks = 0; ks < NKS; ++ks) qf[nq][ks] = *(const bf16x8*)(Qp + (size_t)(wq0 + nq * 16 + fr) * ldq + ks * 32 + fq * 8);
#pragma unroll
    for (int md = 0; md < NMD; ++md) { o[md][0] = (f32x4){0.f, 0.f, 0.f, 0.f}; o[md][1] = (f32x4){0.f, 0.f, 0.f, 0.f}; }
    float mref[2]; mref[0] = mref[1] = -1e30f; lrun[0] = lrun[1] = 0.f;
    const float thr = 8.0f / sc2;
    const int nt = 4 + (seg2e > seg2s ? (seg2e - seg2s) / 64 : 0);
    const int wu = __builtin_amdgcn_readfirstlane(w);
    int koffg[KCPT], voffg[VCPT];
#pragma unroll
    for (int i = 0; i < KCPT; ++i) { const int idx = (wu + 8 * i) * 64 + lane, rho = (idx / KCPR) & 63, cp = idx % KCPR;
        const int key = 32 * (rho >> 5) + 8 * ((rho >> 2) & 3) + 4 * ((rho >> 4) & 1) + (rho & 3);
        const int kcs = (DQK == 64) ? (cp ^ (rho & 7)) : ((cp & ~3) | ((cp & 3) ^ ((4 - ((rho >> 2) & 3)) & 3)));
        koffg[i] = key * ldk + kcs * 8; }
#pragma unroll
    for (int i = 0; i < VCPT; ++i) { const int idx = (wu + 8 * i) * 64 + lane, r = idx >> 3, cp = idx & 7; voffg[i] = r * TOK + ((cp ^ (r & 7)) * 8); }
    __syncthreads();
#define FDMA(t, st) do { const int key0_ = (t) < 4 ? (t) * 64 : seg2s + ((t) - 4) * 64; const bf16_t* kg_ = Kp + (size_t)key0_ * ldk; const bf16_t* vg_ = Vtp + key0_; \
        _Pragma("unroll") for (int i = 0; i < KCPT; ++i) if (wu + 8 * i < NKI) __builtin_amdgcn_global_load_lds((const unsigned*)(kg_ + koffg[i]), (LAS unsigned*)(smem + (st) * STG + (wu + 8 * i) * 1024), 16, 0, 0); \
        _Pragma("unroll") for (int i = 0; i < VCPT; ++i) __builtin_amdgcn_global_load_lds((const unsigned*)(vg_ + voffg[i]), (LAS unsigned*)(smem + (st) * STG + KB + (wu + 8 * i) * 1024), 16, 0, 0); } while (0)
    FDMA(0, 0);
    asm volatile("s_waitcnt vmcnt(0)" ::: "memory"); __syncthreads();
    const int ksw = (DQK == 64) ? (fr & 7) : ((4 - ((fr >> 2) & 3)) & 3);
    for (int t = 0; t < nt; ++t) {
        if (t + 1 < nt) FDMA(t + 1, (t + 1) & 1);
        const char* kb = smem + (t & 1) * STG; const char* vb = kb + KB;
        const int key0 = t < 4 ? t * 64 : seg2s + (t - 4) * 64;
        f32x4 s[4][2];
#pragma unroll
        for (int mk = 0; mk < 4; ++mk) { s[mk][0] = (f32x4){0.f, 0.f, 0.f, 0.f}; s[mk][1] = (f32x4){0.f, 0.f, 0.f, 0.f}; }
#pragma unroll
        for (int ks = 0; ks < NKS; ++ks) {
            const int co = (DQK == 64) ? (((ks * 4 + fq) ^ ksw) * 16) : ((ks * 4 + (fq ^ ksw)) * 16);
#pragma unroll
            for (int mk = 0; mk < 4; ++mk) {
                const bf16x8 kf = *(const bf16x8*)(kb + (mk * 16 + fr) * KROW + co);
                s[mk][0] = __builtin_amdgcn_mfma_f32_16x16x32_bf16(kf, qf[0][ks], s[mk][0], 0, 0, 0);
                s[mk][1] = __builtin_amdgcn_mfma_f32_16x16x32_bf16(kf, qf[1][ks], s[mk][1], 0, 0, 0);
            }
        }
        __builtin_amdgcn_sched_barrier(0);
        bf16x8 vf0[4];
#pragma unroll
        for (int md = 0; md < 4; ++md) vf0[md] = *(const bf16x8*)(vb + (md * 16 + fr) * VROW + ((fq ^ (fr & 7)) * 16));
        bf16x8 pf[2][2];
#pragma unroll
        for (int nq = 0; nq < 2; ++nq) {
            if (WINDOWED && key0 >= CTXL) {
                const int qpos = q_tok0 - CTXL + wq0 + nq * 16 + fr;
#pragma unroll
                for (int mk = 0; mk < 4; ++mk)
#pragma unroll
                    for (int j = 0; j < 4; ++j) { const int kpos = key0 - CTXL + 32 * (mk >> 1) + 8 * fq + 4 * (mk & 1) + j; const int d = qpos - kpos; if (d > 128 || d < -128) s[mk][nq][j] = -1e30f; }
            }
            float mx = fmaxf(fmaxf(s[0][nq][0], s[0][nq][1]), fmaxf(s[0][nq][2], s[0][nq][3]));
#pragma unroll
            for (int mk = 1; mk < 4; ++mk) mx = fmaxf(fmaxf(mx, fmaxf(s[mk][nq][0], s[mk][nq][1])), fmaxf(s[mk][nq][2], s[mk][nq][3]));
            mx = fmaxf(mx, __shfl_xor(mx, 16)); mx = fmaxf(mx, __shfl_xor(mx, 32));
            const bool need = mx > mref[nq] + thr;
            if (__any(need)) {
                const float mnew = need ? mx : mref[nq];
                const float alpha = fast_exp2((mref[nq] - mnew) * sc2);
                mref[nq] = mnew; lrun[nq] *= alpha;
#pragma unroll
                for (int md = 0; md < NMD; ++md) o[md][nq] = o[md][nq] * alpha;
            }
            const float nm = -mref[nq] * sc2;
            float ls = 0.f;
#pragma unroll
            for (int mk = 0; mk < 4; ++mk)
#pragma unroll
                for (int j = 0; j < 4; ++j) { const float pv = fast_exp2(fmaf(s[mk][nq][j], sc2, nm)); s[mk][nq][j] = pv; ls += pv; }
            lrun[nq] += ls;
#pragma unroll
            for (int kk = 0; kk < 2; ++kk) {
                u32x4 pk; pk.x = cvt_pk_bf16(s[2 * kk][nq][0], s[2 * kk][nq][1]); pk.y = cvt_pk_bf16(s[2 * kk][nq][2], s[2 * kk][nq][3]);
                pk.z = cvt_pk_bf16(s[2 * kk + 1][nq][0], s[2 * kk + 1][nq][1]); pk.w = cvt_pk_bf16(s[2 * kk + 1][nq][2], s[2 * kk + 1][nq][3]);
                pf[nq][kk] = __builtin_bit_cast(bf16x8, pk);
            }
        }
        __builtin_amdgcn_sched_barrier(0);
#pragma unroll
        for (int kk = 0; kk < 2; ++kk) {
            const int co = (((kk * 4 + fq) ^ (fr & 7)) * 16);
#pragma unroll
            for (int md = 0; md < NMD; ++md) {
                const bf16x8 vf = (kk == 0 && md < 4) ? vf0[md & 3] : *(const bf16x8*)(vb + (md * 16 + fr) * VROW + co);
                o[md][0] = __builtin_amdgcn_mfma_f32_16x16x32_bf16(vf, pf[0][kk], o[md][0], 0, 0, 0);
                o[md][1] = __builtin_amdgcn_mfma_f32_16x16x32_bf16(vf, pf[1][kk], o[md][1], 0, 0, 0);
            }
        }
        asm volatile("s_waitcnt vmcnt(0)" ::: "memory");
        __syncthreads();
    }
#undef FDMA
#pragma unroll
    for (int nq = 0; nq < 2; ++nq) { float l = lrun[nq]; l += __shfl_xor(l, 16); l += __shfl_xor(l, 32); lrun[nq] = l; mrun[nq] = mref[nq] * sc2; }
}

template <int NMD>
__device__ __forceinline__ void store_o(bf16_t* Op, int ldo, const f32x4 (&o)[NMD][2], const float (&inv)[2]) {
    const int lane = threadIdx.x & 63, w = threadIdx.x >> 6, fr = lane & 15, fq = lane >> 4, wq0 = w * 32;
#pragma unroll
    for (int nq = 0; nq < 2; ++nq)
#pragma unroll
        for (int md = 0; md < NMD; ++md) {
            u32x2 v; v.x = cvt_pk_bf16(o[md][nq][0] * inv[nq], o[md][nq][1] * inv[nq]); v.y = cvt_pk_bf16(o[md][nq][2] * inv[nq], o[md][nq][3] * inv[nq]);
            *(u32x2*)(Op + (size_t)(wq0 + nq * 16 + fr) * ldo + md * 16 + fq * 4) = v;
        }
}

__device__ __forceinline__ void phase_attn0(const Params& p, char* smem) {
    const bf16_t* proj0 = p.big + BE_PROJ0; const bf16_t* vt_swa = p.big + BE_VT_SWA; const bf16_t* q_mla = p.big + BE_Q_MLA;
    const bf16_t* k_mla = p.big + BE_K_MLA; const bf16_t* vt_mla = p.big + BE_VT_MLA;
    for (int it = blockIdx.x; it < 1152; it += gridDim.x) {
        int kind, b, hh, qbl; bool lat;
        if (it < 1024) { lat = true; kind = it >> 9; const int r = it & 511; b = r >> 6; hh = (r >> 3) & 7; qbl = r & 7; }
        else { lat = false; const int r = it - 1024; kind = r >> 6; b = (r >> 3) & 7; hh = r & 7; qbl = 0; }
        const int qtok0 = lat ? CTXL + 256 * qbl : 0, row0 = b * TOK + qtok0;
        f32x4 o[4][2]; float m[2], l[2], inv[2];
        if (kind == 0) {
            flash_pass<96, 64, false>(smem, q_mla + (size_t)row0 * 768 + hh * 96, 768, k_mla + (size_t)b * TOK * 768 + hh * 96, 768,
                               vt_mla + (size_t)((b * 8 + hh) * 64) * TOK, CTXL, lat ? TOK : CTXL, qtok0, 0.10206207262f * LOG2E, o, m, l);
            inv[0] = 1.f / l[0]; inv[1] = 1.f / l[1];
            store_o<4>(p.o + (size_t)row0 * 1024 + hh * 64, 1024, o, inv);
        } else {
            int s2s = CTXL, s2e = CTXL;
            if (lat) { const int lo = 256 * qbl - 128, hi = 256 * qbl + 384; s2s = CTXL + (lo > 0 ? lo : 0); s2e = CTXL + (hi < SEQ ? hi : SEQ); }
            flash_pass<64, 64, true>(smem, proj0 + (size_t)row0 * 1024 + 256 + hh * 64, 1024, proj0 + (size_t)b * TOK * 1024 + 896 + (hh >> 2) * 64, 1024,
                               vt_swa + (size_t)((b * 2 + (hh >> 2)) * 64) * TOK, s2s, s2e, qtok0, 0.125f * LOG2E, o, m, l);
            const float sk = p.sink[hh] * LOG2E;
            inv[0] = 1.f / (l[0] + fast_exp2(sk - m[0])); inv[1] = 1.f / (l[1] + fast_exp2(sk - m[1]));
            store_o<4>(p.o + (size_t)row0 * 1024 + 512 + hh * 64, 1024, o, inv);
        }
    }
}

__device__ __forceinline__ void epi_plain(const float* Ct, bf16_t* out, int ldo, int mt, int nt) {
    const int tid = threadIdx.x;
#pragma unroll 1
    for (int i = 0; i < 4; ++i) {
        const int id = tid + NTHREADS * i, r = id >> 4, c0 = (id & 15) * 8;
        float v[8]; load8(Ct + r * LDC + c0, v);
        store8(out + (size_t)(mt * 128 + r) * ldo + nt * 128 + c0, v);
    }
}
__device__ __forceinline__ void phase_gemm_plain(char* smem, const bf16_t* zero16, const bf16_t* A, int lda, const bf16_t* Wt, int K, int ntn2, bf16_t* out, int ldo, bool lat_only) {
    float* Ct = (float*)smem;
    const int nmt2 = lat_only ? 64 : 72;
    TAIL_DECODE(nmt2 * ntn2);
    for (int it = blockIdx.x; it < total_; it += G_) {
        TAIL_ITEM(it, tile, half)
        int mt2 = tile / ntn2; const int nt2 = tile % ntn2;
        if (lat_only) mt2 = (mt2 >> 3) * 9 + 1 + (mt2 & 7);
        if (half < 0) {
            f32x4 acc[8][4];
            gemm_core(smem, A, lda, mt2 * 256, 0, ROWS, mt2 * 256 + 128, 0, ROWS, Wt + (size_t)nt2 * 256 * K, K, K, zero16, acc);
#pragma unroll 1
            for (int ai = 0; ai < 2; ++ai) {
                acc_to_ct(Ct, acc, ai);
                epi_plain(Ct, out, ldo, mt2 * 2 + ai, nt2 * 2);
                epi_plain(Ct + CT_FLOATS, out, ldo, mt2 * 2 + ai, nt2 * 2 + 1);
            }
        } else {
            const int nt = nt2 * 2 + half;
            f32x4 acc[4][4];
            gemm_core_h(smem, A, lda, mt2 * 256, 0, ROWS, mt2 * 256 + 128, 0, ROWS, Wt + (size_t)nt * 128 * K, K, K, zero16, acc);
#pragma unroll 1
            for (int ai = 0; ai < 2; ++ai) { acc_to_ct_h(Ct, acc, ai); epi_plain(Ct, out, ldo, mt2 * 2 + ai, nt); }
        }
    }
}

__device__ __forceinline__ void phase_ln(const Params& p, const float* res_lat, const float* res_ctx, int layer, int gate_idx, const float* lng, const float* lnb,
                                         float* out_lat, float* out_ctx, bool write_h, int hl, int sh_idx, int sc_idx, bool inc_ctx) {
    const int lane = threadIdx.x & 63, w = threadIdx.x >> 6;
    for (int row = blockIdx.x * NWAVES + w; row < ROWS; row += gridDim.x * NWAVES) {
        const int b = row / TOK, j = row % TOK; const bool isc = j < CTXL;
        if (isc && !inc_ctx) continue;
        const size_t ro = isc ? ((size_t)b * CTXL + j) * DM : ((size_t)b * SEQ + (j - CTXL)) * DM;
        const float* rp = (isc ? res_ctx : res_lat) + ro; float* op = (isc ? out_ctx : out_lat) + ro;
        const int bm = isc ? 8 : b;
        const float* gate = p.mod + (size_t)(layer * 9 + bm) * 6144 + gate_idx * 1024;
        bf16_t* fp = p.h + (size_t)row * DM;
        f32x4 y[4]; float sum = 0.f;
#pragma unroll
        for (int i = 0; i < 4; ++i) {
            const int col = i * 256 + lane * 4;
            const f32x4 r = *(const f32x4*)(rp + col), gt = *(const f32x4*)(gate + col); const u32x2 f = *(const u32x2*)(fp + col);
            y[i][0] = ALPHA_RES * r[0] + gt[0] * bflo(f.x); y[i][1] = ALPHA_RES * r[1] + gt[1] * bfhi(f.x);
            y[i][2] = ALPHA_RES * r[2] + gt[2] * bflo(f.y); y[i][3] = ALPHA_RES * r[3] + gt[3] * bfhi(f.y);
            sum += (y[i][0] + y[i][1]) + (y[i][2] + y[i][3]);
        }
        const float mean = wave_sum(sum) * (1.f / DM); float sq = 0.f;
#pragma unroll
        for (int i = 0; i < 4; ++i) { y[i] = y[i] - mean; sq += (y[i][0] * y[i][0] + y[i][1] * y[i][1]) + (y[i][2] * y[i][2] + y[i][3] * y[i][3]); }
        const float rstd = rsqrtf(wave_sum(sq) * (1.f / DM) + 1e-5f);
        const float* mh = p.mod + (size_t)(hl * 9 + bm) * 6144;
#pragma unroll
        for (int i = 0; i < 4; ++i) {
            const int col = i * 256 + lane * 4;
            const f32x4 g = *(const f32x4*)(lng + col), bb = *(const f32x4*)(lnb + col);
            const f32x4 xl = y[i] * rstd * g + bb;
            *(f32x4*)(op + col) = xl;
            if (write_h) {
                const f32x4 sh = *(const f32x4*)(mh + sh_idx * 1024 + col), sc = *(const f32x4*)(mh + sc_idx * 1024 + col);
                u32x2 hv; hv.x = cvt_pk_bf16(xl[0] * (1.f + sc[0]) + sh[0], xl[1] * (1.f + sc[1]) + sh[1]); hv.y = cvt_pk_bf16(xl[2] * (1.f + sc[2]) + sh[2], xl[3] * (1.f + sc[3]) + sh[3]);
                *(u32x2*)(fp + col) = hv;
            }
        }
    }
}

struct SubTile { int alo, ahi, ar0, jm, seg_len; bool valid; };
__device__ __forceinline__ SubTile ffn_subtile(int layer, int b, int sidx) {
    SubTile t; const int cnt = layer == 0 ? 20 : 17; t.valid = sidx < cnt;
    int jm = sidx, seg_off = CTXL, seg_len = SEQ;
    if (layer == 0) { if (sidx < 3) { seg_off = 0; seg_len = CTXL; } else jm = sidx - 3; }
    t.jm = jm; t.seg_len = seg_len; t.alo = b * TOK + seg_off; t.ahi = t.valid ? t.alo + seg_len : t.alo; t.ar0 = t.alo + 126 * jm - 1;
    return t;
}
__device__ __forceinline__ SubTile sel_subtile(const SubTile& a, const SubTile& b, int ai) {
    SubTile t; t.alo = ai ? b.alo : a.alo; t.ahi = ai ? b.ahi : a.ahi; t.ar0 = ai ? b.ar0 : a.ar0; t.jm = ai ? b.jm : a.jm; t.seg_len = ai ? b.seg_len : a.seg_len; t.valid = ai ? b.valid : a.valid; return t;
}
__device__ __forceinline__ void epi_ffn1(const Params& p, const float* Ct, int layer, const SubTile& t, int hc0) {
    if (!t.valid) return;
    const int tid = threadIdx.x; bf16_t* hid = p.big + BE_HID;
    const float* cw = p.conv_w + (size_t)layer * 3 * DFF; const float* cb = p.conv_b + (size_t)layer * DFF;
    const int c0 = (tid & 7) * 8, hc = hc0 + c0;
    float w0[8], w1[8], w2[8], bs[8];
    load8(cw + hc, w0); load8(cw + DFF + hc, w1); load8(cw + 2 * DFF + hc, w2); load8(cb + hc, bs);
#pragma unroll
    for (int i = 0; i < 2; ++i) {
        const int r = (tid + NTHREADS * i) >> 3;
        const int srow = 126 * t.jm - 1 + r;
        if (r < 1 || r > 126 || srow >= t.seg_len) continue;
        float gm[8], g0[8], gp[8], u[8], hv[8];
        load8(Ct + (r - 1) * LDC + c0, gm); load8(Ct + r * LDC + c0, g0); load8(Ct + (r + 1) * LDC + c0, gp); load8(Ct + r * LDC + 64 + c0, u);
#pragma unroll
        for (int e = 0; e < 8; ++e) { const float cv = gm[e] * w0[e] + g0[e] * w1[e] + gp[e] * w2[e] + bs[e]; hv[e] = cv / (1.f + __expf(-cv)) * u[e]; }
        store8(hid + (size_t)(t.alo + srow) * DFF + hc, hv);
    }
}
__device__ __forceinline__ void phase_ffn1(const Params& p, char* smem, int layer) {
    float* Ct = (float*)smem;
    const bf16_t* wgu = p.wt_gate + (size_t)layer * 5632 * 1024;
    const int cnt = layer == 0 ? 20 : 17, npairs = 4 * cnt;
    NOTAIL_DECODE(npairs * 22);
    for (int it0 = blockIdx.x; it0 < total_; it0 += G_) {
        TAIL_ITEM(it0, it, half)
        int mt2, nt2; const int nfirst = npairs * 16;
        if (it < nfirst) { mt2 = it >> 4; nt2 = it & 15; } else { const int r = it - nfirst; mt2 = r / 6; nt2 = 16 + r % 6; }
        const int g0 = 2 * mt2, g1 = g0 + 1;
        const SubTile t0 = ffn_subtile(layer, g0 / cnt, g0 % cnt), t1 = ffn_subtile(layer, g1 / cnt, g1 % cnt);
        if (half < 0) {
            f32x4 acc[8][4];
            gemm_core(smem, p.h, DM, t0.ar0, t0.alo, t0.ahi, t1.ar0, t1.alo, t1.ahi, wgu + (size_t)nt2 * 256 * DM, DM, DM, (const bf16_t*)p.bar, acc);
#pragma unroll 1
            for (int ai = 0; ai < 2; ++ai) {
                acc_to_ct(Ct, acc, ai);
                const SubTile t = sel_subtile(t0, t1, ai);
                epi_ffn1(p, Ct, layer, t, (nt2 * 2) * 64);
                epi_ffn1(p, Ct + CT_FLOATS, layer, t, (nt2 * 2 + 1) * 64);
            }
        } else {
            const int nt = nt2 * 2 + half;
            f32x4 acc[4][4];
            gemm_core_h(smem, p.h, DM, t0.ar0, t0.alo, t0.ahi, t1.ar0, t1.alo, t1.ahi, wgu + (size_t)nt * 128 * DM, DM, DM, (const bf16_t*)p.bar, acc);
#pragma unroll 1
            for (int ai = 0; ai < 2; ++ai) { acc_to_ct_h(Ct, acc, ai); epi_ffn1(p, Ct, layer, sel_subtile(t0, t1, ai), nt * 64); }
        }
    }
}

__device__ __forceinline__ void epi_proj1(const Params& p, const float* Ct, int mt, int nt) {
    const int tid = threadIdx.x;
    bf16_t* qd = p.big + BE_QD; bf16_t* kd = p.big + BE_KD; bf16_t* vt_d = p.big + BE_VT_D;
    extern __shared__ __attribute__((aligned(16))) char smem_dyn_[]; const float* lds_tab_ = (const float*)(smem_dyn_ + SMEM_BYTES);
    const float* rope64 = lds_tab_ + MISC_ROPE64;
    const int b = mt / 18, jt = mt % 18; const bool is_ctx = jt < 2; const int row0 = mt * 128, tok0 = jt * 128;
    if (nt >= 16) {
        const int hh = nt - 16;
#pragma unroll 1
        for (int i = 0; i < 4; ++i) { const int id = tid + NTHREADS * i, c = id & 127, rc = id >> 7;
            store_col8(Ct, c, rc, vt_d + (size_t)((b * 8 + hh) * 128 + c) * TOK + tok0 + rc * 8, nullptr); }
    } else {
        bf16_t* dst = nt < 8 ? qd : kd; const int dc = (nt & 7) * 128;
#pragma unroll 1
        for (int i = 0; i < 4; ++i) {
            const int id = tid + NTHREADS * i, r = id >> 4, c0 = (id & 15) * 8;
            const float* rowp = Ct + r * LDC; float v[8]; load8(rowp + c0, v);
            if (!is_ctx) rope8(rowp, c0, 64, tok0 + r - CTXL, rope64, v);
            store8(dst + (size_t)(row0 + r) * 1024 + dc + c0, v);
        }
    }
}
__device__ __forceinline__ void phase_proj1(const Params& p, char* smem) {
    float* Ct = (float*)smem;
    TAIL_DECODE(72 * 12);
    for (int it0 = blockIdx.x; it0 < total_; it0 += G_) {
        TAIL_ITEM(it0, it, half)
        int mt2, nt2;
        if (it < 72 * 8) { mt2 = it >> 3; nt2 = it & 7; } else { const int r = it - 72 * 8; mt2 = r >> 2; nt2 = 8 + (r & 3); }
        if ((mt2 % 9) == 0 && nt2 < 4) continue;
        if (half < 0) {
            f32x4 acc[8][4];
            gemm_core(smem, p.h, DM, mt2 * 256, 0, ROWS, mt2 * 256 + 128, 0, ROWS, p.wt_din + (size_t)nt2 * 256 * DM, DM, DM, (const bf16_t*)p.bar, acc);
#pragma unroll 1
            for (int ai = 0; ai < 2; ++ai) {
                acc_to_ct(Ct, acc, ai);
                epi_proj1(p, Ct, mt2 * 2 + ai, nt2 * 2);
                epi_proj1(p, Ct + CT_FLOATS, mt2 * 2 + ai, nt2 * 2 + 1);
            }
        } else {
            const int nt = nt2 * 2 + half;
            f32x4 acc[4][4];
            gemm_core_h(smem, p.h, DM, mt2 * 256, 0, ROWS, mt2 * 256 + 128, 0, ROWS, p.wt_din + (size_t)nt * 128 * DM, DM, DM, (const bf16_t*)p.bar, acc);
#pragma unroll 1
            for (int ai = 0; ai < 2; ++ai) { acc_to_ct_h(Ct, acc, ai); epi_proj1(p, Ct, mt2 * 2 + ai, nt); }
        }
    }
}

__device__ __forceinline__ void phase_attn1(const Params& p, char* smem) {
    const bf16_t* qd = p.big + BE_QD; const bf16_t* kd = p.big + BE_KD; const bf16_t* vt_d = p.big + BE_VT_D;
    const int lane = threadIdx.x & 63, w = threadIdx.x >> 6, fr = lane & 15, fq = lane >> 4, wq0 = w * 32;
    const float lam = p.misc[MISC_LAM];
    for (int it = blockIdx.x; it < 512; it += gridDim.x) {
        const int b = it >> 6, hh = (it >> 3) & 7, qbl = it & 7; const int qtok0 = CTXL + 256 * qbl, row0 = b * TOK + qtok0;
        const bf16_t* vt = vt_d + (size_t)((b * 8 + hh) * 128) * TOK;
        f32x4 o[8][2]; float m[2], l[2];
        flash_pass<64, 128, false>(smem, qd + (size_t)row0 * 1024 + hh * 128, 1024, kd + (size_t)b * TOK * 1024 + hh * 128, 1024, vt, CTXL, TOK, qtok0, 0.125f * LOG2E, o, m, l);
        {
            float inv[2]; inv[0] = 1.f / l[0]; inv[1] = 1.f / l[1];
            store_o<8>(p.o + (size_t)row0 * 1024 + hh * 128, 1024, o, inv);
        }
        flash_pass<64, 128, false>(smem, qd + (size_t)row0 * 1024 + hh * 128 + 64, 1024, kd + (size_t)b * TOK * 1024 + hh * 128 + 64, 1024, vt, CTXL, TOK, qtok0, 0.125f * LOG2E, o, m, l);
#pragma unroll
        for (int nq = 0; nq < 2; ++nq) {
            const float inv = lam / l[nq]; float ss = 0.f;
            const bf16_t* o1p = p.o + (size_t)(row0 + wq0 + nq * 16 + fr) * 1024 + hh * 128;
#pragma unroll
            for (int md = 0; md < 8; ++md) {
                const u32x2 o1 = *(const u32x2*)(o1p + md * 16 + fq * 4);
                o[md][nq][0] = bflo(o1.x) - o[md][nq][0] * inv; o[md][nq][1] = bfhi(o1.x) - o[md][nq][1] * inv;
                o[md][nq][2] = bflo(o1.y) - o[md][nq][2] * inv; o[md][nq][3] = bfhi(o1.y) - o[md][nq][3] * inv;
                ss += (o[md][nq][0] * o[md][nq][0] + o[md][nq][1] * o[md][nq][1]) + (o[md][nq][2] * o[md][nq][2] + o[md][nq][3] * o[md][nq][3]);
            }
            ss += __shfl_xor(ss, 16); ss += __shfl_xor(ss, 32);
            const float rstd = rsqrtf(ss * (1.f / 128.f) + 1e-6f) * (1.f - LAMBDA_INIT);
            bf16_t* op = p.o + (size_t)(row0 + wq0 + nq * 16 + fr) * 1024 + hh * 128;
#pragma unroll
            for (int md = 0; md < 8; ++md) {
                const f32x4 g = *(const f32x4*)(p.subln + md * 16 + fq * 4);
                u32x2 v; v.x = cvt_pk_bf16(o[md][nq][0] * rstd * g[0], o[md][nq][1] * rstd * g[1]); v.y = cvt_pk_bf16(o[md][nq][2] * rstd * g[2], o[md][nq][3] * rstd * g[3]);
                *(u32x2*)(op + md * 16 + fq * 4) = v;
            }
        }
    }
}

constexpr int N_PHASES = 17;
#ifndef ONLY_PHASE
#define ONLY_PHASE -1
#endif
#define PH_ON(k) (ONLY_PHASE < 0 || ONLY_PHASE == (k))
#ifndef DUP_MASK
#define DUP_MASK 0
#endif
#define RUN_PHASE(k, call) if constexpr (PH_ON(k)) { if (ph_lo <= (k) && (k) < ph_hi) { call; if ((k) + 1 < ph_hi) xcd_barrier(xb); } }
__global__ void __launch_bounds__(NTHREADS, 2) mega_fwd(Params p, int ph_lo, int ph_hi) {
    extern __shared__ __attribute__((aligned(16))) char smem[];
    __shared__ uint4 xb_words;
    if (threadIdx.x == 0) xb_words = make_uint4(0u, 0u, 0u, 0u);
    __syncthreads();
    const XcdBarrier xb = xcd_barrier_post(p.bar, (volatile LAS unsigned*)&xb_words);
    if (ph_lo < 0) cg::this_grid().sync();
    RUN_PHASE(0, phase_prologue(p, smem))
    { float* lt = (float*)(smem + SMEM_BYTES); for (int i = threadIdx.x; i < 3072; i += NTHREADS) lt[i] = p.misc[i]; __syncthreads(); }
    RUN_PHASE(1, phase_h0(p))
    RUN_PHASE(2, phase_proj0(p, smem))
    RUN_PHASE(3, phase_mla_up(p, smem))
    RUN_PHASE(4, phase_attn0(p, smem))
    RUN_PHASE(5, phase_gemm_plain(smem, (const bf16_t*)p.bar, p.o, 1024, p.wt_out0, 1024, 4, p.h, 1024, false))
    RUN_PHASE(6, phase_ln(p, p.x, p.ctx, 0, 2, p.ln1_g, p.ln1_b, p.out, p.xc, true, 0, 3, 4, true))
    RUN_PHASE(7, phase_ffn1(p, smem, 0))
    RUN_PHASE(8, phase_gemm_plain(smem, (const bf16_t*)p.bar, p.big + BE_HID, DFF, p.wt_down, DFF, 4, p.h, 1024, false))
    RUN_PHASE(9, phase_ln(p, p.out, p.xc, 0, 5, p.ln2_g, p.ln2_b, p.out, p.xc, true, 1, 0, 1, true))
    RUN_PHASE(10, phase_proj1(p, smem))
    RUN_PHASE(11, phase_attn1(p, smem))
    RUN_PHASE(12, phase_gemm_plain(smem, (const bf16_t*)p.bar, p.o, 1024, p.wt_dout, 1024, 4, p.h, 1024, true))
    RUN_PHASE(13, phase_ln(p, p.out, p.xc, 1, 2, p.ln1_g + DM, p.ln1_b + DM, p.out, p.xc, true, 1, 3, 4, false))
    RUN_PHASE(14, phase_ffn1(p, smem, 1))
    RUN_PHASE(15, phase_gemm_plain(smem, (const bf16_t*)p.bar, p.big + BE_HID, DFF, p.wt_down + (size_t)1024 * 2816, DFF, 4, p.h, 1024, true))
    RUN_PHASE(16, phase_ln(p, p.out, p.xc, 1, 5, p.ln2_g + DM, p.ln2_b + DM, p.out, p.xc, false, 1, 0, 1, false))
}

extern "C" void kernel_launch(void* const* d_in, const int* in_sizes, int n_in, void* d_out, int out_size, void* d_ws, size_t ws_size, hipStream_t stream) {
    static int grid = 0;
    if (grid == 0) {
        if (n_in != 29 || out_size != NBATCH * SEQ * DM || ws_size < WS_END) {
            fprintf(stderr, "kernel_launch: unexpected shapes (n_in %d, out %d, ws %zu, need %zu)\n", n_in, out_size, ws_size, (size_t)WS_END); grid = -1; return; }
        int dev = 0, cus = 0, per_cu = 0;
        hipGetDevice(&dev); hipDeviceGetAttribute(&cus, hipDeviceAttributeMultiprocessorCount, dev);
        if (hipFuncSetAttribute((const void*)mega_fwd, hipFuncAttributeMaxDynamicSharedMemorySize, SMEM_BYTES + SMEM_TABLES) != hipSuccess) { fprintf(stderr, "kernel_launch: hipFuncSetAttribute failed\n"); grid = -1; return; }
        if (hipOccupancyMaxActiveBlocksPerMultiprocessor(&per_cu, (const void*)mega_fwd, NTHREADS, SMEM_BYTES + SMEM_TABLES) != hipSuccess || per_cu < 1) { fprintf(stderr, "kernel_launch: occupancy query failed\n"); grid = -1; return; }
        if (per_cu > 1) per_cu = 1;
        grid = cus * per_cu;
        fprintf(stderr, "kernel_launch: grid %d (%d CUs x %d)\n", grid, cus, per_cu);
    }
    if (grid < 0) return;
    Params p{};
    const float* const* in = (const float* const*)d_in;
    p.x = in[0]; p.c = in[1]; p.ctx = in[2]; p.c_ctx = in[3]; p.w_mod = in[4]; p.b_mod = in[5]; p.ln1_g = in[6]; p.ln1_b = in[7]; p.ln2_g = in[8]; p.ln2_b = in[9];
    p.w_gate = in[10]; p.w_up = in[11]; p.conv_w = in[12]; p.conv_b = in[13]; p.w_down = in[14];
    p.ab_w_in = in[15]; p.q_norm = in[16]; p.w_qb = in[17]; p.kv_norm = in[18]; p.w_kvb = in[19]; p.sink = in[20]; p.ab_w_out = in[21];
    p.d_w_in = in[22]; p.lq1 = in[23]; p.lk1 = in[24]; p.lq2 = in[25]; p.lk2 = in[26]; p.subln = in[27]; p.d_w_out = in[28];
    p.out = (float*)d_out;
    char* ws = (char*)d_ws;
    p.wt_in0 = (bf16_t*)(ws + OFF_WT_IN0); p.wt_qb = (bf16_t*)(ws + OFF_WT_QB); p.wt_kvb = (bf16_t*)(ws + OFF_WT_KVB); p.wt_out0 = (bf16_t*)(ws + OFF_WT_OUT0);
    p.wt_din = (bf16_t*)(ws + OFF_WT_DIN); p.wt_dout = (bf16_t*)(ws + OFF_WT_DOUT); p.wt_gate = (bf16_t*)(ws + OFF_WT_GATE); p.wt_up = (bf16_t*)(ws + OFF_WT_UP);
    p.wt_down = (bf16_t*)(ws + OFF_WT_DOWN); p.mod = (float*)(ws + OFF_MOD); p.misc = (float*)(ws + OFF_MISC); p.bar = (unsigned*)(ws + OFF_BAR); p.xc = (float*)(ws + OFF_XC);
    p.h = (bf16_t*)(ws + OFF_H); p.o = (bf16_t*)(ws + OFF_O); p.big = (bf16_t*)(ws + OFF_BIG);
    if (hipMemsetAsync(ws + OFF_BAR, 0, 16384, stream) != hipSuccess) { fprintf(stderr, "kernel_launch: memset failed\n"); return; }
#if MULTI_LAUNCH
    for (int ph = 0; ph < N_PHASES; ++ph) hipLaunchKernelGGL(mega_fwd, dim3(grid), dim3(NTHREADS), SMEM_BYTES + SMEM_TABLES, stream, p, ph, ph + 1);
#else
    int lo = 0, hi = N_PHASES;
    void* args[] = {&p, &lo, &hi};
    hipError_t e = hipLaunchCooperativeKernel((const void*)mega_fwd, dim3(grid), dim3(NTHREADS), args, SMEM_BYTES + SMEM_TABLES, stream);
    if (e != hipSuccess) fprintf(stderr, "kernel_launch: cooperative launch failed: %s (grid %d)\n", hipGetErrorString(e), grid);
#if EXTRA_PHASE >= 0
    int lo2 = EXTRA_PHASE, hi2 = EXTRA_PHASE + 1;
    void* args2[] = {&p, &lo2, &hi2};
    (void)hipLaunchCooperativeKernel((const void*)mega_fwd, dim3(grid), dim3(NTHREADS), args2, SMEM_BYTES + SMEM_TABLES, stream);
#endif
#endif
}
```

```cpp
#include <hip/hip_runtime.h>
#include <hip/hip_cooperative_groups.h>
#include <cstdio>
#include <cstdint>
namespace cg = cooperative_groups;

#ifndef EXTRA_PHASE
#define EXTRA_PHASE -1
#endif
#ifndef EXTRA_SYNCS
#define EXTRA_SYNCS 0
#endif
#ifndef MULTI_LAUNCH
#define MULTI_LAUNCH 0
#endif

typedef unsigned short bf16_t;
typedef short bf16x8 __attribute__((ext_vector_type(8)));
typedef float f32x4 __attribute__((ext_vector_type(4)));
typedef unsigned u32x4 __attribute__((ext_vector_type(4)));
typedef unsigned u32x2 __attribute__((ext_vector_type(2)));

constexpr int NBATCH = 8, SEQ = 2048, CTXL = 256, TOK = 2304, ROWS = NBATCH * TOK, DM = 1024, DFF = 2816;
constexpr int NTHREADS = 512, NWAVES = 8;
constexpr int LDC = 132;
constexpr int CT_FLOATS = 128 * 132;
constexpr int SMEM_TABLES = 12288;
constexpr int SMEM_BYTES = 139264;
constexpr float ALPHA_RES = 1.41421356237f;
constexpr float LOG2E = 1.44269504089f;
constexpr float LAMBDA_INIT = 0.35550907f;

struct Params {
    const float *x, *c, *ctx, *c_ctx, *w_mod, *b_mod, *ln1_g, *ln1_b, *ln2_g, *ln2_b;
    const float *w_gate, *w_up, *conv_w, *conv_b, *w_down;
    const float *ab_w_in, *q_norm, *w_qb, *kv_norm, *w_kvb, *sink, *ab_w_out;
    const float *d_w_in, *lq1, *lk1, *lq2, *lk2, *subln, *d_w_out;
    float* out;
    bf16_t *wt_in0, *wt_qb, *wt_kvb, *wt_out0, *wt_din, *wt_dout, *wt_gate, *wt_up, *wt_down;
    float *mod, *misc, *xc;
    unsigned* bar;
    bf16_t *h, *o, *big;
};

constexpr size_t SZ_WT_IN0 = 1280ull * 1024 * 2, SZ_WT_QB = 768ull * 256 * 2, SZ_WT_KVB = 1024ull * 128 * 2, SZ_WT_SQ = 1024ull * 1024 * 2,
                 SZ_WT_DIN = 3072ull * 1024 * 2, SZ_WT_FF = 2ull * 2816 * 1024 * 2;
constexpr size_t OFF_WT_IN0 = 0, OFF_WT_QB = OFF_WT_IN0 + SZ_WT_IN0, OFF_WT_KVB = OFF_WT_QB + SZ_WT_QB, OFF_WT_OUT0 = OFF_WT_KVB + SZ_WT_KVB,
                 OFF_WT_DIN = OFF_WT_OUT0 + SZ_WT_SQ, OFF_WT_DOUT = OFF_WT_DIN + SZ_WT_DIN, OFF_WT_GATE = OFF_WT_DOUT + SZ_WT_SQ,
                 OFF_WT_UP = OFF_WT_GATE + SZ_WT_FF, OFF_WT_DOWN = OFF_WT_UP + SZ_WT_FF, OFF_MOD = OFF_WT_DOWN + SZ_WT_FF,
                 OFF_MISC = OFF_MOD + 2ull * 9 * 6144 * 4, OFF_BAR = OFF_MISC + 65536, OFF_XC = OFF_BAR + 16384, OFF_H = OFF_XC + 2048ull * 1024 * 4,
                 OFF_O = OFF_H + (size_t)ROWS * 1024 * 2, OFF_BIG = OFF_O + (size_t)ROWS * 1024 * 2;
constexpr size_t BE_PROJ0 = 0, BE_VT_SWA = BE_PROJ0 + (size_t)ROWS * 1024, BE_Q_MLA = BE_VT_SWA + 8ull * 2 * 64 * TOK,
                 BE_K_MLA = BE_Q_MLA + (size_t)ROWS * 768, BE_VT_MLA = BE_K_MLA + (size_t)ROWS * 768, BE_END0 = BE_VT_MLA + 8ull * 8 * 64 * TOK;
constexpr size_t BE_QD = 0, BE_KD = BE_QD + (size_t)ROWS * 1024, BE_VT_D = BE_KD + (size_t)ROWS * 1024, BE_END1 = BE_VT_D + 8ull * 8 * 128 * TOK;
constexpr size_t BE_HID = 0, BE_END2 = (size_t)ROWS * DFF;
constexpr size_t BIG_ELEMS = BE_END0 > BE_END1 ? (BE_END0 > BE_END2 ? BE_END0 : BE_END2) : (BE_END1 > BE_END2 ? BE_END1 : BE_END2);
constexpr size_t WS_END = OFF_BIG + BIG_ELEMS * 2;
constexpr int MISC_ROPE64 = 0, MISC_ROPE32 = 2048, MISC_LAM = 3072;

__device__ __forceinline__ unsigned cvt_pk_bf16(float lo, float hi) { unsigned r; asm("v_cvt_pk_bf16_f32 %0, %1, %2" : "=v"(r) : "v"(lo), "v"(hi)); return r; }
__device__ __forceinline__ float bf2f(unsigned short v) { return __uint_as_float((unsigned)v << 16); }
__device__ __forceinline__ float bflo(unsigned v) { return __uint_as_float(v << 16); }
__device__ __forceinline__ float bfhi(unsigned v) { return __uint_as_float(v & 0xffff0000u); }
__device__ __forceinline__ void store8(bf16_t* dst, const float (&v)[8]) {
    u32x4 w; w.x = cvt_pk_bf16(v[0], v[1]); w.y = cvt_pk_bf16(v[2], v[3]); w.z = cvt_pk_bf16(v[4], v[5]); w.w = cvt_pk_bf16(v[6], v[7]);
    *(u32x4*)dst = w;
}
__device__ __forceinline__ float wave_sum(float v) {
#pragma unroll
    for (int o = 1; o < 64; o <<= 1) v += __shfl_xor(v, o);
    return v;
}
__device__ __forceinline__ float fast_exp2(float x) { return __builtin_amdgcn_exp2f(x); }


#define XB_TMO      128
#define XB_XCNT(j)  (256  + 64 * (j))
#define XB_XSUB(j)  (1280 + 64 * (j))
#define XB_XGEN(j)  (2304 + 64 * (j))
#define XB_TOP      3328
#define XB_TOPGEN   3392
#define XCD_BAR_WORDS 3456
#define XB_SPIN_CAP (1u << 18)
#define LAS __attribute__((address_space(3)))
__device__ __forceinline__ unsigned xb_ld(unsigned* p)              { return __hip_atomic_load(p, __ATOMIC_RELAXED, __HIP_MEMORY_SCOPE_AGENT); }
__device__ __forceinline__ unsigned xb_add(unsigned* p, unsigned v) { return __hip_atomic_fetch_add(p, v, __ATOMIC_RELAXED, __HIP_MEMORY_SCOPE_AGENT); }
__device__ __forceinline__ unsigned xb_xcc_id() { return (unsigned)__builtin_amdgcn_s_getreg((3 << 11) | 20) & 0xFu; }
#define XB_SPIN(cond, bar) do { unsigned _sp = 0; while (cond) { __builtin_amdgcn_s_sleep(1); \
    if ((++_sp & 255u) == 0u) { if (xb_ld(&(bar)[XB_TMO])) break; if (_sp > XB_SPIN_CAP) { atomicAdd(&(bar)[XB_TMO], 1u); break; } } } } while (0)
struct XcdBarrier { unsigned* bar; unsigned x; volatile LAS unsigned* st; };
__device__ __forceinline__ XcdBarrier xcd_barrier_post(unsigned* bar, volatile LAS unsigned* st) {
    XcdBarrier b; b.bar = bar; b.x = xb_xcc_id(); b.st = st;
    if (threadIdx.x == 0) (void)xb_add(&bar[XB_XCNT(b.x)], 1u);
    return b;
}
__device__ __forceinline__ void xcd_barrier_complete(unsigned* bar, unsigned x, unsigned& nloc, unsigned& nx) {
    const unsigned G = gridDim.x * gridDim.y * gridDim.z;
    unsigned sum, cnt, mine, sp = 0u;
    for (;;) {
        sum = 0u; cnt = 0u; mine = 0u;
#pragma unroll
        for (unsigned j = 0; j < 16; ++j) { const unsigned c = xb_ld(&bar[XB_XCNT(j)]); sum += c; cnt += (c > 0u) ? 1u : 0u; mine = (j == x) ? c : mine; }
        if (sum == G) break;
        __builtin_amdgcn_s_sleep(1);
        if ((++sp & 255u) == 0u) { if (xb_ld(&bar[XB_TMO])) break; if (sp > XB_SPIN_CAP) { atomicAdd(&bar[XB_TMO], 1u); break; } }
    }
    nloc = mine > 0u ? mine : 1u; nx = cnt > 0u ? cnt : 1u;
}
__device__ __forceinline__ void xcd_barrier(const XcdBarrier& b) {
    asm volatile("s_waitcnt vmcnt(0)" ::: "memory");
    __syncthreads();
    if (threadIdx.x == 0) {
        unsigned* bar = b.bar;
        __builtin_amdgcn_s_waitcnt(0);
        unsigned nloc = b.st[0], nx = b.st[1];
        if (nloc == 0u) { xcd_barrier_complete(bar, b.x, nloc, nx); b.st[0] = nloc; b.st[1] = nx; }
        const unsigned old = xb_add(&bar[XB_XSUB(b.x)], 1u);
        const unsigned gen = old / nloc;
        if (old + 1u == (gen + 1u) * nloc) {
            __builtin_amdgcn_fence(__ATOMIC_RELEASE, "agent");
            asm volatile("s_waitcnt vmcnt(0)" ::: "memory");
            const unsigned og = xb_add(&bar[XB_TOP], 1u);
            const unsigned tg = og / nx;
            if (og + 1u == (tg + 1u) * nx) xb_add(&bar[XB_TOPGEN], 1u);
            else XB_SPIN(xb_ld(&bar[XB_TOPGEN]) == tg, bar);
            __builtin_amdgcn_fence(__ATOMIC_ACQUIRE, "agent");
            xb_add(&bar[XB_XGEN(b.x)], 1u);
            asm volatile("s_waitcnt vmcnt(0)" ::: "memory");
        } else {
            XB_SPIN(xb_ld(&bar[XB_XGEN(b.x)]) == gen, bar);
            __builtin_amdgcn_fence(__ATOMIC_ACQUIRE, "agent");
            asm volatile("s_waitcnt vmcnt(0)" ::: "memory");
        }
    }
    __syncthreads();
}

__device__ __forceinline__ void mod_item(const Params& p, char* smem, int it) {
    float* s_silu = (float*)smem;
    float* red = (float*)(smem + 9 * 1024 * 4);
    const int tid = threadIdx.x, lane = tid & 63, w = tid >> 6;
    const int layer = it / 96, col0 = (it % 96) * 64;
    for (int idx = tid; idx < 9 * 1024; idx += NTHREADS) {
        const int b = idx >> 10, k = idx & 1023;
        const float v = (b < 8) ? p.c[b * 1024 + k] : p.c_ctx[k];
        s_silu[idx] = v / (1.f + __expf(-v));
    }
    __syncthreads();
    float acc[9];
#pragma unroll
    for (int b = 0; b < 9; ++b) acc[b] = 0.f;
    const float* wp = p.w_mod + (size_t)layer * 1024 * 6144 + (size_t)(w * 128) * 6144 + col0 + lane;
    for (int kk = 0; kk < 128; kk += 8) {
        float wv[8];
#pragma unroll
        for (int u = 0; u < 8; ++u) wv[u] = wp[(size_t)(kk + u) * 6144];
#pragma unroll
        for (int b = 0; b < 9; ++b) {
            const f32x4 s0 = *(const f32x4*)(s_silu + b * 1024 + w * 128 + kk), s1 = *(const f32x4*)(s_silu + b * 1024 + w * 128 + kk + 4);
            acc[b] += s0[0] * wv[0] + s0[1] * wv[1] + s0[2] * wv[2] + s0[3] * wv[3] + s1[0] * wv[4] + s1[1] * wv[5] + s1[2] * wv[6] + s1[3] * wv[7];
        }
    }
#pragma unroll
    for (int b = 0; b < 9; ++b) red[(w * 9 + b) * 64 + lane] = acc[b];
    __syncthreads();
    for (int idx = tid; idx < 9 * 64; idx += NTHREADS) {
        const int b = idx >> 6, l = idx & 63;
        float s = 0.f;
#pragma unroll
        for (int ww = 0; ww < NWAVES; ++ww) s += red[(ww * 9 + b) * 64 + l];
        p.mod[(size_t)(layer * 9 + b) * 6144 + col0 + l] = s + p.b_mod[layer * 6144 + col0 + l];
    }
}

__device__ __forceinline__ void table_item(const Params& p) {
    const int tid = threadIdx.x;
    for (int idx = tid; idx < 64 * 16; idx += NTHREADS) {
        const int pi = idx >> 4, i = idx & 15;
        const float freq = exp2f(-(float)i * (13.28771238f / 16.f));
        const float ang = (float)pi * freq;
        p.misc[MISC_ROPE64 + idx * 2] = __cosf(ang); p.misc[MISC_ROPE64 + idx * 2 + 1] = __sinf(ang);
    }
    for (int idx = tid; idx < 64 * 8; idx += NTHREADS) {
        const int pi = idx >> 3, i = idx & 7;
        const float freq = exp2f(-(float)i * (13.28771238f / 8.f));
        const float ang = (float)pi * freq;
        p.misc[MISC_ROPE32 + idx * 2] = __cosf(ang); p.misc[MISC_ROPE32 + idx * 2 + 1] = __sinf(ang);
    }
    if (tid == 0) {
        float s1 = 0.f, s2 = 0.f;
        for (int i = 0; i < 64; ++i) { s1 += p.lq1[i] * p.lk1[i]; s2 += p.lq2[i] * p.lk2[i]; }
        p.misc[MISC_LAM] = __expf(s1) - __expf(s2) + LAMBDA_INIT;
    }
}

__device__ __forceinline__ void transpose_tile(char* smem, const float* src, int K, int Nsrc, bf16_t* dst, int ntn, int mode, const float* gain, int tile, int dmul = 1, int dadd = 0) {
    float* t = (float*)smem;
    const int tid = threadIdx.x, tx = tid & 63, ty = tid >> 6;
    const int kt = tile / ntn, nt = tile % ntn;
    const int np = nt * 64 + tx;
    int n = np;
    if (mode == 1) { n = np < 896 ? np : (np < 1024 ? 928 + (np - 896) : (np < 1152 ? 1056 + (np - 1024) : (np < 1184 ? 896 + (np - 1152) : -1))); }
    else if (mode == 2) { if (np < 512) n = (np >> 6) * 96 + (np & 63); else { const int m = np - 512; n = (m >> 5) * 96 + 64 + (m & 31); } }
#pragma unroll
    for (int i = 0; i < 8; ++i) {
        const int kl = ty + 8 * i, k = kt * 64 + kl;
        float v = 0.f;
        if (n >= 0) { v = src[(size_t)k * Nsrc + n]; if (gain) v *= gain[k]; }
        t[kl * 65 + tx] = v;
    }
    __syncthreads();
#pragma unroll
    for (int i = 0; i < 8; ++i) {
        const int nl = ty + 8 * i;
        dst[(size_t)((nt * dmul + dadd) * 64 + nl) * K + kt * 64 + tx] = (bf16_t)(cvt_pk_bf16(t[tx * 65 + nl], 0.f) & 0xffffu);
    }
}

__device__ __forceinline__ void transpose_item(const Params& p, char* smem, int r) {
    constexpr int T0 = 16 * 20, T1 = 4 * 12, T2 = 2 * 16, T3 = 16 * 16, T4 = 16 * 48, T5 = 16 * 16, TF = 16 * 44;
    if (r < T0) { transpose_tile(smem, p.ab_w_in, 1024, 1184, p.wt_in0, 20, 1, nullptr, r); return; } r -= T0;
    if (r < T1) { transpose_tile(smem, p.w_qb, 256, 768, p.wt_qb, 12, 2, p.q_norm, r); return; } r -= T1;
    if (r < T2) { transpose_tile(smem, p.w_kvb, 128, 1024, p.wt_kvb, 16, 0, p.kv_norm, r); return; } r -= T2;
    if (r < T3) { transpose_tile(smem, p.ab_w_out, 1024, 1024, p.wt_out0, 16, 0, nullptr, r); return; } r -= T3;
    if (r < T4) { transpose_tile(smem, p.d_w_in, 1024, 3072, p.wt_din, 48, 0, nullptr, r); return; } r -= T4;
    if (r < T5) { transpose_tile(smem, p.d_w_out, 1024, 1024, p.wt_dout, 16, 0, nullptr, r); return; } r -= T5;
    {
        const int j = r / TF, rr = r % TF;
        if (j < 2) transpose_tile(smem, p.w_gate + (size_t)j * 1024 * 2816, 1024, 2816, p.wt_gate + (size_t)j * 5632 * 1024, 44, 0, nullptr, rr, 2, 0);
        else if (j < 4) transpose_tile(smem, p.w_up + (size_t)(j - 2) * 1024 * 2816, 1024, 2816, p.wt_gate + (size_t)(j - 2) * 5632 * 1024, 44, 0, nullptr, rr, 2, 1);
        else transpose_tile(smem, p.w_down + (size_t)(j - 4) * 2816 * 1024, 2816, 1024, p.wt_down + (size_t)(j - 4) * 1024 * 2816, 16, 0, nullptr, rr);
    }
}
constexpr int N_TR_TILES = 16 * 20 + 4 * 12 + 2 * 16 + 16 * 16 + 16 * 48 + 16 * 16 + 6 * 16 * 44;

__device__ __forceinline__ void phase_prologue(const Params& p, char* smem) {
    const int total = 193 + N_TR_TILES;
    for (int it = blockIdx.x; it < total; it += gridDim.x) {
        if (it < 192) mod_item(p, smem, it);
        else if (it == 192) table_item(p);
        else transpose_item(p, smem, it - 193);
        __syncthreads();
    }
}

__device__ __forceinline__ void phase_h0(const Params& p) {
    const int lane = threadIdx.x & 63, w = threadIdx.x >> 6;
    for (int row = blockIdx.x * NWAVES + w; row < ROWS; row += gridDim.x * NWAVES) {
        const int b = row / TOK, j = row % TOK; const bool isc = j < CTXL;
        const float* rp = isc ? p.ctx + ((size_t)b * CTXL + j) * DM : p.x + ((size_t)b * SEQ + (j - CTXL)) * DM;
        const float* md = p.mod + (size_t)(0 * 9 + (isc ? 8 : b)) * 6144;
#pragma unroll 1
        for (int i = 0; i < 4; ++i) {
            const int col = i * 256 + lane * 4;
            const f32x4 v = *(const f32x4*)(rp + col), sh = *(const f32x4*)(md + col), sc = *(const f32x4*)(md + 1024 + col);
            u32x2 o; o.x = cvt_pk_bf16(v[0] * (1.f + sc[0]) + sh[0], v[1] * (1.f + sc[1]) + sh[1]); o.y = cvt_pk_bf16(v[2] * (1.f + sc[2]) + sh[2], v[3] * (1.f + sc[3]) + sh[3]);
            *(u32x2*)(p.h + (size_t)row * DM + col) = o;
        }
    }
}

__device__ __forceinline__ void gemm_core(char* smem, const bf16_t* __restrict__ A, int lda, int ar0a, int aloa, int ahia, int ar0b, int alob, int ahib,
                                          const bf16_t* __restrict__ B, int ldb, int K, const bf16_t* zero16, f32x4 (&acc)[8][4]) {
    constexpr int ROWB = 128, OPA = 256 * ROWB, STG = 2 * OPA, NI = 4;
    static_assert(2 * STG <= SMEM_BYTES, "LDS");
    const int tid = threadIdx.x, lane = tid & 63, w = __builtin_amdgcn_readfirstlane(tid >> 6), wr = w >> 2, wc = w & 3, fr = lane & 15, fq = lane >> 4;
    const int rl = lane >> 3, kcs = (lane & 7) ^ rl;
#pragma unroll
    for (int m = 0; m < 8; ++m)
#pragma unroll
        for (int n = 0; n < 4; ++n) acc[m][n] = (f32x4){0.f, 0.f, 0.f, 0.f};
    const int nk = K / 64;
    int aoff[NI], boff[NI];
#pragma unroll
    for (int i = 0; i < NI; ++i) {
        const int row = (w * NI + i) * 8 + rl, hf = row >> 7, gr = (hf ? ar0b : ar0a) + (row & 127);
        const bool ok = hf ? (gr >= alob && gr < ahib) : (gr >= aloa && gr < ahia);
        aoff[i] = ok ? gr * lda + kcs * 8 : -1;
        boff[i] = row * ldb + kcs * 8;
    }
    __syncthreads();
#pragma unroll
    for (int i = 0; i < NI; ++i) {
        __builtin_amdgcn_global_load_lds((const unsigned*)(aoff[i] >= 0 ? A + aoff[i] : zero16), (LAS unsigned*)(smem + (w * NI + i) * 1024), 16, 0, 0);
        __builtin_amdgcn_global_load_lds((const unsigned*)(B + boff[i]), (LAS unsigned*)(smem + OPA + (w * NI + i) * 1024), 16, 0, 0);
    }
    asm volatile("s_waitcnt vmcnt(0)" ::: "memory"); __syncthreads();
    const int sw = fr & 7;
    for (int kt = 0; kt < nk; ++kt) {
        const bool pf = kt + 1 < nk; const int nst = ((kt + 1) & 1) * STG;
        const char* base = smem + (kt & 1) * STG;
        bf16x8 bfr[2][4];
#pragma unroll
        for (int n = 0; n < 4; ++n) bfr[0][n] = *(const bf16x8*)(base + OPA + (wc * 64 + n * 16 + fr) * ROWB + ((fq ^ sw) * 16));
#pragma unroll
        for (int ks = 0; ks < 2; ++ks) {
            const int co = (((ks * 4 + fq) ^ sw) * 16);
#pragma unroll
            for (int m = 0; m < 8; ++m) {
                const bf16x8 af = *(const bf16x8*)(base + (wr * 128 + m * 16 + fr) * ROWB + co);
#pragma unroll
                for (int n = 0; n < 4; ++n) acc[m][n] = __builtin_amdgcn_mfma_f32_16x16x32_bf16(af, bfr[ks][n], acc[m][n], 0, 0, 0);
                if (ks == 0 && m == 5) {
#pragma unroll
                    for (int n = 0; n < 4; ++n) bfr[1][n] = *(const bf16x8*)(base + OPA + (wc * 64 + n * 16 + fr) * ROWB + (((4 + fq) ^ sw) * 16));
                }
                if (ks == 0 && pf) {
                    const int i = m & 3, lo_ = nst + (w * NI + i) * 1024;
                    if (m < 4) __builtin_amdgcn_global_load_lds((const unsigned*)(aoff[i] >= 0 ? A + aoff[i] + (kt + 1) * 64 : zero16), (LAS unsigned*)(smem + lo_), 16, 0, 0);
                    else __builtin_amdgcn_global_load_lds((const unsigned*)(B + boff[i] + (kt + 1) * 64), (LAS unsigned*)(smem + lo_ + OPA), 16, 0, 0);
                }
            }
        }
        asm volatile("s_waitcnt vmcnt(0)" ::: "memory");
        __syncthreads();
    }
}

__device__ __forceinline__ void acc_to_ct(float* Ct0, const f32x4 (&acc)[8][4], int ai) {
    const int tid = threadIdx.x, lane = tid & 63, w = tid >> 6, wr = w >> 2, wc = w & 3, fr = lane & 15, fq = lane >> 4;
    __syncthreads();
    if (wr == ai) {
        float* Ct = Ct0 + (wc >> 1) * CT_FLOATS + (wc & 1) * 64 + fr;
#pragma unroll
        for (int m = 0; m < 8; ++m)
#pragma unroll
            for (int n = 0; n < 4; ++n)
#pragma unroll
                for (int j = 0; j < 4; ++j) Ct[(m * 16 + fq * 4 + j) * LDC + n * 16] = acc[m][n][j];
    }
    __syncthreads();
}

__device__ __forceinline__ void gemm_core_h(char* smem, const bf16_t* __restrict__ A, int lda, int ar0a, int aloa, int ahia, int ar0b, int alob, int ahib,
                                            const bf16_t* __restrict__ B, int ldb, int K, const bf16_t* zero16, f32x4 (&acc)[4][4]) {
    constexpr int ROWB = 128, OPA = 256 * ROWB, STG = 2 * OPA, NI = 4, NIB = 2;
    const int tid = threadIdx.x, lane = tid & 63, w = __builtin_amdgcn_readfirstlane(tid >> 6), wr = w >> 1, wc = w & 1, fr = lane & 15, fq = lane >> 4;
    const int rl = lane >> 3, kcs = (lane & 7) ^ rl;
#pragma unroll
    for (int m = 0; m < 4; ++m)
#pragma unroll
        for (int n = 0; n < 4; ++n) acc[m][n] = (f32x4){0.f, 0.f, 0.f, 0.f};
    const int nk = K / 64;
    int aoff[NI], boff[NIB];
#pragma unroll
    for (int i = 0; i < NI; ++i) {
        const int row = (w * NI + i) * 8 + rl, hf = row >> 7, gr = (hf ? ar0b : ar0a) + (row & 127);
        const bool ok = hf ? (gr >= alob && gr < ahib) : (gr >= aloa && gr < ahia);
        aoff[i] = ok ? gr * lda + kcs * 8 : -1;
    }
#pragma unroll
    for (int i = 0; i < NIB; ++i) boff[i] = ((w * NIB + i) * 8 + rl) * ldb + kcs * 8;
    __syncthreads();
#pragma unroll
    for (int i = 0; i < NI; ++i) __builtin_amdgcn_global_load_lds((const unsigned*)(aoff[i] >= 0 ? A + aoff[i] : zero16), (LAS unsigned*)(smem + (w * NI + i) * 1024), 16, 0, 0);
#pragma unroll
    for (int i = 0; i < NIB; ++i) __builtin_amdgcn_global_load_lds((const unsigned*)(B + boff[i]), (LAS unsigned*)(smem + OPA + (w * NIB + i) * 1024), 16, 0, 0);
    asm volatile("s_waitcnt vmcnt(0)" ::: "memory"); __syncthreads();
    const int sw = fr & 7;
    for (int kt = 0; kt < nk; ++kt) {
        const bool pf = kt + 1 < nk; const int nst = ((kt + 1) & 1) * STG;
        const char* base = smem + (kt & 1) * STG;
#pragma unroll
        for (int ks = 0; ks < 2; ++ks) {
            const int co = (((ks * 4 + fq) ^ sw) * 16);
            bf16x8 bfr[4];
#pragma unroll
            for (int n = 0; n < 4; ++n) bfr[n] = *(const bf16x8*)(base + OPA + (wc * 64 + n * 16 + fr) * ROWB + co);
#pragma unroll
            for (int m = 0; m < 4; ++m) {
                const bf16x8 af = *(const bf16x8*)(base + (wr * 64 + m * 16 + fr) * ROWB + co);
#pragma unroll
                for (int n = 0; n < 4; ++n) acc[m][n] = __builtin_amdgcn_mfma_f32_16x16x32_bf16(af, bfr[n], acc[m][n], 0, 0, 0);
                if (pf) {
                    if (ks == 0) __builtin_amdgcn_global_load_lds((const unsigned*)(aoff[m] >= 0 ? A + aoff[m] + (kt + 1) * 64 : zero16), (LAS unsigned*)(smem + nst + (w * NI + m) * 1024), 16, 0, 0);
                    else if (m < NIB) __builtin_amdgcn_global_load_lds((const unsigned*)(B + boff[m & 1] + (kt + 1) * 64), (LAS unsigned*)(smem + nst + OPA + (w * NIB + (m & 1)) * 1024), 16, 0, 0);
                }
            }
        }
        asm volatile("s_waitcnt vmcnt(0)" ::: "memory");
        __syncthreads();
    }
}
__device__ __forceinline__ void acc_to_ct_h(float* Ct0, const f32x4 (&acc)[4][4], int ai) {
    const int tid = threadIdx.x, lane = tid & 63, w = tid >> 6, wr = w >> 1, wc = w & 1, fr = lane & 15, fq = lane >> 4;
    __syncthreads();
    if ((wr >> 1) == ai) {
        float* Ct = Ct0 + ((wr & 1) * 64 + fq * 4) * LDC + wc * 64 + fr;
#pragma unroll
        for (int m = 0; m < 4; ++m)
#pragma unroll
            for (int n = 0; n < 4; ++n)
#pragma unroll
                for (int j = 0; j < 4; ++j) Ct[(m * 16 + j) * LDC + n * 16] = acc[m][n][j];
    }
    __syncthreads();
}
#define TAIL_DECODE(T) const int G_ = gridDim.x, Tfull_ = ((T) / G_) * G_, total_ = Tfull_ + 2 * ((T) - Tfull_)
#define NOTAIL_DECODE(T) const int G_ = gridDim.x, Tfull_ = (T), total_ = (T)
#define TAIL_ITEM(it, tile, half) int tile, half; if ((it) < Tfull_) { tile = (it); half = -1; } else { const int r_ = (it) - Tfull_; tile = Tfull_ + (r_ >> 1); half = r_ & 1; }

__device__ __forceinline__ void load8(const float* src, float (&v)[8]) {
    const f32x4 a = *(const f32x4*)src, b = *(const f32x4*)(src + 4);
    v[0] = a[0]; v[1] = a[1]; v[2] = a[2]; v[3] = a[3]; v[4] = b[0]; v[5] = b[1]; v[6] = b[2]; v[7] = b[3];
}

__device__ __forceinline__ void rope8(const float* rowp, int c0, int hd, int pos, const float* tab, float (&v)[8]) {
    const int qs = hd >> 2, ch = c0 & (hd - 1), qd = ch / qs, i0 = ch & (qs - 1);
    const int idx = (qd < 2) ? (pos >> 6) : (pos & 63);
    const int pc = (qd & 1) ? c0 - qs : c0 + qs; const float sgn = (qd & 1) ? 1.f : -1.f;
    const float* t = tab + (idx * qs + i0) * 2;
#pragma unroll
    for (int e = 0; e < 8; ++e) v[e] = v[e] * t[2 * e] + sgn * rowp[pc + e] * t[2 * e + 1];
}

__device__ __forceinline__ void store_col8(const float* Ct, int c, int rc, bf16_t* dst, const float* rs) {
    float v[8];
#pragma unroll
    for (int e = 0; e < 8; ++e) { v[e] = Ct[(rc * 8 + e) * LDC + c]; if (rs) v[e] *= rs[rc * 8 + e]; }
    store8(dst, v);
}

__device__ __forceinline__ void epi_proj0(const Params& p, const float* Ct, int mt, int nt) {
    const int tid = threadIdx.x;
    bf16_t* proj0 = p.big + BE_PROJ0; bf16_t* vt_swa = p.big + BE_VT_SWA; bf16_t* k_mla = p.big + BE_K_MLA;
    extern __shared__ __attribute__((aligned(16))) char smem_dyn_[]; const float* lds_tab_ = (const float*)(smem_dyn_ + SMEM_BYTES);
    const float* rope64 = lds_tab_ + MISC_ROPE64; const float* rope32 = lds_tab_ + MISC_ROPE32;
    const int b = mt / 18, jt = mt % 18; const bool is_ctx = jt < 2; const int row0 = mt * 128, tok0 = jt * 128;
    if (nt == 8) {
#pragma unroll 1
        for (int i = 0; i < 4; ++i) { const int id = tid + NTHREADS * i, c = id & 127, rc = id >> 7;
            store_col8(Ct, c, rc, vt_swa + (size_t)((b * 2 + (c >> 6)) * 64 + (c & 63)) * TOK + tok0 + rc * 8, nullptr); }
    } else {
#pragma unroll 1
        for (int i = 0; i < 4; ++i) {
            const int id = tid + NTHREADS * i, r = id >> 4, c0 = (id & 15) * 8;
            const float* rowp = Ct + r * LDC; float v[8]; load8(rowp + c0, v);
            const int grow = row0 + r, pos = tok0 + r - CTXL;
            if (nt <= 1 || nt == 6) { store8(proj0 + (size_t)grow * 1024 + nt * 128 + c0, v); }
            else if (nt <= 5 || nt == 7) { if (!is_ctx) rope8(rowp, c0, 64, pos, rope64, v); store8(proj0 + (size_t)grow * 1024 + (nt == 7 ? 896 : nt * 128) + c0, v); }
            else if (c0 < 32) { if (!is_ctx) rope8(rowp, c0, 32, pos, rope32, v);
#pragma unroll
                for (int hh = 0; hh < 8; ++hh) store8(k_mla + (size_t)grow * 768 + hh * 96 + 64 + c0, v); }
        }
    }
}
__device__ __forceinline__ void phase_proj0(const Params& p, char* smem) {
    float* Ct = (float*)smem;
    TAIL_DECODE(72 * 5);
    for (int it = blockIdx.x; it < total_; it += G_) {
        TAIL_ITEM(it, tile, half)
        const int mt2 = tile / 5, nt2 = tile % 5;
        if (half < 0) {
            f32x4 acc[8][4];
            gemm_core(smem, p.h, DM, mt2 * 256, 0, ROWS, mt2 * 256 + 128, 0, ROWS, p.wt_in0 + (size_t)nt2 * 256 * DM, DM, DM, (const bf16_t*)p.bar, acc);
#pragma unroll 1
            for (int ai = 0; ai < 2; ++ai) {
                acc_to_ct(Ct, acc, ai);
                epi_proj0(p, Ct, mt2 * 2 + ai, nt2 * 2);
                epi_proj0(p, Ct + CT_FLOATS, mt2 * 2 + ai, nt2 * 2 + 1);
            }
        } else {
            const int nt = nt2 * 2 + half;
            f32x4 acc[4][4];
            gemm_core_h(smem, p.h, DM, mt2 * 256, 0, ROWS, mt2 * 256 + 128, 0, ROWS, p.wt_in0 + (size_t)nt * 128 * DM, DM, DM, (const bf16_t*)p.bar, acc);
#pragma unroll 1
            for (int ai = 0; ai < 2; ++ai) { acc_to_ct_h(Ct, acc, ai); epi_proj0(p, Ct, mt2 * 2 + ai, nt); }
        }
    }
}

__device__ __forceinline__ void row_rstd(const bf16_t* A, int lda, int row0, int K, float* rs) {
    const int tid = threadIdx.x;
    if (tid < 256) {
        const int r = tid >> 1, hf = tid & 1; const int n = K / 2;
        const bf16_t* ap = A + (size_t)(row0 + r) * lda + hf * n; float ss = 0.f;
        for (int k = 0; k < n; k += 8) { const u32x4 v = *(const u32x4*)(ap + k);
            ss += bflo(v.x) * bflo(v.x) + bfhi(v.x) * bfhi(v.x) + bflo(v.y) * bflo(v.y) + bfhi(v.y) * bfhi(v.y) + bflo(v.z) * bflo(v.z) + bfhi(v.z) * bfhi(v.z) + bflo(v.w) * bflo(v.w) + bfhi(v.w) * bfhi(v.w); }
        ss += __shfl_xor(ss, 1);
        if (hf == 0) rs[r] = rsqrtf(ss / (float)K + 1e-6f);
    }
    __syncthreads();
}
__device__ __forceinline__ void epi_mla_q(const Params& p, const float* Ct, const float* rs, int mt, int nt) {
    extern __shared__ __attribute__((aligned(16))) char smem_dyn_[]; const float* lds_tab_ = (const float*)(smem_dyn_ + SMEM_BYTES);
    const int tid = threadIdx.x; bf16_t* q_mla = p.big + BE_Q_MLA; const float* rope32 = lds_tab_ + MISC_ROPE32;
    const int jt = mt % 18; const bool is_ctx = jt < 2; const int row0 = mt * 128, tok0 = jt * 128;
#pragma unroll 1
    for (int i = 0; i < 4; ++i) {
        const int id = tid + NTHREADS * i, r = id >> 4, c0 = (id & 15) * 8;
        const float* rowp = Ct + r * LDC; float v[8]; load8(rowp + c0, v);
        const int grow = row0 + r, pos = tok0 + r - CTXL; const float sc = rs[r];
        int dcol;
        if (nt < 4) { const int cg = nt * 128 + c0; dcol = (cg >> 6) * 96 + (cg & 63); }
        else { const int cg = (nt - 4) * 128 + c0; dcol = (cg >> 5) * 96 + 64 + (cg & 31); if (!is_ctx) rope8(rowp, c0, 32, pos, rope32, v); }
#pragma unroll
        for (int e = 0; e < 8; ++e) v[e] *= sc;
        store8(q_mla + (size_t)grow * 768 + dcol, v);
    }
}
__device__ __forceinline__ void epi_mla_kv(const Params& p, const float* Ct, const float* rs, int mt, int hh) {
    const int tid = threadIdx.x; bf16_t* k_mla = p.big + BE_K_MLA; bf16_t* vt_mla = p.big + BE_VT_MLA;
    const int b = mt / 18, jt = mt % 18; const int row0 = mt * 128, tok0 = jt * 128;
#pragma unroll 1
    for (int i = 0; i < 2; ++i) {
        const int id = tid + NTHREADS * i, r = id >> 3, c0 = (id & 7) * 8;
        float v[8]; load8(Ct + r * LDC + c0, v); const float sc = rs[r];
#pragma unroll
        for (int e = 0; e < 8; ++e) v[e] *= sc;
        store8(k_mla + (size_t)(row0 + r) * 768 + hh * 96 + c0, v);
    }
#pragma unroll 1
    for (int i = 0; i < 2; ++i) { const int id = tid + NTHREADS * i, c = 64 + (id & 63), rc = id >> 6;
        store_col8(Ct, c, rc, vt_mla + (size_t)((b * 8 + hh) * 64 + (c - 64)) * TOK + tok0 + rc * 8, rs); }
}
__device__ __forceinline__ void phase_mla_up(const Params& p, char* smem) {
    float* Ct = (float*)smem; float* rs = (float*)(smem + 2 * CT_FLOATS * 4);
    bf16_t* proj0 = p.big + BE_PROJ0;
    for (int it = blockIdx.x; it < 72 * 7; it += gridDim.x) {
        const int mt2 = it / 7, nt2 = it % 7;
        f32x4 acc[8][4];
        if (nt2 < 3) gemm_core(smem, proj0, 1024, mt2 * 256, 0, ROWS, mt2 * 256 + 128, 0, ROWS, p.wt_qb + (size_t)nt2 * 256 * 256, 256, 256, (const bf16_t*)p.bar, acc);
        else gemm_core(smem, proj0 + 768, 1024, mt2 * 256, 0, ROWS, mt2 * 256 + 128, 0, ROWS, p.wt_kvb + (size_t)(nt2 - 3) * 256 * 128, 128, 128, (const bf16_t*)p.bar, acc);
#pragma unroll 1
        for (int ai = 0; ai < 2; ++ai) {
            acc_to_ct(Ct, acc, ai);
            const int mt = mt2 * 2 + ai;
            if (nt2 < 3) { row_rstd(proj0, 1024, mt * 128, 256, rs); epi_mla_q(p, Ct, rs, mt, nt2 * 2); epi_mla_q(p, Ct + CT_FLOATS, rs, mt, nt2 * 2 + 1); }
            else { row_rstd(proj0 + 768, 1024, mt * 128, 128, rs); epi_mla_kv(p, Ct, rs, mt, (nt2 - 3) * 2); epi_mla_kv(p, Ct + CT_FLOATS, rs, mt, (nt2 - 3) * 2 + 1); }
        }
    }
}

template <int DQK, int DV, bool WINDOWED>
__device__ __forceinline__ void flash_pass(char* smem, const bf16_t* __restrict__ Qp, int ldq, const bf16_t* __restrict__ Kp, int ldk,
                                           const bf16_t* __restrict__ Vtp, int seg2s, int seg2e, int q_tok0, float sc2,
                                           f32x4 (&o)[DV / 16][2], float (&mrun)[2], float (&lrun)[2]) {
    constexpr int KROW = DQK * 2, VROW = 128, KB = 64 * KROW, VB = DV * VROW, STG = KB + VB;
    constexpr int KCPR = DQK / 8, NKI = KCPR, NVI = DV / 8, KCPT = (NKI + 7) / 8, VCPT = NVI / 8, NKS = DQK / 32, NMD = DV / 16;
    static_assert(2 * STG <= SMEM_BYTES, "LDS");
    const int tid = threadIdx.x, lane = tid & 63, w = tid >> 6, fr = lane & 15, fq = lane >> 4, wq0 = w * 32;
    bf16x8 qf[2][NKS];
#pragma unroll
    for (int nq = 0; nq < 2; ++nq)
#pragma unroll
        for (int ks = 0; ks < NKS; ++ks) qf[nq][ks] = *(const bf16x8*)(Qp + (size_t)(wq0 + nq * 16 + fr) * ldq + ks * 32 + fq * 8);
#pragma unroll
    for (int md = 0; md < NMD; ++md) { o[md][0] = (f32x4){0.f, 0.f, 0.f, 0.f}; o[md][1] = (f32x4){0.f, 0.f, 0.f, 0.f}; }
    float mref[2]; mref[0] = mref[1] = -1e30f; lrun[0] = lrun[1] = 0.f;
    const float thr = 8.0f / sc2;
    const int nt = 4 + (seg2e > seg2s ? (seg2e - seg2s) / 64 : 0);
    const int wu = __builtin_amdgcn_readfirstlane(w);
    int koffg[KCPT], voffg[VCPT];
#pragma unroll
    for (int i = 0; i < KCPT; ++i) { const int idx = (wu + 8 * i) * 64 + lane, rho = (idx / KCPR) & 63, cp = idx % KCPR;
        const int key = 32 * (rho >> 5) + 8 * ((rho >> 2) & 3) + 4 * ((rho >> 4) & 1) + (rho & 3);
        const int kcs = (DQK == 64) ? (cp ^ (rho & 7)) : ((cp & ~3) | ((cp & 3) ^ ((4 - ((rho >> 2) & 3)) & 3)));
        koffg[i] = key * ldk + kcs * 8; }
#pragma unroll
    for (int i = 0; i < VCPT; ++i) { const int idx = (wu + 8 * i) * 64 + lane, r = idx >> 3, cp = idx & 7; voffg[i] = r * TOK + ((cp ^ (r & 7)) * 8); }
    __syncthreads();
#define FDMA(t, st) do { const int key0_ = (t) < 4 ? (t) * 64 : seg2s + ((t) - 4) * 64; const bf16_t* kg_ = Kp + (size_t)key0_ * ldk; const bf16_t* vg_ = Vtp + key0_; \
        _Pragma("unroll") for (int i = 0; i < KCPT; ++i) if (wu + 8 * i < NKI) __builtin_amdgcn_global_load_lds((const unsigned*)(kg_ + koffg[i]), (LAS unsigned*)(smem + (st) * STG + (wu + 8 * i) * 1024), 16, 0, 0); \
        _Pragma("unroll") for (int i = 0; i < VCPT; ++i) __builtin_amdgcn_global_load_lds((const unsigned*)(vg_ + voffg[i]), (LAS unsigned*)(smem + (st) * STG + KB + (wu + 8 * i) * 1024), 16, 0, 0); } while (0)
    FDMA(0, 0);
    asm volatile("s_waitcnt vmcnt(0)" ::: "memory"); __syncthreads();
    const int ksw = (DQK == 64) ? (fr & 7) : ((4 - ((fr >> 2) & 3)) & 3);
    for (int t = 0; t < nt; ++t) {
        if (t + 1 < nt) FDMA(t + 1, (t + 1) & 1);
        const char* kb = smem + (t & 1) * STG; const char* vb = kb + KB;
        const int key0 = t < 4 ? t * 64 : seg2s + (t - 4) * 64;
        f32x4 s[4][2];
#pragma unroll
        for (int mk = 0; mk < 4; ++mk) { s[mk][0] = (f32x4){0.f, 0.f, 0.f, 0.f}; s[mk][1] = (f32x4){0.f, 0.f, 0.f, 0.f}; }
#pragma unroll
        for (int ks = 0; ks < NKS; ++ks) {
            const int co = (DQK == 64) ? (((ks * 4 + fq) ^ ksw) * 16) : ((ks * 4 + (fq ^ ksw)) * 16);
#pragma unroll
            for (int mk = 0; mk < 4; ++mk) {
                const bf16x8 kf = *(const bf16x8*)(kb + (mk * 16 + fr) * KROW + co);
                s[mk][0] = __builtin_amdgcn_mfma_f32_16x16x32_bf16(kf, qf[0][ks], s[mk][0], 0, 0, 0);
                s[mk][1] = __builtin_amdgcn_mfma_f32_16x16x32_bf16(kf, qf[1][ks], s[mk][1], 0, 0, 0);
            }
        }
        __builtin_amdgcn_sched_barrier(0);
        bf16x8 vf0[4];
#pragma unroll
        for (int md = 0; md < 4; ++md) vf0[md] = *(const bf16x8*)(vb + (md * 16 + fr) * VROW + ((fq ^ (fr & 7)) * 16));
        bf16x8 pf[2][2];
#pragma unroll
        for (int nq = 0; nq < 2; ++nq) {
            if (WINDOWED && key0 >= CTXL) {
                const int qpos = q_tok0 - CTXL + wq0 + nq * 16 + fr;
#pragma unroll
                for (int mk = 0; mk < 4; ++mk)
#pragma unroll
                    for (int j = 0; j < 4; ++j) { const int kpos = key0 - CTXL + 32 * (mk >> 1) + 8 * fq + 4 * (mk & 1) + j; const int d = qpos - kpos; if (d > 128 || d < -128) s[mk][nq][j] = -1e30f; }
            }
            float mx = fmaxf(fmaxf(s[0][nq][0], s[0][nq][1]), fmaxf(s[0][nq][2], s[0][nq][3]));
#pragma unroll
            for (int mk = 1; mk < 4; ++mk) mx = fmaxf(fmaxf(mx, fmaxf(s[mk][nq][0], s[mk][nq][1])), fmaxf(s[mk][nq][2], s[mk][nq][3]));
            mx = fmaxf(mx, __shfl_xor(mx, 16)); mx = fmaxf(mx, __shfl_xor(mx, 32));
            const bool need = mx > mref[nq] + thr;
            if (__any(need)) {
                const float mnew = need ? mx : mref[nq];
                const float alpha = fast_exp2((mref[nq] - mnew) * sc2);
                mref[nq] = mnew; lrun[nq] *= alpha;
#pragma unroll
                for (int md = 0; md < NMD; ++md) o[md][nq] = o[md][nq] * alpha;
            }
            const float nm = -mref[nq] * sc2;
            float ls = 0.f;
#pragma unroll
            for (int mk = 0; mk < 4; ++mk)
#pragma unroll
                for (int j = 0; j < 4; ++j) { const float pv = fast_exp2(fmaf(s[mk][nq][j], sc2, nm)); s[mk][nq][j] = pv; ls += pv; }
            lrun[nq] += ls;
#pragma unroll
            for (int kk = 0; kk < 2; ++kk) {
                u32x4 pk; pk.x = cvt_pk_bf16(s[2 * kk][nq][0], s[2 * kk][nq][1]); pk.y = cvt_pk_bf16(s[2 * kk][nq][2], s[2 * kk][nq][3]);
                pk.z = cvt_pk_bf16(s[2 * kk + 1][nq][0], s[2 * kk + 1][nq][1]); pk.w = cvt_pk_bf16(s[2 * kk + 1][nq][2], s[2 * kk + 1][nq][3]);
                pf[nq][kk] = __builtin_bit_cast(bf16x8, pk);
            }
        }
        __builtin_amdgcn_sched_barrier(0);
#pragma unroll
        for (int kk = 0; kk < 2; ++kk) {
            const int co = (((kk * 4 + fq) ^ (fr & 7)) * 16);
#pragma unroll
            for (int md = 0; md < NMD; ++md) {
                const bf16x8 vf = (kk == 0 && md < 4) ? vf0[md & 3] : *(const bf16x8*)(vb + (md * 16 + fr) * VROW + co);
                o[md][0] = __builtin_amdgcn_mfma_f32_16x16x32_bf16(vf, pf[0][kk], o[md][0], 0, 0, 0);
                o[md][1] = __builtin_amdgcn_mfma_f32_16x16x32_bf16(vf, pf[1][kk], o[md][1], 0, 0, 0);
            }
        }
        asm volatile("s_waitcnt vmcnt(0)" ::: "memory");
        __syncthreads();
    }
#undef FDMA
#pragma unroll
    for (int nq = 0; nq < 2; ++nq) { float l = lrun[nq]; l += __shfl_xor(l, 16); l += __shfl_xor(l, 32); lrun[nq] = l; mrun[nq] = mref[nq] * sc2; }
}

template <int NMD>
__device__ __forceinline__ void store_o(bf16_t* Op, int ldo, const f32x4 (&o)[NMD][2], const float (&inv)[2]) {
    const int lane = threadIdx.x & 63, w = threadIdx.x >> 6, fr = lane & 15, fq = lane >> 4, wq0 = w * 32;
#pragma unroll
    for (int nq = 0; nq < 2; ++nq)
#pragma unroll
        for (int md = 0; md < NMD; ++md) {
            u32x2 v; v.x = cvt_pk_bf16(o[md][nq][0] * inv[nq], o[md][nq][1] * inv[nq]); v.y = cvt_pk_bf16(o[md][nq][2] * inv[nq], o[md][nq][3] * inv[nq]);
            *(u32x2*)(Op + (size_t)(wq0 + nq * 16 + fr) * ldo + md * 16 + fq * 4) = v;
        }
}

__device__ __forceinline__ void phase_attn0(const Params& p, char* smem) {
    const bf16_t* proj0 = p.big + BE_PROJ0; const bf16_t* vt_swa = p.big + BE_VT_SWA; const bf16_t* q_mla = p.big + BE_Q_MLA;
    const bf16_t* k_mla = p.big + BE_K_MLA; const bf16_t* vt_mla = p.big + BE_VT_MLA;
    for (int it = blockIdx.x; it < 1152; it += gridDim.x) {
        int kind, b, hh, qbl; bool lat;
        if (it < 1024) { lat = true; kind = it >> 9; const int r = it & 511; b = r >> 6; hh = (r >> 3) & 7; qbl = r & 7; }
        else { lat = false; const int r = it - 1024; kind = r >> 6; b = (r >> 3) & 7; hh = r & 7; qbl = 0; }
        const int qtok0 = lat ? CTXL + 256 * qbl : 0, row0 = b * TOK + qtok0;
        f32x4 o[4][2]; float m[2], l[2], inv[2];
        if (kind == 0) {
            flash_pass<96, 64, false>(smem, q_mla + (size_t)row0 * 768 + hh * 96, 768, k_mla + (size_t)b * TOK * 768 + hh * 96, 768,
                               vt_mla + (size_t)((b * 8 + hh) * 64) * TOK, CTXL, lat ? TOK : CTXL, qtok0, 0.10206207262f * LOG2E, o, m, l);
            inv[0] = 1.f / l[0]; inv[1] = 1.f / l[1];
            store_o<4>(p.o + (size_t)row0 * 1024 + hh * 64, 1024, o, inv);
        } else {
            int s2s = CTXL, s2e = CTXL;
            if (lat) { const int lo = 256 * qbl - 128, hi = 256 * qbl + 384; s2s = CTXL + (lo > 0 ? lo : 0); s2e = CTXL + (hi < SEQ ? hi : SEQ); }
            flash_pass<64, 64, true>(smem, proj0 + (size_t)row0 * 1024 + 256 + hh * 64, 1024, proj0 + (size_t)b * TOK * 1024 + 896 + (hh >> 2) * 64, 1024,
                               vt_swa + (size_t)((b * 2 + (hh >> 2)) * 64) * TOK, s2s, s2e, qtok0, 0.125f * LOG2E, o, m, l);
            const float sk = p.sink[hh] * LOG2E;
            inv[0] = 1.f / (l[0] + fast_exp2(sk - m[0])); inv[1] = 1.f / (l[1] + fast_exp2(sk - m[1]));
            store_o<4>(p.o + (size_t)row0 * 1024 + 512 + hh * 64, 1024, o, inv);
        }
    }
}

__device__ __forceinline__ void epi_plain(const float* Ct, bf16_t* out, int ldo, int mt, int nt) {
    const int tid = threadIdx.x;
#pragma unroll 1
    for (int i = 0; i < 4; ++i) {
        const int id = tid + NTHREADS * i, r = id >> 4, c0 = (id & 15) * 8;
        float v[8]; load8(Ct + r * LDC + c0, v);
        store8(out + (size_t)(mt * 128 + r) * ldo + nt * 128 + c0, v);
    }
}
__device__ __forceinline__ void phase_gemm_plain(char* smem, const bf16_t* zero16, const bf16_t* A, int lda, const bf16_t* Wt, int K, int ntn2, bf16_t* out, int ldo, bool lat_only) {
    float* Ct = (float*)smem;
    const int nmt2 = lat_only ? 64 : 72;
    TAIL_DECODE(nmt2 * ntn2);
    for (int it = blockIdx.x; it < total_; it += G_) {
        TAIL_ITEM(it, tile, half)
        int mt2 = tile / ntn2; const int nt2 = tile % ntn2;
        if (lat_only) mt2 = (mt2 >> 3) * 9 + 1 + (mt2 & 7);
        if (half < 0) {
            f32x4 acc[8][4];
            gemm_core(smem, A, lda, mt2 * 256, 0, ROWS, mt2 * 256 + 128, 0, ROWS, Wt + (size_t)nt2 * 256 * K, K, K, zero16, acc);
#pragma unroll 1
            for (int ai = 0; ai < 2; ++ai) {
                acc_to_ct(Ct, acc, ai);
                epi_plain(Ct, out, ldo, mt2 * 2 + ai, nt2 * 2);
                epi_plain(Ct + CT_FLOATS, out, ldo, mt2 * 2 + ai, nt2 * 2 + 1);
            }
        } else {
            const int nt = nt2 * 2 + half;
            f32x4 acc[4][4];
            gemm_core_h(smem, A, lda, mt2 * 256, 0, ROWS, mt2 * 256 + 128, 0, ROWS, Wt + (size_t)nt * 128 * K, K, K, zero16, acc);
#pragma unroll 1
            for (int ai = 0; ai < 2; ++ai) { acc_to_ct_h(Ct, acc, ai); epi_plain(Ct, out, ldo, mt2 * 2 + ai, nt); }
        }
    }
}

__device__ __forceinline__ void phase_ln(const Params& p, const float* res_lat, const float* res_ctx, int layer, int gate_idx, const float* lng, const float* lnb,
                                         float* out_lat, float* out_ctx, bool write_h, int hl, int sh_idx, int sc_idx, bool inc_ctx) {
    const int lane = threadIdx.x & 63, w = threadIdx.x >> 6;
    for (int row = blockIdx.x * NWAVES + w; row < ROWS; row += gridDim.x * NWAVES) {
        const int b = row / TOK, j = row % TOK; const bool isc = j < CTXL;
        if (isc && !inc_ctx) continue;
        const size_t ro = isc ? ((size_t)b * CTXL + j) * DM : ((size_t)b * SEQ + (j - CTXL)) * DM;
        const float* rp = (isc ? res_ctx : res_lat) + ro; float* op = (isc ? out_ctx : out_lat) + ro;
        const int bm = isc ? 8 : b;
        const float* gate = p.mod + (size_t)(layer * 9 + bm) * 6144 + gate_idx * 1024;
        bf16_t* fp = p.h + (size_t)row * DM;
        f32x4 y[4]; float sum = 0.f;
#pragma unroll
        for (int i = 0; i < 4; ++i) {
            const int col = i * 256 + lane * 4;
            const f32x4 r = *(const f32x4*)(rp + col), gt = *(const f32x4*)(gate + col); const u32x2 f = *(const u32x2*)(fp + col);
            y[i][0] = ALPHA_RES * r[0] + gt[0] * bflo(f.x); y[i][1] = ALPHA_RES * r[1] + gt[1] * bfhi(f.x);
            y[i][2] = ALPHA_RES * r[2] + gt[2] * bflo(f.y); y[i][3] = ALPHA_RES * r[3] + gt[3] * bfhi(f.y);
            sum += (y[i][0] + y[i][1]) + (y[i][2] + y[i][3]);
        }
        const float mean = wave_sum(sum) * (1.f / DM); float sq = 0.f;
#pragma unroll
        for (int i = 0; i < 4; ++i) { y[i] = y[i] - mean; sq += (y[i][0] * y[i][0] + y[i][1] * y[i][1]) + (y[i][2] * y[i][2] + y[i][3] * y[i][3]); }
        const float rstd = rsqrtf(wave_sum(sq) * (1.f / DM) + 1e-5f);
        const float* mh = p.mod + (size_t)(hl * 9 + bm) * 6144;
#pragma unroll
        for (int i = 0; i < 4; ++i) {
            const int col = i * 256 + lane * 4;
            const f32x4 g = *(const f32x4*)(lng + col), bb = *(const f32x4*)(lnb + col);
            const f32x4 xl = y[i] * rstd * g + bb;
            *(f32x4*)(op + col) = xl;
            if (write_h) {
                const f32x4 sh = *(const f32x4*)(mh + sh_idx * 1024 + col), sc = *(const f32x4*)(mh + sc_idx * 1024 + col);
                u32x2 hv; hv.x = cvt_pk_bf16(xl[0] * (1.f + sc[0]) + sh[0], xl[1] * (1.f + sc[1]) + sh[1]); hv.y = cvt_pk_bf16(xl[2] * (1.f + sc[2]) + sh[2], xl[3] * (1.f + sc[3]) + sh[3]);
                *(u32x2*)(fp + col) = hv;
            }
        }
    }
}

struct SubTile { int alo, ahi, ar0, jm, seg_len; bool valid; };
__device__ __forceinline__ SubTile ffn_subtile(int layer, int b, int sidx) {
    SubTile t; const int cnt = layer == 0 ? 20 : 17; t.valid = sidx < cnt;
    int jm = sidx, seg_off = CTXL, seg_len = SEQ;
    if (layer == 0) { if (sidx < 3) { seg_off = 0; seg_len = CTXL; } else jm = sidx - 3; }
    t.jm = jm; t.seg_len = seg_len; t.alo = b * TOK + seg_off; t.ahi = t.valid ? t.alo + seg_len : t.alo; t.ar0 = t.alo + 126 * jm - 1;
    return t;
}
__device__ __forceinline__ SubTile sel_subtile(const SubTile& a, const SubTile& b, int ai) {
    SubTile t; t.alo = ai ? b.alo : a.alo; t.ahi = ai ? b.ahi : a.ahi; t.ar0 = ai ? b.ar0 : a.ar0; t.jm = ai ? b.jm : a.jm; t.seg_len = ai ? b.seg_len : a.seg_len; t.valid = ai ? b.valid : a.valid; return t;
}
__device__ __forceinline__ void epi_ffn1(const Params& p, const float* Ct, int layer, const SubTile& t, int hc0) {
    if (!t.valid) return;
    const int tid = threadIdx.x; bf16_t* hid = p.big + BE_HID;
    const float* cw = p.conv_w + (size_t)layer * 3 * DFF; const float* cb = p.conv_b + (size_t)layer * DFF;
    const int c0 = (tid & 7) * 8, hc = hc0 + c0;
    float w0[8], w1[8], w2[8], bs[8];
    load8(cw + hc, w0); load8(cw + DFF + hc, w1); load8(cw + 2 * DFF + hc, w2); load8(cb + hc, bs);
#pragma unroll
    for (int i = 0; i < 2; ++i) {
        const int r = (tid + NTHREADS * i) >> 3;
        const int srow = 126 * t.jm - 1 + r;
        if (r < 1 || r > 126 || srow >= t.seg_len) continue;
        float gm[8], g0[8], gp[8], u[8], hv[8];
        load8(Ct + (r - 1) * LDC + c0, gm); load8(Ct + r * LDC + c0, g0); load8(Ct + (r + 1) * LDC + c0, gp); load8(Ct + r * LDC + 64 + c0, u);
#pragma unroll
        for (int e = 0; e < 8; ++e) { const float cv = gm[e] * w0[e] + g0[e] * w1[e] + gp[e] * w2[e] + bs[e]; hv[e] = cv * __builtin_amdgcn_rcpf(1.f + fast_exp2(-LOG2E * cv)) * u[e]; }
        store8(hid + (size_t)(t.alo + srow) * DFF + hc, hv);
    }
}
__device__ __forceinline__ void phase_ffn1(const Params& p, char* smem, int layer) {
    float* Ct = (float*)smem;
    const bf16_t* wgu = p.wt_gate + (size_t)layer * 5632 * 1024;
    const int cnt = layer == 0 ? 20 : 17, npairs = 4 * cnt;
    NOTAIL_DECODE(npairs * 22);
    for (int it0 = blockIdx.x; it0 < total_; it0 += G_) {
        TAIL_ITEM(it0, it, half)
        int mt2, nt2; const int nfirst = npairs * 16;
        if (it < nfirst) { mt2 = it >> 4; nt2 = it & 15; } else { const int r = it - nfirst; mt2 = r / 6; nt2 = 16 + r % 6; }
        const int g0 = 2 * mt2, g1 = g0 + 1;
        const SubTile t0 = ffn_subtile(layer, g0 / cnt, g0 % cnt), t1 = ffn_subtile(layer, g1 / cnt, g1 % cnt);
        if (half < 0) {
            f32x4 acc[8][4];
            gemm_core(smem, p.h, DM, t0.ar0, t0.alo, t0.ahi, t1.ar0, t1.alo, t1.ahi, wgu + (size_t)nt2 * 256 * DM, DM, DM, (const bf16_t*)p.bar, acc);
#pragma unroll 1
            for (int ai = 0; ai < 2; ++ai) {
                acc_to_ct(Ct, acc, ai);
                const SubTile t = sel_subtile(t0, t1, ai);
                epi_ffn1(p, Ct, layer, t, (nt2 * 2) * 64);
                epi_ffn1(p, Ct + CT_FLOATS, layer, t, (nt2 * 2 + 1) * 64);
            }
        } else {
            const int nt = nt2 * 2 + half;
            f32x4 acc[4][4];
            gemm_core_h(smem, p.h, DM, t0.ar0, t0.alo, t0.ahi, t1.ar0, t1.alo, t1.ahi, wgu + (size_t)nt * 128 * DM, DM, DM, (const bf16_t*)p.bar, acc);
#pragma unroll 1
            for (int ai = 0; ai < 2; ++ai) { acc_to_ct_h(Ct, acc, ai); epi_ffn1(p, Ct, layer, sel_subtile(t0, t1, ai), nt * 64); }
        }
    }
}

__device__ __forceinline__ void epi_proj1(const Params& p, const float* Ct, int mt, int nt) {
    const int tid = threadIdx.x;
    bf16_t* qd = p.big + BE_QD; bf16_t* kd = p.big + BE_KD; bf16_t* vt_d = p.big + BE_VT_D;
    extern __shared__ __attribute__((aligned(16))) char smem_dyn_[]; const float* lds_tab_ = (const float*)(smem_dyn_ + SMEM_BYTES);
    const float* rope64 = lds_tab_ + MISC_ROPE64;
    const int b = mt / 18, jt = mt % 18; const bool is_ctx = jt < 2; const int row0 = mt * 128, tok0 = jt * 128;
    if (nt >= 16) {
        const int hh = nt - 16;
#pragma unroll 1
        for (int i = 0; i < 4; ++i) { const int id = tid + NTHREADS * i, c = id & 127, rc = id >> 7;
            store_col8(Ct, c, rc, vt_d + (size_t)((b * 8 + hh) * 128 + c) * TOK + tok0 + rc * 8, nullptr); }
    } else {
        bf16_t* dst = nt < 8 ? qd : kd; const int dc = (nt & 7) * 128;
#pragma unroll 1
        for (int i = 0; i < 4; ++i) {
            const int id = tid + NTHREADS * i, r = id >> 4, c0 = (id & 15) * 8;
            const float* rowp = Ct + r * LDC; float v[8]; load8(rowp + c0, v);
            if (!is_ctx) rope8(rowp, c0, 64, tok0 + r - CTXL, rope64, v);
            store8(dst + (size_t)(row0 + r) * 1024 + dc + c0, v);
        }
    }
}
__device__ __forceinline__ void phase_proj1(const Params& p, char* smem) {
    float* Ct = (float*)smem;
    TAIL_DECODE(72 * 12);
    for (int it0 = blockIdx.x; it0 < total_; it0 += G_) {
        TAIL_ITEM(it0, it, half)
        int mt2, nt2;
        if (it < 72 * 8) { mt2 = it >> 3; nt2 = it & 7; } else { const int r = it - 72 * 8; mt2 = r >> 2; nt2 = 8 + (r & 3); }
        if ((mt2 % 9) == 0 && nt2 < 4) continue;
        if (half < 0) {
            f32x4 acc[8][4];
            gemm_core(smem, p.h, DM, mt2 * 256, 0, ROWS, mt2 * 256 + 128, 0, ROWS, p.wt_din + (size_t)nt2 * 256 * DM, DM, DM, (const bf16_t*)p.bar, acc);
#pragma unroll 1
            for (int ai = 0; ai < 2; ++ai) {
                acc_to_ct(Ct, acc, ai);
                epi_proj1(p, Ct, mt2 * 2 + ai, nt2 * 2);
                epi_proj1(p, Ct + CT_FLOATS, mt2 * 2 + ai, nt2 * 2 + 1);
            }
        } else {
            const int nt = nt2 * 2 + half;
            f32x4 acc[4][4];
            gemm_core_h(smem, p.h, DM, mt2 * 256, 0, ROWS, mt2 * 256 + 128, 0, ROWS, p.wt_din + (size_t)nt * 128 * DM, DM, DM, (const bf16_t*)p.bar, acc);
#pragma unroll 1
            for (int ai = 0; ai < 2; ++ai) { acc_to_ct_h(Ct, acc, ai); epi_proj1(p, Ct, mt2 * 2 + ai, nt); }
        }
    }
}

__device__ __forceinline__ void phase_attn1(const Params& p, char* smem) {
    const bf16_t* qd = p.big + BE_QD; const bf16_t* kd = p.big + BE_KD; const bf16_t* vt_d = p.big + BE_VT_D;
    const int lane = threadIdx.x & 63, w = threadIdx.x >> 6, fr = lane & 15, fq = lane >> 4, wq0 = w * 32;
    const float lam = p.misc[MISC_LAM];
    for (int it = blockIdx.x; it < 512; it += gridDim.x) {
        const int b = it >> 6, hh = (it >> 3) & 7, qbl = it & 7; const int qtok0 = CTXL + 256 * qbl, row0 = b * TOK + qtok0;
        const bf16_t* vt = vt_d + (size_t)((b * 8 + hh) * 128) * TOK;
        f32x4 o[8][2]; float m[2], l[2];
        flash_pass<64, 128, false>(smem, qd + (size_t)row0 * 1024 + hh * 128, 1024, kd + (size_t)b * TOK * 1024 + hh * 128, 1024, vt, CTXL, TOK, qtok0, 0.125f * LOG2E, o, m, l);
        {
            float inv[2]; inv[0] = 1.f / l[0]; inv[1] = 1.f / l[1];
            store_o<8>(p.o + (size_t)row0 * 1024 + hh * 128, 1024, o, inv);
        }
        flash_pass<64, 128, false>(smem, qd + (size_t)row0 * 1024 + hh * 128 + 64, 1024, kd + (size_t)b * TOK * 1024 + hh * 128 + 64, 1024, vt, CTXL, TOK, qtok0, 0.125f * LOG2E, o, m, l);
#pragma unroll
        for (int nq = 0; nq < 2; ++nq) {
            const float inv = lam / l[nq]; float ss = 0.f;
            const bf16_t* o1p = p.o + (size_t)(row0 + wq0 + nq * 16 + fr) * 1024 + hh * 128;
#pragma unroll
            for (int md = 0; md < 8; ++md) {
                const u32x2 o1 = *(const u32x2*)(o1p + md * 16 + fq * 4);
                o[md][nq][0] = bflo(o1.x) - o[md][nq][0] * inv; o[md][nq][1] = bfhi(o1.x) - o[md][nq][1] * inv;
                o[md][nq][2] = bflo(o1.y) - o[md][nq][2] * inv; o[md][nq][3] = bfhi(o1.y) - o[md][nq][3] * inv;
                ss += (o[md][nq][0] * o[md][nq][0] + o[md][nq][1] * o[md][nq][1]) + (o[md][nq][2] * o[md][nq][2] + o[md][nq][3] * o[md][nq][3]);
            }
            ss += __shfl_xor(ss, 16); ss += __shfl_xor(ss, 32);
            const float rstd = rsqrtf(ss * (1.f / 128.f) + 1e-6f) * (1.f - LAMBDA_INIT);
            bf16_t* op = p.o + (size_t)(row0 + wq0 + nq * 16 + fr) * 1024 + hh * 128;
#pragma unroll
            for (int md = 0; md < 8; ++md) {
                const f32x4 g = *(const f32x4*)(p.subln + md * 16 + fq * 4);
                u32x2 v; v.x = cvt_pk_bf16(o[md][nq][0] * rstd * g[0], o[md][nq][1] * rstd * g[1]); v.y = cvt_pk_bf16(o[md][nq][2] * rstd * g[2], o[md][nq][3] * rstd * g[3]);
                *(u32x2*)(op + md * 16 + fq * 4) = v;
            }
        }
    }
}

constexpr int N_PHASES = 17;
#ifndef ONLY_PHASE
#define ONLY_PHASE -1
#endif
#define PH_ON(k) (ONLY_PHASE < 0 || ONLY_PHASE == (k))
#ifndef DUP_MASK
#define DUP_MASK 0
#endif
#define RUN_PHASE(k, call) if constexpr (PH_ON(k)) { if (ph_lo <= (k) && (k) < ph_hi) { call; if ((k) + 1 < ph_hi) xcd_barrier(xb); } }
__global__ void __launch_bounds__(NTHREADS, 2) mega_fwd(Params p, int ph_lo, int ph_hi) {
    extern __shared__ __attribute__((aligned(16))) char smem[];
    __shared__ uint4 xb_words;
    if (threadIdx.x == 0) xb_words = make_uint4(0u, 0u, 0u, 0u);
    __syncthreads();
    const XcdBarrier xb = xcd_barrier_post(p.bar, (volatile LAS unsigned*)&xb_words);
    if (ph_lo < 0) cg::this_grid().sync();
    RUN_PHASE(0, phase_prologue(p, smem))
    { float* lt = (float*)(smem + SMEM_BYTES); for (int i = threadIdx.x; i < 3072; i += NTHREADS) lt[i] = p.misc[i]; __syncthreads(); }
    RUN_PHASE(1, phase_h0(p))
    RUN_PHASE(2, phase_proj0(p, smem))
    RUN_PHASE(3, phase_mla_up(p, smem))
    RUN_PHASE(4, phase_attn0(p, smem))
    RUN_PHASE(5, phase_gemm_plain(smem, (const bf16_t*)p.bar, p.o, 1024, p.wt_out0, 1024, 4, p.h, 1024, false))
    RUN_PHASE(6, phase_ln(p, p.x, p.ctx, 0, 2, p.ln1_g, p.ln1_b, p.out, p.xc, true, 0, 3, 4, true))
    RUN_PHASE(7, phase_ffn1(p, smem, 0))
    RUN_PHASE(8, phase_gemm_plain(smem, (const bf16_t*)p.bar, p.big + BE_HID, DFF, p.wt_down, DFF, 4, p.h, 1024, false))
    RUN_PHASE(9, phase_ln(p, p.out, p.xc, 0, 5, p.ln2_g, p.ln2_b, p.out, p.xc, true, 1, 0, 1, true))
    RUN_PHASE(10, phase_proj1(p, smem))
    RUN_PHASE(11, phase_attn1(p, smem))
    RUN_PHASE(12, phase_gemm_plain(smem, (const bf16_t*)p.bar, p.o, 1024, p.wt_dout, 1024, 4, p.h, 1024, true))
    RUN_PHASE(13, phase_ln(p, p.out, p.xc, 1, 2, p.ln1_g + DM, p.ln1_b + DM, p.out, p.xc, true, 1, 3, 4, false))
    RUN_PHASE(14, phase_ffn1(p, smem, 1))
    RUN_PHASE(15, phase_gemm_plain(smem, (const bf16_t*)p.bar, p.big + BE_HID, DFF, p.wt_down + (size_t)1024 * 2816, DFF, 4, p.h, 1024, true))
    RUN_PHASE(16, phase_ln(p, p.out, p.xc, 1, 5, p.ln2_g + DM, p.ln2_b + DM, p.out, p.xc, false, 1, 0, 1, false))
}

extern "C" void kernel_launch(void* const* d_in, const int* in_sizes, int n_in, void* d_out, int out_size, void* d_ws, size_t ws_size, hipStream_t stream) {
    static int grid = 0;
    if (grid == 0) {
        if (n_in != 29 || out_size != NBATCH * SEQ * DM || ws_size < WS_END) {
            fprintf(stderr, "kernel_launch: unexpected shapes (n_in %d, out %d, ws %zu, need %zu)\n", n_in, out_size, ws_size, (size_t)WS_END); grid = -1; return; }
        int dev = 0, cus = 0, per_cu = 0;
        hipGetDevice(&dev); hipDeviceGetAttribute(&cus, hipDeviceAttributeMultiprocessorCount, dev);
        if (hipFuncSetAttribute((const void*)mega_fwd, hipFuncAttributeMaxDynamicSharedMemorySize, SMEM_BYTES + SMEM_TABLES) != hipSuccess) { fprintf(stderr, "kernel_launch: hipFuncSetAttribute failed\n"); grid = -1; return; }
        if (hipOccupancyMaxActiveBlocksPerMultiprocessor(&per_cu, (const void*)mega_fwd, NTHREADS, SMEM_BYTES + SMEM_TABLES) != hipSuccess || per_cu < 1) { fprintf(stderr, "kernel_launch: occupancy query failed\n"); grid = -1; return; }
        if (per_cu > 1) per_cu = 1;
        grid = cus * per_cu;
        fprintf(stderr, "kernel_launch: grid %d (%d CUs x %d)\n", grid, cus, per_cu);
    }
    if (grid < 0) return;
    Params p{};
    const float* const* in = (const float* const*)d_in;
    p.x = in[0]; p.c = in[1]; p.ctx = in[2]; p.c_ctx = in[3]; p.w_mod = in[4]; p.b_mod = in[5]; p.ln1_g = in[6]; p.ln1_b = in[7]; p.ln2_g = in[8]; p.ln2_b = in[9];
    p.w_gate = in[10]; p.w_up = in[11]; p.conv_w = in[12]; p.conv_b = in[13]; p.w_down = in[14];
    p.ab_w_in = in[15]; p.q_norm = in[16]; p.w_qb = in[17]; p.kv_norm = in[18]; p.w_kvb = in[19]; p.sink = in[20]; p.ab_w_out = in[21];
    p.d_w_in = in[22]; p.lq1 = in[23]; p.lk1 = in[24]; p.lq2 = in[25]; p.lk2 = in[26]; p.subln = in[27]; p.d_w_out = in[28];
    p.out = (float*)d_out;
    char* ws = (char*)d_ws;
    p.wt_in0 = (bf16_t*)(ws + OFF_WT_IN0); p.wt_qb = (bf16_t*)(ws + OFF_WT_QB); p.wt_kvb = (bf16_t*)(ws + OFF_WT_KVB); p.wt_out0 = (bf16_t*)(ws + OFF_WT_OUT0);
    p.wt_din = (bf16_t*)(ws + OFF_WT_DIN); p.wt_dout = (bf16_t*)(ws + OFF_WT_DOUT); p.wt_gate = (bf16_t*)(ws + OFF_WT_GATE); p.wt_up = (bf16_t*)(ws + OFF_WT_UP);
    p.wt_down = (bf16_t*)(ws + OFF_WT_DOWN); p.mod = (float*)(ws + OFF_MOD); p.misc = (float*)(ws + OFF_MISC); p.bar = (unsigned*)(ws + OFF_BAR); p.xc = (float*)(ws + OFF_XC);
    p.h = (bf16_t*)(ws + OFF_H); p.o = (bf16_t*)(ws + OFF_O); p.big = (bf16_t*)(ws + OFF_BIG);
    if (hipMemsetAsync(ws + OFF_BAR, 0, 16384, stream) != hipSuccess) { fprintf(stderr, "kernel_launch: memset failed\n"); return; }
#if MULTI_LAUNCH
    for (int ph = 0; ph < N_PHASES; ++ph) hipLaunchKernelGGL(mega_fwd, dim3(grid), dim3(NTHREADS), SMEM_BYTES + SMEM_TABLES, stream, p, ph, ph + 1);
#else
    int lo = 0, hi = N_PHASES;
    void* args[] = {&p, &lo, &hi};
    hipError_t e = hipLaunchCooperativeKernel((const void*)mega_fwd, dim3(grid), dim3(NTHREADS), args, SMEM_BYTES + SMEM_TABLES, stream);
    if (e != hipSuccess) fprintf(stderr, "kernel_launch: cooperative launch failed: %s (grid %d)\n", hipGetErrorString(e), grid);
#if EXTRA_PHASE >= 0
    int lo2 = EXTRA_PHASE, hi2 = EXTRA_PHASE + 1;
    void* args2[] = {&p, &lo2, &hi2};
    (void)hipLaunchCooperativeKernel((const void*)mega_fwd, dim3(grid), dim3(NTHREADS), args2, SMEM_BYTES + SMEM_TABLES, stream);
#endif
#endif
}
```

```cpp
#include <hip/hip_runtime.h>
#include <hip/hip_cooperative_groups.h>
#include <cstdio>
#include <cstdint>
namespace cg = cooperative_groups;

#ifndef EXTRA_PHASE
#define EXTRA_PHASE -1
#endif
#ifndef EXTRA_SYNCS
#define EXTRA_SYNCS 0
#endif
#ifndef MULTI_LAUNCH
#define MULTI_LAUNCH 0
#endif

typedef unsigned short bf16_t;
typedef short bf16x8 __attribute__((ext_vector_type(8)));
typedef float f32x4 __attribute__((ext_vector_type(4)));
typedef unsigned u32x4 __attribute__((ext_vector_type(4)));
typedef unsigned u32x2 __attribute__((ext_vector_type(2)));

constexpr int NBATCH = 8, SEQ = 2048, CTXL = 256, TOK = 2304, ROWS = NBATCH * TOK, DM = 1024, DFF = 2816;
constexpr int NTHREADS = 512, NWAVES = 8;
constexpr int LDC = 132;
constexpr int CT_FLOATS = 128 * 132;
constexpr int SMEM_TABLES = 12288;
constexpr int SMEM_BYTES = 139264;
constexpr float ALPHA_RES = 1.41421356237f;
constexpr float LOG2E = 1.44269504089f;
constexpr float LAMBDA_INIT = 0.35550907f;

struct Params {
    const float *x, *c, *ctx, *c_ctx, *w_mod, *b_mod, *ln1_g, *ln1_b, *ln2_g, *ln2_b;
    const float *w_gate, *w_up, *conv_w, *conv_b, *w_down;
    const float *ab_w_in, *q_norm, *w_qb, *kv_norm, *w_kvb, *sink, *ab_w_out;
    const float *d_w_in, *lq1, *lk1, *lq2, *lk2, *subln, *d_w_out;
    float* out;
    bf16_t *wt_in0, *wt_qb, *wt_kvb, *wt_out0, *wt_din, *wt_dout, *wt_gate, *wt_up, *wt_down;
    float *mod, *misc, *xc;
    unsigned* bar;
    bf16_t *h, *o, *big;
};

constexpr size_t SZ_WT_IN0 = 1280ull * 1024 * 2, SZ_WT_QB = 768ull * 256 * 2, SZ_WT_KVB = 1024ull * 128 * 2, SZ_WT_SQ = 1024ull * 1024 * 2,
                 SZ_WT_DIN = 3072ull * 1024 * 2, SZ_WT_FF = 2ull * 2816 * 1024 * 2;
constexpr size_t OFF_WT_IN0 = 0, OFF_WT_QB = OFF_WT_IN0 + SZ_WT_IN0, OFF_WT_KVB = OFF_WT_QB + SZ_WT_QB, OFF_WT_OUT0 = OFF_WT_KVB + SZ_WT_KVB,
                 OFF_WT_DIN = OFF_WT_OUT0 + SZ_WT_SQ, OFF_WT_DOUT = OFF_WT_DIN + SZ_WT_DIN, OFF_WT_GATE = OFF_WT_DOUT + SZ_WT_SQ,
                 OFF_WT_UP = OFF_WT_GATE + SZ_WT_FF, OFF_WT_DOWN = OFF_WT_UP + SZ_WT_FF, OFF_MOD = OFF_WT_DOWN + SZ_WT_FF,
                 OFF_MISC = OFF_MOD + 2ull * 9 * 6144 * 4, OFF_BAR = OFF_MISC + 65536, OFF_XC = OFF_BAR + 16384, OFF_H = OFF_XC + 2048ull * 1024 * 4,
                 OFF_O = OFF_H + (size_t)ROWS * 1024 * 2, OFF_BIG = OFF_O + (size_t)ROWS * 1024 * 2;
constexpr size_t BE_PROJ0 = 0, BE_VT_SWA = BE_PROJ0 + (size_t)ROWS * 1024, BE_Q_MLA = BE_VT_SWA + 8ull * 2 * 64 * TOK,
                 BE_K_MLA = BE_Q_MLA + (size_t)ROWS * 768, BE_VT_MLA = BE_K_MLA + (size_t)ROWS * 768, BE_END0 = BE_VT_MLA + 8ull * 8 * 64 * TOK;
constexpr size_t BE_QD = 0, BE_KD = BE_QD + (size_t)ROWS * 1024, BE_VT_D = BE_KD + (size_t)ROWS * 1024, BE_END1 = BE_VT_D + 8ull * 8 * 128 * TOK;
constexpr size_t BE_HID = 0, BE_END2 = (size_t)ROWS * DFF;
constexpr size_t BIG_ELEMS = BE_END0 > BE_END1 ? (BE_END0 > BE_END2 ? BE_END0 : BE_END2) : (BE_END1 > BE_END2 ? BE_END1 : BE_END2);
constexpr size_t WS_END = OFF_BIG + BIG_ELEMS * 2;
constexpr int MISC_ROPE64 = 0, MISC_ROPE32 = 2048, MISC_LAM = 3072;

__device__ __forceinline__ unsigned cvt_pk_bf16(float lo, float hi) { unsigned r; asm("v_cvt_pk_bf16_f32 %0, %1, %2" : "=v"(r) : "v"(lo), "v"(hi)); return r; }
__device__ __forceinline__ float bf2f(unsigned short v) { return __uint_as_float((unsigned)v << 16); }
__device__ __forceinline__ float bflo(unsigned v) { return __uint_as_float(v << 16); }
__device__ __forceinline__ float bfhi(unsigned v) { return __uint_as_float(v & 0xffff0000u); }
__device__ __forceinline__ void store8(bf16_t* dst, const float (&v)[8]) {
    u32x4 w; w.x = cvt_pk_bf16(v[0], v[1]); w.y = cvt_pk_bf16(v[2], v[3]); w.z = cvt_pk_bf16(v[4], v[5]); w.w = cvt_pk_bf16(v[6], v[7]);
    *(u32x4*)dst = w;
}
__device__ __forceinline__ float wave_sum(float v) {
#pragma unroll
    for (int o = 1; o < 64; o <<= 1) v += __shfl_xor(v, o);
    return v;
}
__device__ __forceinline__ float fast_exp2(float x) { return __builtin_amdgcn_exp2f(x); }


#define XB_TMO      128
#define XB_XCNT(j)  (256  + 64 * (j))
#define XB_XSUB(j)  (1280 + 64 * (j))
#define XB_XGEN(j)  (2304 + 64 * (j))
#define XB_TOP      3328
#define XB_TOPGEN   3392
#define XCD_BAR_WORDS 3456
#define XB_SPIN_CAP (1u << 18)
#define LAS __attribute__((address_space(3)))
__device__ __forceinline__ unsigned xb_ld(unsigned* p)              { return __hip_atomic_load(p, __ATOMIC_RELAXED, __HIP_MEMORY_SCOPE_AGENT); }
__device__ __forceinline__ unsigned xb_add(unsigned* p, unsigned v) { return __hip_atomic_fetch_add(p, v, __ATOMIC_RELAXED, __HIP_MEMORY_SCOPE_AGENT); }
__device__ __forceinline__ unsigned xb_xcc_id() { return (unsigned)__builtin_amdgcn_s_getreg((3 << 11) | 20) & 0xFu; }
#define XB_SPIN(cond, bar) do { unsigned _sp = 0; while (cond) { __builtin_amdgcn_s_sleep(1); \
    if ((++_sp & 255u) == 0u) { if (xb_ld(&(bar)[XB_TMO])) break; if (_sp > XB_SPIN_CAP) { atomicAdd(&(bar)[XB_TMO], 1u); break; } } } } while (0)
struct XcdBarrier { unsigned* bar; unsigned x; volatile LAS unsigned* st; };
__device__ __forceinline__ XcdBarrier xcd_barrier_post(unsigned* bar, volatile LAS unsigned* st) {
    XcdBarrier b; b.bar = bar; b.x = xb_xcc_id(); b.st = st;
    if (threadIdx.x == 0) (void)xb_add(&bar[XB_XCNT(b.x)], 1u);
    return b;
}
__device__ __forceinline__ void xcd_barrier_complete(unsigned* bar, unsigned x, unsigned& nloc, unsigned& nx) {
    const unsigned G = gridDim.x * gridDim.y * gridDim.z;
    unsigned sum, cnt, mine, sp = 0u;
    for (;;) {
        sum = 0u; cnt = 0u; mine = 0u;
#pragma unroll
        for (unsigned j = 0; j < 16; ++j) { const unsigned c = xb_ld(&bar[XB_XCNT(j)]); sum += c; cnt += (c > 0u) ? 1u : 0u; mine = (j == x) ? c : mine; }
        if (sum == G) break;
        __builtin_amdgcn_s_sleep(1);
        if ((++sp & 255u) == 0u) { if (xb_ld(&bar[XB_TMO])) break; if (sp > XB_SPIN_CAP) { atomicAdd(&bar[XB_TMO], 1u); break; } }
    }
    nloc = mine > 0u ? mine : 1u; nx = cnt > 0u ? cnt : 1u;
}
__device__ __forceinline__ void xcd_barrier(const XcdBarrier& b) {
    asm volatile("s_waitcnt vmcnt(0)" ::: "memory");
    __syncthreads();
    if (threadIdx.x == 0) {
        unsigned* bar = b.bar;
        __builtin_amdgcn_s_waitcnt(0);
        unsigned nloc = b.st[0], nx = b.st[1];
        if (nloc == 0u) { xcd_barrier_complete(bar, b.x, nloc, nx); b.st[0] = nloc; b.st[1] = nx; }
        const unsigned old = xb_add(&bar[XB_XSUB(b.x)], 1u);
        const unsigned gen = old / nloc;
        if (old + 1u == (gen + 1u) * nloc) {
            __builtin_amdgcn_fence(__ATOMIC_RELEASE, "agent");
            asm volatile("s_waitcnt vmcnt(0)" ::: "memory");
            const unsigned og = xb_add(&bar[XB_TOP], 1u);
            const unsigned tg = og / nx;
            if (og + 1u == (tg + 1u) * nx) xb_add(&bar[XB_TOPGEN], 1u);
            else XB_SPIN(xb_ld(&bar[XB_TOPGEN]) == tg, bar);
            __builtin_amdgcn_fence(__ATOMIC_ACQUIRE, "agent");
            xb_add(&bar[XB_XGEN(b.x)], 1u);
            asm volatile("s_waitcnt vmcnt(0)" ::: "memory");
        } else {
            XB_SPIN(xb_ld(&bar[XB_XGEN(b.x)]) == gen, bar);
            __builtin_amdgcn_fence(__ATOMIC_ACQUIRE, "agent");
            asm volatile("s_waitcnt vmcnt(0)" ::: "memory");
        }
    }
    __syncthreads();
}

__device__ __forceinline__ void mod_item(const Params& p, char* smem, int it) {
    float* s_silu = (float*)smem;
    float* red = (float*)(smem + 9 * 1024 * 4);
    const int tid = threadIdx.x, lane = tid & 63, w = tid >> 6;
    const int layer = it / 96, col0 = (it % 96) * 64;
    for (int idx = tid; idx < 9 * 1024; idx += NTHREADS) {
        const int b = idx >> 10, k = idx & 1023;
        const float v = (b < 8) ? p.c[b * 1024 + k] : p.c_ctx[k];
        s_silu[idx] = v / (1.f + __expf(-v));
    }
    __syncthreads();
    float acc[9];
#pragma unroll
    for (int b = 0; b < 9; ++b) acc[b] = 0.f;
    const float* wp = p.w_mod + (size_t)layer * 1024 * 6144 + (size_t)(w * 128) * 6144 + col0 + lane;
    for (int kk = 0; kk < 128; kk += 8) {
        float wv[8];
#pragma unroll
        for (int u = 0; u < 8; ++u) wv[u] = wp[(size_t)(kk + u) * 6144];
#pragma unroll
        for (int b = 0; b < 9; ++b) {
            const f32x4 s0 = *(const f32x4*)(s_silu + b * 1024 + w * 128 + kk), s1 = *(const f32x4*)(s_silu + b * 1024 + w * 128 + kk + 4);
            acc[b] += s0[0] * wv[0] + s0[1] * wv[1] + s0[2] * wv[2] + s0[3] * wv[3] + s1[0] * wv[4] + s1[1] * wv[5] + s1[2] * wv[6] + s1[3] * wv[7];
        }
    }
#pragma unroll
    for (int b = 0; b < 9; ++b) red[(w * 9 + b) * 64 + lane] = acc[b];
    __syncthreads();
    for (int idx = tid; idx < 9 * 64; idx += NTHREADS) {
        const int b = idx >> 6, l = idx & 63;
        float s = 0.f;
#pragma unroll
        for (int ww = 0; ww < NWAVES; ++ww) s += red[(ww * 9 + b) * 64 + l];
        p.mod[(size_t)(layer * 9 + b) * 6144 + col0 + l] = s + p.b_mod[layer * 6144 + col0 + l];
    }
}

__device__ __forceinline__ void table_item(const Params& p) {
    const int tid = threadIdx.x;
    for (int idx = tid; idx < 64 * 16; idx += NTHREADS) {
        const int pi = idx >> 4, i = idx & 15;
        const float freq = exp2f(-(float)i * (13.28771238f / 16.f));
        const float ang = (float)pi * freq;
        p.misc[MISC_ROPE64 + idx * 2] = __cosf(ang); p.misc[MISC_ROPE64 + idx * 2 + 1] = __sinf(ang);
    }
    for (int idx = tid; idx < 64 * 8; idx += NTHREADS) {
        const int pi = idx >> 3, i = idx & 7;
        const float freq = exp2f(-(float)i * (13.28771238f / 8.f));
        const float ang = (float)pi * freq;
        p.misc[MISC_ROPE32 + idx * 2] = __cosf(ang); p.misc[MISC_ROPE32 + idx * 2 + 1] = __sinf(ang);
    }
    if (tid == 0) {
        float s1 = 0.f, s2 = 0.f;
        for (int i = 0; i < 64; ++i) { s1 += p.lq1[i] * p.lk1[i]; s2 += p.lq2[i] * p.lk2[i]; }
        p.misc[MISC_LAM] = __expf(s1) - __expf(s2) + LAMBDA_INIT;
    }
}

__device__ __forceinline__ void transpose_tile(char* smem, const float* src, int K, int Nsrc, bf16_t* dst, int ntn, int mode, const float* gain, int tile, int dmul = 1, int dadd = 0) {
    float* t = (float*)smem;
    const int tid = threadIdx.x, tx = tid & 63, ty = tid >> 6;
    const int kt = tile / ntn, nt = tile % ntn;
    const int np = nt * 64 + tx;
    int n = np;
    if (mode == 1) { n = np < 896 ? np : (np < 1024 ? 928 + (np - 896) : (np < 1152 ? 1056 + (np - 1024) : (np < 1184 ? 896 + (np - 1152) : -1))); }
    else if (mode == 2) { if (np < 512) n = (np >> 6) * 96 + (np & 63); else { const int m = np - 512; n = (m >> 5) * 96 + 64 + (m & 31); } }
#pragma unroll
    for (int i = 0; i < 8; ++i) {
        const int kl = ty + 8 * i, k = kt * 64 + kl;
        float v = 0.f;
        if (n >= 0) { v = src[(size_t)k * Nsrc + n]; if (gain) v *= gain[k]; }
        t[kl * 65 + tx] = v;
    }
    __syncthreads();
#pragma unroll
    for (int i = 0; i < 8; ++i) {
        const int nl = ty + 8 * i;
        dst[(size_t)((nt * dmul + dadd) * 64 + nl) * K + kt * 64 + tx] = (bf16_t)(cvt_pk_bf16(t[tx * 65 + nl], 0.f) & 0xffffu);
    }
}

__device__ __forceinline__ void transpose_item(const Params& p, char* smem, int r) {
    constexpr int T0 = 16 * 20, T1 = 4 * 12, T2 = 2 * 16, T3 = 16 * 16, T4 = 16 * 48, T5 = 16 * 16, TF = 16 * 44;
    if (r < T0) { transpose_tile(smem, p.ab_w_in, 1024, 1184, p.wt_in0, 20, 1, nullptr, r); return; } r -= T0;
    if (r < T1) { transpose_tile(smem, p.w_qb, 256, 768, p.wt_qb, 12, 2, p.q_norm, r); return; } r -= T1;
    if (r < T2) { transpose_tile(smem, p.w_kvb, 128, 1024, p.wt_kvb, 16, 0, p.kv_norm, r); return; } r -= T2;
    if (r < T3) { transpose_tile(smem, p.ab_w_out, 1024, 1024, p.wt_out0, 16, 0, nullptr, r); return; } r -= T3;
    if (r < T4) { transpose_tile(smem, p.d_w_in, 1024, 3072, p.wt_din, 48, 0, nullptr, r); return; } r -= T4;
    if (r < T5) { transpose_tile(smem, p.d_w_out, 1024, 1024, p.wt_dout, 16, 0, nullptr, r); return; } r -= T5;
    {
        const int j = r / TF, rr = r % TF;
        if (j < 2) transpose_tile(smem, p.w_gate + (size_t)j * 1024 * 2816, 1024, 2816, p.wt_gate + (size_t)j * 5632 * 1024, 44, 0, nullptr, rr, 2, 0);
        else if (j < 4) transpose_tile(smem, p.w_up + (size_t)(j - 2) * 1024 * 2816, 1024, 2816, p.wt_gate + (size_t)(j - 2) * 5632 * 1024, 44, 0, nullptr, rr, 2, 1);
        else transpose_tile(smem, p.w_down + (size_t)(j - 4) * 2816 * 1024, 2816, 1024, p.wt_down + (size_t)(j - 4) * 1024 * 2816, 16, 0, nullptr, rr);
    }
}
constexpr int N_TR_TILES = 16 * 20 + 4 * 12 + 2 * 16 + 16 * 16 + 16 * 48 + 16 * 16 + 6 * 16 * 44;

__device__ __forceinline__ void phase_prologue(const Params& p, char* smem) {
    const int total = 193 + N_TR_TILES;
    for (int it = blockIdx.x; it < total; it += gridDim.x) {
        if (it < 192) mod_item(p, smem, it);
        else if (it == 192) table_item(p);
        else transpose_item(p, smem, it - 193);
        __syncthreads();
    }
}

__device__ __forceinline__ void phase_h0(const Params& p) {
    const int lane = threadIdx.x & 63, w = threadIdx.x >> 6;
    for (int row = blockIdx.x * NWAVES + w; row < ROWS; row += gridDim.x * NWAVES) {
        const int b = row / TOK, j = row % TOK; const bool isc = j < CTXL;
        const float* rp = isc ? p.ctx + ((size_t)b * CTXL + j) * DM : p.x + ((size_t)b * SEQ + (j - CTXL)) * DM;
        const float* md = p.mod + (size_t)(0 * 9 + (isc ? 8 : b)) * 6144;
#pragma unroll 1
        for (int i = 0; i < 4; ++i) {
            const int col = i * 256 + lane * 4;
            const f32x4 v = *(const f32x4*)(rp + col), sh = *(const f32x4*)(md + col), sc = *(const f32x4*)(md + 1024 + col);
            u32x2 o; o.x = cvt_pk_bf16(v[0] * (1.f + sc[0]) + sh[0], v[1] * (1.f + sc[1]) + sh[1]); o.y = cvt_pk_bf16(v[2] * (1.f + sc[2]) + sh[2], v[3] * (1.f + sc[3]) + sh[3]);
            *(u32x2*)(p.h + (size_t)row * DM + col) = o;
        }
    }
}

__device__ __forceinline__ void gemm_core(char* smem, const bf16_t* __restrict__ A, int lda, int ar0a, int aloa, int ahia, int ar0b, int alob, int ahib,
                                          const bf16_t* __restrict__ B, int ldb, int K, const bf16_t* zero16, f32x4 (&acc)[8][4]) {
    constexpr int ROWB = 128, OPA = 256 * ROWB, STG = 2 * OPA, NI = 4;
    static_assert(2 * STG <= SMEM_BYTES, "LDS");
    const int tid = threadIdx.x, lane = tid & 63, w = __builtin_amdgcn_readfirstlane(tid >> 6), wr = w >> 2, wc = w & 3, fr = lane & 15, fq = lane >> 4;
    const int rl = lane >> 3, kcs = (lane & 7) ^ rl;
#pragma unroll
    for (int m = 0; m < 8; ++m)
#pragma unroll
        for (int n = 0; n < 4; ++n) acc[m][n] = (f32x4){0.f, 0.f, 0.f, 0.f};
    const int nk = K / 64;
    int aoff[NI], boff[NI];
#pragma unroll
    for (int i = 0; i < NI; ++i) {
        const int row = (w * NI + i) * 8 + rl, hf = row >> 7, gr = (hf ? ar0b : ar0a) + (row & 127);
        const bool ok = hf ? (gr >= alob && gr < ahib) : (gr >= aloa && gr < ahia);
        aoff[i] = ok ? gr * lda + kcs * 8 : -1;
        boff[i] = row * ldb + kcs * 8;
    }
    __syncthreads();
#pragma unroll
    for (int i = 0; i < NI; ++i) {
        __builtin_amdgcn_global_load_lds((const unsigned*)(aoff[i] >= 0 ? A + aoff[i] : zero16), (LAS unsigned*)(smem + (w * NI + i) * 1024), 16, 0, 0);
        __builtin_amdgcn_global_load_lds((const unsigned*)(B + boff[i]), (LAS unsigned*)(smem + OPA + (w * NI + i) * 1024), 16, 0, 0);
    }
    asm volatile("s_waitcnt vmcnt(0)" ::: "memory"); __syncthreads();
    const int sw = fr & 7;
    for (int kt = 0; kt < nk; ++kt) {
        const bool pf = kt + 1 < nk; const int nst = ((kt + 1) & 1) * STG;
        const char* base = smem + (kt & 1) * STG;
        bf16x8 bfr[2][4];
#pragma unroll
        for (int n = 0; n < 4; ++n) bfr[0][n] = *(const bf16x8*)(base + OPA + (wc * 64 + n * 16 + fr) * ROWB + ((fq ^ sw) * 16));
#pragma unroll
        for (int ks = 0; ks < 2; ++ks) {
            const int co = (((ks * 4 + fq) ^ sw) * 16);
#pragma unroll
            for (int m = 0; m < 8; ++m) {
                const bf16x8 af = *(const bf16x8*)(base + (wr * 128 + m * 16 + fr) * ROWB + co);
#pragma unroll
                for (int n = 0; n < 4; ++n) acc[m][n] = __builtin_amdgcn_mfma_f32_16x16x32_bf16(af, bfr[ks][n], acc[m][n], 0, 0, 0);
                if (ks == 0 && m == 5) {
#pragma unroll
                    for (int n = 0; n < 4; ++n) bfr[1][n] = *(const bf16x8*)(base + OPA + (wc * 64 + n * 16 + fr) * ROWB + (((4 + fq) ^ sw) * 16));
                }
                if (ks == 0 && pf) {
                    const int i = m & 3, lo_ = nst + (w * NI + i) * 1024;
                    if (m < 4) __builtin_amdgcn_global_load_lds((const unsigned*)(aoff[i] >= 0 ? A + aoff[i] + (kt + 1) * 64 : zero16), (LAS unsigned*)(smem + lo_), 16, 0, 0);
                    else __builtin_amdgcn_global_load_lds((const unsigned*)(B + boff[i] + (kt + 1) * 64), (LAS unsigned*)(smem + lo_ + OPA), 16, 0, 0);
                }
            }
        }
        asm volatile("s_waitcnt vmcnt(0)" ::: "memory");
        __syncthreads();
    }
}

__device__ __forceinline__ void acc_to_ct(float* Ct0, const f32x4 (&acc)[8][4], int ai) {
    const int tid = threadIdx.x, lane = tid & 63, w = tid >> 6, wr = w >> 2, wc = w & 3, fr = lane & 15, fq = lane >> 4;
    __syncthreads();
    if (wr == ai) {
        float* Ct = Ct0 + (wc >> 1) * CT_FLOATS + (wc & 1) * 64 + fr;
#pragma unroll
        for (int m = 0; m < 8; ++m)
#pragma unroll
            for (int n = 0; n < 4; ++n)
#pragma unroll
                for (int j = 0; j < 4; ++j) Ct[(m * 16 + fq * 4 + j) * LDC + n * 16] = acc[m][n][j];
    }
    __syncthreads();
}

__device__ __forceinline__ void gemm_core_h(char* smem, const bf16_t* __restrict__ A, int lda, int ar0a, int aloa, int ahia, int ar0b, int alob, int ahib,
                                            const bf16_t* __restrict__ B, int ldb, int K, const bf16_t* zero16, f32x4 (&acc)[4][4]) {
    constexpr int ROWB = 128, OPA = 256 * ROWB, STG = 2 * OPA, NI = 4, NIB = 2;
    const int tid = threadIdx.x, lane = tid & 63, w = __builtin_amdgcn_readfirstlane(tid >> 6), wr = w >> 1, wc = w & 1, fr = lane & 15, fq = lane >> 4;
    const int rl = lane >> 3, kcs = (lane & 7) ^ rl;
#pragma unroll
    for (int m = 0; m < 4; ++m)
#pragma unroll
        for (int n = 0; n < 4; ++n) acc[m][n] = (f32x4){0.f, 0.f, 0.f, 0.f};
    const int nk = K / 64;
    int aoff[NI], boff[NIB];
#pragma unroll
    for (int i = 0; i < NI; ++i) {
        const int row = (w * NI + i) * 8 + rl, hf = row >> 7, gr = (hf ? ar0b : ar0a) + (row & 127);
        const bool ok = hf ? (gr >= alob && gr < ahib) : (gr >= aloa && gr < ahia);
        aoff[i] = ok ? gr * lda + kcs * 8 : -1;
    }
#pragma unroll
    for (int i = 0; i < NIB; ++i) boff[i] = ((w * NIB + i) * 8 + rl) * ldb + kcs * 8;
    __syncthreads();
#pragma unroll
    for (int i = 0; i < NI; ++i) __builtin_amdgcn_global_load_lds((const unsigned*)(aoff[i] >= 0 ? A + aoff[i] : zero16), (LAS unsigned*)(smem + (w * NI + i) * 1024), 16, 0, 0);
#pragma unroll
    for (int i = 0; i < NIB; ++i) __builtin_amdgcn_global_load_lds((const unsigned*)(B + boff[i]), (LAS unsigned*)(smem + OPA + (w * NIB + i) * 1024), 16, 0, 0);
    asm volatile("s_waitcnt vmcnt(0)" ::: "memory"); __syncthreads();
    const int sw = fr & 7;
    for (int kt = 0; kt < nk; ++kt) {
        const bool pf = kt + 1 < nk; const int nst = ((kt + 1) & 1) * STG;
        const char* base = smem + (kt & 1) * STG;
#pragma unroll
        for (int ks = 0; ks < 2; ++ks) {
            const int co = (((ks * 4 + fq) ^ sw) * 16);
            bf16x8 bfr[4];
#pragma unroll
            for (int n = 0; n < 4; ++n) bfr[n] = *(const bf16x8*)(base + OPA + (wc * 64 + n * 16 + fr) * ROWB + co);
#pragma unroll
            for (int m = 0; m < 4; ++m) {
                const bf16x8 af = *(const bf16x8*)(base + (wr * 64 + m * 16 + fr) * ROWB + co);
#pragma unroll
                for (int n = 0; n < 4; ++n) acc[m][n] = __builtin_amdgcn_mfma_f32_16x16x32_bf16(af, bfr[n], acc[m][n], 0, 0, 0);
                if (pf) {
                    if (ks == 0) __builtin_amdgcn_global_load_lds((const unsigned*)(aoff[m] >= 0 ? A + aoff[m] + (kt + 1) * 64 : zero16), (LAS unsigned*)(smem + nst + (w * NI + m) * 1024), 16, 0, 0);
                    else if (m < NIB) __builtin_amdgcn_global_load_lds((const unsigned*)(B + boff[m & 1] + (kt + 1) * 64), (LAS unsigned*)(smem + nst + OPA + (w * NIB + (m & 1)) * 1024), 16, 0, 0);
                }
            }
        }
        asm volatile("s_waitcnt vmcnt(0)" ::: "memory");
        __syncthreads();
    }
}
__device__ __forceinline__ void acc_to_ct_h(float* Ct0, const f32x4 (&acc)[4][4], int ai) {
    const int tid = threadIdx.x, lane = tid & 63, w = tid >> 6, wr = w >> 1, wc = w & 1, fr = lane & 15, fq = lane >> 4;
    __syncthreads();
    if ((wr >> 1) == ai) {
        float* Ct = Ct0 + ((wr & 1) * 64 + fq * 4) * LDC + wc * 64 + fr;
#pragma unroll
        for (int m = 0; m < 4; ++m)
#pragma unroll
            for (int n = 0; n < 4; ++n)
#pragma unroll
                for (int j = 0; j < 4; ++j) Ct[(m * 16 + j) * LDC + n * 16] = acc[m][n][j];
    }
    __syncthreads();
}
#define TAIL_DECODE(T) const int G_ = gridDim.x, Tfull_ = ((T) / G_) * G_, total_ = Tfull_ + 2 * ((T) - Tfull_)
#define NOTAIL_DECODE(T) const int G_ = gridDim.x, Tfull_ = (T), total_ = (T)
#define TAIL_ITEM(it, tile, half) int tile, half; if ((it) < Tfull_) { tile = (it); half = -1; } else { const int r_ = (it) - Tfull_; tile = Tfull_ + (r_ >> 1); half = r_ & 1; }

__device__ __forceinline__ void load8(const float* src, float (&v)[8]) {
    const f32x4 a = *(const f32x4*)src, b = *(const f32x4*)(src + 4);
    v[0] = a[0]; v[1] = a[1]; v[2] = a[2]; v[3] = a[3]; v[4] = b[0]; v[5] = b[1]; v[6] = b[2]; v[7] = b[3];
}

__device__ __forceinline__ void rope8(const float* rowp, int c0, int hd, int pos, const float* tab, float (&v)[8]) {
    const int qs = hd >> 2, ch = c0 & (hd - 1), qd = ch / qs, i0 = ch & (qs - 1);
    const int idx = (qd < 2) ? (pos >> 6) : (pos & 63);
    const int pc = (qd & 1) ? c0 - qs : c0 + qs; const float sgn = (qd & 1) ? 1.f : -1.f;
    const float* t = tab + (idx * qs + i0) * 2;
#pragma unroll
    for (int e = 0; e < 8; ++e) v[e] = v[e] * t[2 * e] + sgn * rowp[pc + e] * t[2 * e + 1];
}

__device__ __forceinline__ void store_col8(const float* Ct, int c, int rc, bf16_t* dst, const float* rs) {
    float v[8];
#pragma unroll
    for (int e = 0; e < 8; ++e) { v[e] = Ct[(rc * 8 + e) * LDC + c]; if (rs) v[e] *= rs[rc * 8 + e]; }
    store8(dst, v);
}

__device__ __forceinline__ void epi_proj0(const Params& p, const float* Ct, int mt, int nt) {
    const int tid = threadIdx.x;
    bf16_t* proj0 = p.big + BE_PROJ0; bf16_t* vt_swa = p.big + BE_VT_SWA; bf16_t* k_mla = p.big + BE_K_MLA;
    extern __shared__ __attribute__((aligned(16))) char smem_dyn_[]; const float* lds_tab_ = (const float*)(smem_dyn_ + SMEM_BYTES);
    const float* rope64 = lds_tab_ + MISC_ROPE64; const float* rope32 = lds_tab_ + MISC_ROPE32;
    const int b = mt / 18, jt = mt % 18; const bool is_ctx = jt < 2; const int row0 = mt * 128, tok0 = jt * 128;
    if (nt == 8) {
#pragma unroll 1
        for (int i = 0; i < 4; ++i) { const int id = tid + NTHREADS * i, c = id & 127, rc = id >> 7;
            store_col8(Ct, c, rc, vt_swa + (size_t)((b * 2 + (c >> 6)) * 64 + (c & 63)) * TOK + tok0 + rc * 8, nullptr); }
    } else {
#pragma unroll 1
        for (int i = 0; i < 4; ++i) {
            const int id = tid + NTHREADS * i, r = id >> 4, c0 = (id & 15) * 8;
            const float* rowp = Ct + r * LDC; float v[8]; load8(rowp + c0, v);
            const int grow = row0 + r, pos = tok0 + r - CTXL;
            if (nt <= 1 || nt == 6) { store8(proj0 + (size_t)grow * 1024 + nt * 128 + c0, v); }
            else if (nt <= 5 || nt == 7) { if (!is_ctx) rope8(rowp, c0, 64, pos, rope64, v); store8(proj0 + (size_t)grow * 1024 + (nt == 7 ? 896 : nt * 128) + c0, v); }
            else if (c0 < 32) { if (!is_ctx) rope8(rowp, c0, 32, pos, rope32, v);
#pragma unroll
                for (int hh = 0; hh < 8; ++hh) store8(k_mla + (size_t)grow * 768 + hh * 96 + 64 + c0, v); }
        }
    }
}
__device__ __forceinline__ void phase_proj0(const Params& p, char* smem) {
    float* Ct = (float*)smem;
    TAIL_DECODE(72 * 5);
    for (int it = blockIdx.x; it < total_; it += G_) {
        TAIL_ITEM(it, tile, half)
        const int mt2 = tile / 5, nt2 = tile % 5;
        if (half < 0) {
            f32x4 acc[8][4];
            gemm_core(smem, p.h, DM, mt2 * 256, 0, ROWS, mt2 * 256 + 128, 0, ROWS, p.wt_in0 + (size_t)nt2 * 256 * DM, DM, DM, (const bf16_t*)p.bar, acc);
#pragma unroll 1
            for (int ai = 0; ai < 2; ++ai) {
                acc_to_ct(Ct, acc, ai);
                epi_proj0(p, Ct, mt2 * 2 + ai, nt2 * 2);
                epi_proj0(p, Ct + CT_FLOATS, mt2 * 2 + ai, nt2 * 2 + 1);
            }
        } else {
            const int nt = nt2 * 2 + half;
            f32x4 acc[4][4];
            gemm_core_h(smem, p.h, DM, mt2 * 256, 0, ROWS, mt2 * 256 + 128, 0, ROWS, p.wt_in0 + (size_t)nt * 128 * DM, DM, DM, (const bf16_t*)p.bar, acc);
#pragma unroll 1
            for (int ai = 0; ai < 2; ++ai) { acc_to_ct_h(Ct, acc, ai); epi_proj0(p, Ct, mt2 * 2 + ai, nt); }
        }
    }
}

__device__ __forceinline__ void row_rstd(const bf16_t* A, int lda, int row0, int K, float* rs) {
    const int tid = threadIdx.x;
    if (tid < 256) {
        const int r = tid >> 1, hf = tid & 1; const int n = K / 2;
        const bf16_t* ap = A + (size_t)(row0 + r) * lda + hf * n; float ss = 0.f;
        for (int k = 0; k < n; k += 8) { const u32x4 v = *(const u32x4*)(ap + k);
            ss += bflo(v.x) * bflo(v.x) + bfhi(v.x) * bfhi(v.x) + bflo(v.y) * bflo(v.y) + bfhi(v.y) * bfhi(v.y) + bflo(v.z) * bflo(v.z) + bfhi(v.z) * bfhi(v.z) + bflo(v.w) * bflo(v.w) + bfhi(v.w) * bfhi(v.w); }
        ss += __shfl_xor(ss, 1);
        if (hf == 0) rs[r] = rsqrtf(ss / (float)K + 1e-6f);
    }
    __syncthreads();
}
__device__ __forceinline__ void epi_mla_q(const Params& p, const float* Ct, const float* rs, int mt, int nt) {
    extern __shared__ __attribute__((aligned(16))) char smem_dyn_[]; const float* lds_tab_ = (const float*)(smem_dyn_ + SMEM_BYTES);
    const int tid = threadIdx.x; bf16_t* q_mla = p.big + BE_Q_MLA; const float* rope32 = lds_tab_ + MISC_ROPE32;
    const int jt = mt % 18; const bool is_ctx = jt < 2; const int row0 = mt * 128, tok0 = jt * 128;
#pragma unroll 1
    for (int i = 0; i < 4; ++i) {
        const int id = tid + NTHREADS * i, r = id >> 4, c0 = (id & 15) * 8;
        const float* rowp = Ct + r * LDC; float v[8]; load8(rowp + c0, v);
        const int grow = row0 + r, pos = tok0 + r - CTXL; const float sc = rs[r];
        int dcol;
        if (nt < 4) { const int cg = nt * 128 + c0; dcol = (cg >> 6) * 96 + (cg & 63); }
        else { const int cg = (nt - 4) * 128 + c0; dcol = (cg >> 5) * 96 + 64 + (cg & 31); if (!is_ctx) rope8(rowp, c0, 32, pos, rope32, v); }
#pragma unroll
        for (int e = 0; e < 8; ++e) v[e] *= sc;
        store8(q_mla + (size_t)grow * 768 + dcol, v);
    }
}
__device__ __forceinline__ void epi_mla_kv(const Params& p, const float* Ct, const float* rs, int mt, int hh) {
    const int tid = threadIdx.x; bf16_t* k_mla = p.big + BE_K_MLA; bf16_t* vt_mla = p.big + BE_VT_MLA;
    const int b = mt / 18, jt = mt % 18; const int row0 = mt * 128, tok0 = jt * 128;
#pragma unroll 1
    for (int i = 0; i < 2; ++i) {
        const int id = tid + NTHREADS * i, r = id >> 3, c0 = (id & 7) * 8;
        float v[8]; load8(Ct + r * LDC + c0, v); const float sc = rs[r];
#pragma unroll
        for (int e = 0; e < 8; ++e) v[e] *= sc;
        store8(k_mla + (size_t)(row0 + r) * 768 + hh * 96 + c0, v);
    }
#pragma unroll 1
    for (int i = 0; i < 2; ++i) { const int id = tid + NTHREADS * i, c = 64 + (id & 63), rc = id >> 6;
        store_col8(Ct, c, rc, vt_mla + (size_t)((b * 8 + hh) * 64 + (c - 64)) * TOK + tok0 + rc * 8, rs); }
}
__device__ __forceinline__ void phase_mla_up(const Params& p, char* smem) {
    float* Ct = (float*)smem; float* rs = (float*)(smem + 2 * CT_FLOATS * 4);
    bf16_t* proj0 = p.big + BE_PROJ0;
    for (int it = blockIdx.x; it < 72 * 7; it += gridDim.x) {
        const int mt2 = it / 7, nt2 = it % 7;
        f32x4 acc[8][4];
        if (nt2 < 3) gemm_core(smem, proj0, 1024, mt2 * 256, 0, ROWS, mt2 * 256 + 128, 0, ROWS, p.wt_qb + (size_t)nt2 * 256 * 256, 256, 256, (const bf16_t*)p.bar, acc);
        else gemm_core(smem, proj0 + 768, 1024, mt2 * 256, 0, ROWS, mt2 * 256 + 128, 0, ROWS, p.wt_kvb + (size_t)(nt2 - 3) * 256 * 128, 128, 128, (const bf16_t*)p.bar, acc);
#pragma unroll 1
        for (int ai = 0; ai < 2; ++ai) {
            acc_to_ct(Ct, acc, ai);
            const int mt = mt2 * 2 + ai;
            if (nt2 < 3) { row_rstd(proj0, 1024, mt * 128, 256, rs); epi_mla_q(p, Ct, rs, mt, nt2 * 2); epi_mla_q(p, Ct + CT_FLOATS, rs, mt, nt2 * 2 + 1); }
            else { row_rstd(proj0 + 768, 1024, mt * 128, 128, rs); epi_mla_kv(p, Ct, rs, mt, (nt2 - 3) * 2); epi_mla_kv(p, Ct + CT_FLOATS, rs, mt, (nt2 - 3) * 2 + 1); }
        }
    }
}

template <int DQK, int DV, bool WINDOWED>
__device__ __forceinline__ void flash_pass(char* smem, const bf16_t* __restrict__ Qp, int ldq, const bf16_t* __restrict__ Kp, int ldk,
                                           const bf16_t* __restrict__ Vtp, int seg2s, int seg2e, int q_tok0, float sc2,
                                           f32x4 (&o)[DV / 16][2], float (&mrun)[2], float (&lrun)[2]) {
    constexpr int KROW = DQK * 2, VROW = 128, KB = 64 * KROW, VB = DV * VROW, STG = KB + VB;
    constexpr int KCPR = DQK / 8, NKI = KCPR, NVI = DV / 8, KCPT = (NKI + 7) / 8, VCPT = NVI / 8, NKS = DQK / 32, NMD = DV / 16;
    static_assert(2 * STG <= SMEM_BYTES, "LDS");
    const int tid = threadIdx.x, lane = tid & 63, w = tid >> 6, fr = lane & 15, fq = lane >> 4, wq0 = w * 32;
    bf16x8 qf[2][NKS];
#pragma unroll
    for (int nq = 0; nq < 2; ++nq)
#pragma unroll
        for (int ks = 0; ks < NKS; ++ks) qf[nq][ks] = *(const bf16x8*)(Qp + (size_t)(wq0 + nq * 16 + fr) * ldq + ks * 32 + fq * 8);
#pragma unroll
    for (int md = 0; md < NMD; ++md) { o[md][0] = (f32x4){0.f, 0.f, 0.f, 0.f}; o[md][1] = (f32x4){0.f, 0.f, 0.f, 0.f}; }
    float mref[2]; mref[0] = mref[1] = -1e30f; lrun[0] = lrun[1] = 0.f;
    const float thr = 8.0f / sc2;
    const int nt = 4 + (seg2e > seg2s ? (seg2e - seg2s) / 64 : 0);
    const int wu = __builtin_amdgcn_readfirstlane(w);
    int koffg[KCPT], voffg[VCPT];
#pragma unroll
    for (int i = 0; i < KCPT; ++i) { const int idx = (wu + 8 * i) * 64 + lane, rho = (idx / KCPR) & 63, cp = idx % KCPR;
        const int key = 32 * (rho >> 5) + 8 * ((rho >> 2) & 3) + 4 * ((rho >> 4) & 1) + (rho & 3);
        const int kcs = (DQK == 64) ? (cp ^ (rho & 7)) : ((cp & ~3) | ((cp & 3) ^ ((4 - ((rho >> 2) & 3)) & 3)));
        koffg[i] = key * ldk + kcs * 8; }
#pragma unroll
    for (int i = 0; i < VCPT; ++i) { const int idx = (wu + 8 * i) * 64 + lane, r = idx >> 3, cp = idx & 7; voffg[i] = r * TOK + ((cp ^ (r & 7)) * 8); }
    __syncthreads();
#define FDMA(t, st) do { const int key0_ = (t) < 4 ? (t) * 64 : seg2s + ((t) - 4) * 64; const bf16_t* kg_ = Kp + (size_t)key0_ * ldk; const bf16_t* vg_ = Vtp + key0_; \
        _Pragma("unroll") for (int i = 0; i < KCPT; ++i) if (wu + 8 * i < NKI) __builtin_amdgcn_global_load_lds((const unsigned*)(kg_ + koffg[i]), (LAS unsigned*)(smem + (st) * STG + (wu + 8 * i) * 1024), 16, 0, 0); \
        _Pragma("unroll") for (int i = 0; i < VCPT; ++i) __builtin_amdgcn_global_load_lds((const unsigned*)(vg_ + voffg[i]), (LAS unsigned*)(smem + (st) * STG + KB + (wu + 8 * i) * 1024), 16, 0, 0); } while (0)
    FDMA(0, 0);
    asm volatile("s_waitcnt vmcnt(0)" ::: "memory"); __syncthreads();
    const int ksw = (DQK == 64) ? (fr & 7) : ((4 - ((fr >> 2) & 3)) & 3);
    for (int t = 0; t < nt; ++t) {
        if (t + 1 < nt) FDMA(t + 1, (t + 1) & 1);
        const char* kb = smem + (t & 1) * STG; const char* vb = kb + KB;
        const int key0 = t < 4 ? t * 64 : seg2s + (t - 4) * 64;
        f32x4 s[4][2];
#pragma unroll
        for (int mk = 0; mk < 4; ++mk) { s[mk][0] = (f32x4){0.f, 0.f, 0.f, 0.f}; s[mk][1] = (f32x4){0.f, 0.f, 0.f, 0.f}; }
#pragma unroll
        for (int ks = 0; ks < NKS; ++ks) {
            const int co = (DQK == 64) ? (((ks * 4 + fq) ^ ksw) * 16) : ((ks * 4 + (fq ^ ksw)) * 16);
#pragma unroll
            for (int mk = 0; mk < 4; ++mk) {
                const bf16x8 kf = *(const bf16x8*)(kb + (mk * 16 + fr) * KROW + co);
                s[mk][0] = __builtin_amdgcn_mfma_f32_16x16x32_bf16(kf, qf[0][ks], s[mk][0], 0, 0, 0);
                s[mk][1] = __builtin_amdgcn_mfma_f32_16x16x32_bf16(kf, qf[1][ks], s[mk][1], 0, 0, 0);
            }
        }
        __builtin_amdgcn_sched_barrier(0);
        bf16x8 vf0[4];
#pragma unroll
        for (int md = 0; md < 4; ++md) vf0[md] = *(const bf16x8*)(vb + (md * 16 + fr) * VROW + ((fq ^ (fr & 7)) * 16));
        bf16x8 pf[2][2];
#pragma unroll
        for (int nq = 0; nq < 2; ++nq) {
            if (WINDOWED && key0 >= CTXL) {
                const int qpos = q_tok0 - CTXL + wq0 + nq * 16 + fr;
#pragma unroll
                for (int mk = 0; mk < 4; ++mk)
#pragma unroll
                    for (int j = 0; j < 4; ++j) { const int kpos = key0 - CTXL + 32 * (mk >> 1) + 8 * fq + 4 * (mk & 1) + j; const int d = qpos - kpos; if (d > 128 || d < -128) s[mk][nq][j] = -1e30f; }
            }
            float mx = fmaxf(fmaxf(s[0][nq][0], s[0][nq][1]), fmaxf(s[0][nq][2], s[0][nq][3]));
#pragma unroll
            for (int mk = 1; mk < 4; ++mk) mx = fmaxf(fmaxf(mx, fmaxf(s[mk][nq][0], s[mk][nq][1])), fmaxf(s[mk][nq][2], s[mk][nq][3]));
            mx = fmaxf(mx, __shfl_xor(mx, 16)); mx = fmaxf(mx, __shfl_xor(mx, 32));
            const bool need = mx > mref[nq] + thr;
            if (__any(need)) {
                const float mnew = need ? mx : mref[nq];
                const float alpha = fast_exp2((mref[nq] - mnew) * sc2);
                mref[nq] = mnew; lrun[nq] *= alpha;
#pragma unroll
                for (int md = 0; md < NMD; ++md) o[md][nq] = o[md][nq] * alpha;
            }
            const float nm = -mref[nq] * sc2;
            float ls = 0.f;
#pragma unroll
            for (int mk = 0; mk < 4; ++mk)
#pragma unroll
                for (int j = 0; j < 4; ++j) { const float pv = fast_exp2(fmaf(s[mk][nq][j], sc2, nm)); s[mk][nq][j] = pv; ls += pv; }
            lrun[nq] += ls;
#pragma unroll
            for (int kk = 0; kk < 2; ++kk) {
                u32x4 pk; pk.x = cvt_pk_bf16(s[2 * kk][nq][0], s[2 * kk][nq][1]); pk.y = cvt_pk_bf16(s[2 * kk][nq][2], s[2 * kk][nq][3]);
                pk.z = cvt_pk_bf16(s[2 * kk + 1][nq][0], s[2 * kk + 1][nq][1]); pk.w = cvt_pk_bf16(s[2 * kk + 1][nq][2], s[2 * kk + 1][nq][3]);
                pf[nq][kk] = __builtin_bit_cast(bf16x8, pk);
            }
#pragma unroll
            for (int kk = 0; kk < 2; ++kk) {
                const int co = (((kk * 4 + fq) ^ (fr & 7)) * 16);
#pragma unroll
                for (int md = 0; md < NMD; ++md) {
                    const bf16x8 vf = (nq == 0 && kk == 0 && md < 4) ? vf0[md & 3] : *(const bf16x8*)(vb + (md * 16 + fr) * VROW + co);
                    o[md][nq] = __builtin_amdgcn_mfma_f32_16x16x32_bf16(vf, pf[nq][kk], o[md][nq], 0, 0, 0);
                }
            }
        }
        asm volatile("s_waitcnt vmcnt(0)" ::: "memory");
        __syncthreads();
    }
#undef FDMA
#pragma unroll
    for (int nq = 0; nq < 2; ++nq) { float l = lrun[nq]; l += __shfl_xor(l, 16); l += __shfl_xor(l, 32); lrun[nq] = l; mrun[nq] = mref[nq] * sc2; }
}

template <int NMD>
__device__ __forceinline__ void store_o(bf16_t* Op, int ldo, const f32x4 (&o)[NMD][2], const float (&inv)[2]) {
    const int lane = threadIdx.x & 63, w = threadIdx.x >> 6, fr = lane & 15, fq = lane >> 4, wq0 = w * 32;
#pragma unroll
    for (int nq = 0; nq < 2; ++nq)
#pragma unroll
        for (int md = 0; md < NMD; ++md) {
            u32x2 v; v.x = cvt_pk_bf16(o[md][nq][0] * inv[nq], o[md][nq][1] * inv[nq]); v.y = cvt_pk_bf16(o[md][nq][2] * inv[nq], o[md][nq][3] * inv[nq]);
            *(u32x2*)(Op + (size_t)(wq0 + nq * 16 + fr) * ldo + md * 16 + fq * 4) = v;
        }
}

__device__ __forceinline__ void phase_attn0(const Params& p, char* smem) {
    const bf16_t* proj0 = p.big + BE_PROJ0; const bf16_t* vt_swa = p.big + BE_VT_SWA; const bf16_t* q_mla = p.big + BE_Q_MLA;
    const bf16_t* k_mla = p.big + BE_K_MLA; const bf16_t* vt_mla = p.big + BE_VT_MLA;
    for (int it = blockIdx.x; it < 1152; it += gridDim.x) {
        int kind, b, hh, qbl; bool lat;
        if (it < 1024) { lat = true; kind = it >> 9; const int r = it & 511; b = r >> 6; hh = (r >> 3) & 7; qbl = r & 7; }
        else { lat = false; const int r = it - 1024; kind = r >> 6; b = (r >> 3) & 7; hh = r & 7; qbl = 0; }
        const int qtok0 = lat ? CTXL + 256 * qbl : 0, row0 = b * TOK + qtok0;
        f32x4 o[4][2]; float m[2], l[2], inv[2];
        if (kind == 0) {
            flash_pass<96, 64, false>(smem, q_mla + (size_t)row0 * 768 + hh * 96, 768, k_mla + (size_t)b * TOK * 768 + hh * 96, 768,
                               vt_mla + (size_t)((b * 8 + hh) * 64) * TOK, CTXL, lat ? TOK : CTXL, qtok0, 0.10206207262f * LOG2E, o, m, l);
            inv[0] = 1.f / l[0]; inv[1] = 1.f / l[1];
            store_o<4>(p.o + (size_t)row0 * 1024 + hh * 64, 1024, o, inv);
        } else {
            int s2s = CTXL, s2e = CTXL;
            if (lat) { const int lo = 256 * qbl - 128, hi = 256 * qbl + 384; s2s = CTXL + (lo > 0 ? lo : 0); s2e = CTXL + (hi < SEQ ? hi : SEQ); }
            flash_pass<64, 64, true>(smem, proj0 + (size_t)row0 * 1024 + 256 + hh * 64, 1024, proj0 + (size_t)b * TOK * 1024 + 896 + (hh >> 2) * 64, 1024,
                               vt_swa + (size_t)((b * 2 + (hh >> 2)) * 64) * TOK, s2s, s2e, qtok0, 0.125f * LOG2E, o, m, l);
            const float sk = p.sink[hh] * LOG2E;
            inv[0] = 1.f / (l[0] + fast_exp2(sk - m[0])); inv[1] = 1.f / (l[1] + fast_exp2(sk - m[1]));
            store_o<4>(p.o + (size_t)row0 * 1024 + 512 + hh * 64, 1024, o, inv);
        }
    }
}

__device__ __forceinline__ void epi_plain(const float* Ct, bf16_t* out, int ldo, int mt, int nt) {
    const int tid = threadIdx.x;
#pragma unroll 1
    for (int i = 0; i < 4; ++i) {
        const int id = tid + NTHREADS * i, r = id >> 4, c0 = (id & 15) * 8;
        float v[8]; load8(Ct + r * LDC + c0, v);
        store8(out + (size_t)(mt * 128 + r) * ldo + nt * 128 + c0, v);
    }
}
__device__ __forceinline__ void phase_gemm_plain(char* smem, const bf16_t* zero16, const bf16_t* A, int lda, const bf16_t* Wt, int K, int ntn2, bf16_t* out, int ldo, bool lat_only) {
    float* Ct = (float*)smem;
    const int nmt2 = lat_only ? 64 : 72;
    TAIL_DECODE(nmt2 * ntn2);
    for (int it = blockIdx.x; it < total_; it += G_) {
        TAIL_ITEM(it, tile, half)
        int mt2 = tile / ntn2; const int nt2 = tile % ntn2;
        if (lat_only) mt2 = (mt2 >> 3) * 9 + 1 + (mt2 & 7);
        if (half < 0) {
            f32x4 acc[8][4];
            gemm_core(smem, A, lda, mt2 * 256, 0, ROWS, mt2 * 256 + 128, 0, ROWS, Wt + (size_t)nt2 * 256 * K, K, K, zero16, acc);
#pragma unroll 1
            for (int ai = 0; ai < 2; ++ai) {
                acc_to_ct(Ct, acc, ai);
                epi_plain(Ct, out, ldo, mt2 * 2 + ai, nt2 * 2);
                epi_plain(Ct + CT_FLOATS, out, ldo, mt2 * 2 + ai, nt2 * 2 + 1);
            }
        } else {
            const int nt = nt2 * 2 + half;
            f32x4 acc[4][4];
            gemm_core_h(smem, A, lda, mt2 * 256, 0, ROWS, mt2 * 256 + 128, 0, ROWS, Wt + (size_t)nt * 128 * K, K, K, zero16, acc);
#pragma unroll 1
            for (int ai = 0; ai < 2; ++ai) { acc_to_ct_h(Ct, acc, ai); epi_plain(Ct, out, ldo, mt2 * 2 + ai, nt); }
        }
    }
}

__device__ __forceinline__ void phase_ln(const Params& p, const float* res_lat, const float* res_ctx, int layer, int gate_idx, const float* lng, const float* lnb,
                                         float* out_lat, float* out_ctx, bool write_h, int hl, int sh_idx, int sc_idx, bool inc_ctx) {
    const int lane = threadIdx.x & 63, w = threadIdx.x >> 6;
    for (int row = blockIdx.x * NWAVES + w; row < ROWS; row += gridDim.x * NWAVES) {
        const int b = row / TOK, j = row % TOK; const bool isc = j < CTXL;
        if (isc && !inc_ctx) continue;
        const size_t ro = isc ? ((size_t)b * CTXL + j) * DM : ((size_t)b * SEQ + (j - CTXL)) * DM;
        const float* rp = (isc ? res_ctx : res_lat) + ro; float* op = (isc ? out_ctx : out_lat) + ro;
        const int bm = isc ? 8 : b;
        const float* gate = p.mod + (size_t)(layer * 9 + bm) * 6144 + gate_idx * 1024;
        bf16_t* fp = p.h + (size_t)row * DM;
        f32x4 y[4]; float sum = 0.f;
#pragma unroll
        for (int i = 0; i < 4; ++i) {
            const int col = i * 256 + lane * 4;
            const f32x4 r = *(const f32x4*)(rp + col), gt = *(const f32x4*)(gate + col); const u32x2 f = *(const u32x2*)(fp + col);
            y[i][0] = ALPHA_RES * r[0] + gt[0] * bflo(f.x); y[i][1] = ALPHA_RES * r[1] + gt[1] * bfhi(f.x);
            y[i][2] = ALPHA_RES * r[2] + gt[2] * bflo(f.y); y[i][3] = ALPHA_RES * r[3] + gt[3] * bfhi(f.y);
            sum += (y[i][0] + y[i][1]) + (y[i][2] + y[i][3]);
        }
        const float mean = wave_sum(sum) * (1.f / DM); float sq = 0.f;
#pragma unroll
        for (int i = 0; i < 4; ++i) { y[i] = y[i] - mean; sq += (y[i][0] * y[i][0] + y[i][1] * y[i][1]) + (y[i][2] * y[i][2] + y[i][3] * y[i][3]); }
        const float rstd = rsqrtf(wave_sum(sq) * (1.f / DM) + 1e-5f);
        const float* mh = p.mod + (size_t)(hl * 9 + bm) * 6144;
#pragma unroll
        for (int i = 0; i < 4; ++i) {
            const int col = i * 256 + lane * 4;
            const f32x4 g = *(const f32x4*)(lng + col), bb = *(const f32x4*)(lnb + col);
            const f32x4 xl = y[i] * rstd * g + bb;
            *(f32x4*)(op + col) = xl;
            if (write_h) {
                const f32x4 sh = *(const f32x4*)(mh + sh_idx * 1024 + col), sc = *(const f32x4*)(mh + sc_idx * 1024 + col);
                u32x2 hv; hv.x = cvt_pk_bf16(xl[0] * (1.f + sc[0]) + sh[0], xl[1] * (1.f + sc[1]) + sh[1]); hv.y = cvt_pk_bf16(xl[2] * (1.f + sc[2]) + sh[2], xl[3] * (1.f + sc[3]) + sh[3]);
                *(u32x2*)(fp + col) = hv;
            }
        }
    }
}

struct SubTile { int alo, ahi, ar0, jm, seg_len; bool valid; };
__device__ __forceinline__ SubTile ffn_subtile(int layer, int b, int sidx) {
    SubTile t; const int cnt = layer == 0 ? 20 : 17; t.valid = sidx < cnt;
    int jm = sidx, seg_off = CTXL, seg_len = SEQ;
    if (layer == 0) { if (sidx < 3) { seg_off = 0; seg_len = CTXL; } else jm = sidx - 3; }
    t.jm = jm; t.seg_len = seg_len; t.alo = b * TOK + seg_off; t.ahi = t.valid ? t.alo + seg_len : t.alo; t.ar0 = t.alo + 126 * jm - 1;
    return t;
}
__device__ __forceinline__ SubTile sel_subtile(const SubTile& a, const SubTile& b, int ai) {
    SubTile t; t.alo = ai ? b.alo : a.alo; t.ahi = ai ? b.ahi : a.ahi; t.ar0 = ai ? b.ar0 : a.ar0; t.jm = ai ? b.jm : a.jm; t.seg_len = ai ? b.seg_len : a.seg_len; t.valid = ai ? b.valid : a.valid; return t;
}
__device__ __forceinline__ void epi_ffn1(const Params& p, const float* Ct, int layer, const SubTile& t, int hc0) {
    if (!t.valid) return;
    const int tid = threadIdx.x; bf16_t* hid = p.big + BE_HID;
    const float* cw = p.conv_w + (size_t)layer * 3 * DFF; const float* cb = p.conv_b + (size_t)layer * DFF;
    const int c0 = (tid & 7) * 8, hc = hc0 + c0;
    float w0[8], w1[8], w2[8], bs[8];
    load8(cw + hc, w0); load8(cw + DFF + hc, w1); load8(cw + 2 * DFF + hc, w2); load8(cb + hc, bs);
#pragma unroll
    for (int i = 0; i < 2; ++i) {
        const int r = (tid + NTHREADS * i) >> 3;
        const int srow = 126 * t.jm - 1 + r;
        if (r < 1 || r > 126 || srow >= t.seg_len) continue;
        float gm[8], g0[8], gp[8], u[8], hv[8];
        load8(Ct + (r - 1) * LDC + c0, gm); load8(Ct + r * LDC + c0, g0); load8(Ct + (r + 1) * LDC + c0, gp); load8(Ct + r * LDC + 64 + c0, u);
#pragma unroll
        for (int e = 0; e < 8; ++e) { const float cv = gm[e] * w0[e] + g0[e] * w1[e] + gp[e] * w2[e] + bs[e]; hv[e] = cv * __builtin_amdgcn_rcpf(1.f + fast_exp2(-LOG2E * cv)) * u[e]; }
        store8(hid + (size_t)(t.alo + srow) * DFF + hc, hv);
    }
}
__device__ __forceinline__ void phase_ffn1(const Params& p, char* smem, int layer) {
    float* Ct = (float*)smem;
    const bf16_t* wgu = p.wt_gate + (size_t)layer * 5632 * 1024;
    const int cnt = layer == 0 ? 20 : 17, npairs = 4 * cnt;
    NOTAIL_DECODE(npairs * 22);
    for (int it0 = blockIdx.x; it0 < total_; it0 += G_) {
        TAIL_ITEM(it0, it, half)
        int mt2, nt2; const int nfirst = npairs * 16;
        if (it < nfirst) { mt2 = it >> 4; nt2 = it & 15; } else { const int r = it - nfirst; mt2 = r / 6; nt2 = 16 + r % 6; }
        const int g0 = 2 * mt2, g1 = g0 + 1;
        const SubTile t0 = ffn_subtile(layer, g0 / cnt, g0 % cnt), t1 = ffn_subtile(layer, g1 / cnt, g1 % cnt);
        if (half < 0) {
            f32x4 acc[8][4];
            gemm_core(smem, p.h, DM, t0.ar0, t0.alo, t0.ahi, t1.ar0, t1.alo, t1.ahi, wgu + (size_t)nt2 * 256 * DM, DM, DM, (const bf16_t*)p.bar, acc);
#pragma unroll 1
            for (int ai = 0; ai < 2; ++ai) {
                acc_to_ct(Ct, acc, ai);
                const SubTile t = sel_subtile(t0, t1, ai);
                epi_ffn1(p, Ct, layer, t, (nt2 * 2) * 64);
                epi_ffn1(p, Ct + CT_FLOATS, layer, t, (nt2 * 2 + 1) * 64);
            }
        } else {
            const int nt = nt2 * 2 + half;
            f32x4 acc[4][4];
            gemm_core_h(smem, p.h, DM, t0.ar0, t0.alo, t0.ahi, t1.ar0, t1.alo, t1.ahi, wgu + (size_t)nt * 128 * DM, DM, DM, (const bf16_t*)p.bar, acc);
#pragma unroll 1
            for (int ai = 0; ai < 2; ++ai) { acc_to_ct_h(Ct, acc, ai); epi_ffn1(p, Ct, layer, sel_subtile(t0, t1, ai), nt * 64); }
        }
    }
}

__device__ __forceinline__ void epi_proj1(const Params& p, const float* Ct, int mt, int nt) {
    const int tid = threadIdx.x;
    bf16_t* qd = p.big + BE_QD; bf16_t* kd = p.big + BE_KD; bf16_t* vt_d = p.big + BE_VT_D;
    extern __shared__ __attribute__((aligned(16))) char smem_dyn_[]; const float* lds_tab_ = (const float*)(smem_dyn_ + SMEM_BYTES);
    const float* rope64 = lds_tab_ + MISC_ROPE64;
    const int b = mt / 18, jt = mt % 18; const bool is_ctx = jt < 2; const int row0 = mt * 128, tok0 = jt * 128;
    if (nt >= 16) {
        const int hh = nt - 16;
#pragma unroll 1
        for (int i = 0; i < 4; ++i) { const int id = tid + NTHREADS * i, c = id & 127, rc = id >> 7;
            store_col8(Ct, c, rc, vt_d + (size_t)((b * 8 + hh) * 128 + c) * TOK + tok0 + rc * 8, nullptr); }
    } else {
        bf16_t* dst = nt < 8 ? qd : kd; const int dc = (nt & 7) * 128;
#pragma unroll 1
        for (int i = 0; i < 4; ++i) {
            const int id = tid + NTHREADS * i, r = id >> 4, c0 = (id & 15) * 8;
            const float* rowp = Ct + r * LDC; float v[8]; load8(rowp + c0, v);
            if (!is_ctx) rope8(rowp, c0, 64, tok0 + r - CTXL, rope64, v);
            store8(dst + (size_t)(row0 + r) * 1024 + dc + c0, v);
        }
    }
}
__device__ __forceinline__ void phase_proj1(const Params& p, char* smem) {
    float* Ct = (float*)smem;
    TAIL_DECODE(72 * 12);
    for (int it0 = blockIdx.x; it0 < total_; it0 += G_) {
        TAIL_ITEM(it0, it, half)
        int mt2, nt2;
        if (it < 72 * 8) { mt2 = it >> 3; nt2 = it & 7; } else { const int r = it - 72 * 8; mt2 = r >> 2; nt2 = 8 + (r & 3); }
        if ((mt2 % 9) == 0 && nt2 < 4) continue;
        if (half < 0) {
            f32x4 acc[8][4];
            gemm_core(smem, p.h, DM, mt2 * 256, 0, ROWS, mt2 * 256 + 128, 0, ROWS, p.wt_din + (size_t)nt2 * 256 * DM, DM, DM, (const bf16_t*)p.bar, acc);
#pragma unroll 1
            for (int ai = 0; ai < 2; ++ai) {
                acc_to_ct(Ct, acc, ai);
                epi_proj1(p, Ct, mt2 * 2 + ai, nt2 * 2);
                epi_proj1(p, Ct + CT_FLOATS, mt2 * 2 + ai, nt2 * 2 + 1);
            }
        } else {
            const int nt = nt2 * 2 + half;
            f32x4 acc[4][4];
            gemm_core_h(smem, p.h, DM, mt2 * 256, 0, ROWS, mt2 * 256 + 128, 0, ROWS, p.wt_din + (size_t)nt * 128 * DM, DM, DM, (const bf16_t*)p.bar, acc);
#pragma unroll 1
            for (int ai = 0; ai < 2; ++ai) { acc_to_ct_h(Ct, acc, ai); epi_proj1(p, Ct, mt2 * 2 + ai, nt); }
        }
    }
}

__device__ __forceinline__ void phase_attn1(const Params& p, char* smem) {
    const bf16_t* qd = p.big + BE_QD; const bf16_t* kd = p.big + BE_KD; const bf16_t* vt_d = p.big + BE_VT_D;
    const int lane = threadIdx.x & 63, w = threadIdx.x >> 6, fr = lane & 15, fq = lane >> 4, wq0 = w * 32;
    const float lam = p.misc[MISC_LAM];
    for (int it = blockIdx.x; it < 512; it += gridDim.x) {
        const int b = it >> 6, hh = (it >> 3) & 7, qbl = it & 7; const int qtok0 = CTXL + 256 * qbl, row0 = b * TOK + qtok0;
        const bf16_t* vt = vt_d + (size_t)((b * 8 + hh) * 128) * TOK;
        f32x4 o[8][2]; float m[2], l[2];
        flash_pass<64, 128, false>(smem, qd + (size_t)row0 * 1024 + hh * 128, 1024, kd + (size_t)b * TOK * 1024 + hh * 128, 1024, vt, CTXL, TOK, qtok0, 0.125f * LOG2E, o, m, l);
        {
            float inv[2]; inv[0] = 1.f / l[0]; inv[1] = 1.f / l[1];
            store_o<8>(p.o + (size_t)row0 * 1024 + hh * 128, 1024, o, inv);
        }
        flash_pass<64, 128, false>(smem, qd + (size_t)row0 * 1024 + hh * 128 + 64, 1024, kd + (size_t)b * TOK * 1024 + hh * 128 + 64, 1024, vt, CTXL, TOK, qtok0, 0.125f * LOG2E, o, m, l);
#pragma unroll
        for (int nq = 0; nq < 2; ++nq) {
            const float inv = lam / l[nq]; float ss = 0.f;
            const bf16_t* o1p = p.o + (size_t)(row0 + wq0 + nq * 16 + fr) * 1024 + hh * 128;
#pragma unroll
            for (int md = 0; md < 8; ++md) {
                const u32x2 o1 = *(const u32x2*)(o1p + md * 16 + fq * 4);
                o[md][nq][0] = bflo(o1.x) - o[md][nq][0] * inv; o[md][nq][1] = bfhi(o1.x) - o[md][nq][1] * inv;
                o[md][nq][2] = bflo(o1.y) - o[md][nq][2] * inv; o[md][nq][3] = bfhi(o1.y) - o[md][nq][3] * inv;
                ss += (o[md][nq][0] * o[md][nq][0] + o[md][nq][1] * o[md][nq][1]) + (o[md][nq][2] * o[md][nq][2] + o[md][nq][3] * o[md][nq][3]);
            }
            ss += __shfl_xor(ss, 16); ss += __shfl_xor(ss, 32);
            const float rstd = rsqrtf(ss * (1.f / 128.f) + 1e-6f) * (1.f - LAMBDA_INIT);
            bf16_t* op = p.o + (size_t)(row0 + wq0 + nq * 16 + fr) * 1024 + hh * 128;
#pragma unroll
            for (int md = 0; md < 8; ++md) {
                const f32x4 g = *(const f32x4*)(p.subln + md * 16 + fq * 4);
                u32x2 v; v.x = cvt_pk_bf16(o[md][nq][0] * rstd * g[0], o[md][nq][1] * rstd * g[1]); v.y = cvt_pk_bf16(o[md][nq][2] * rstd * g[2], o[md][nq][3] * rstd * g[3]);
                *(u32x2*)(op + md * 16 + fq * 4) = v;
            }
        }
    }
}

constexpr int N_PHASES = 17;
#ifndef ONLY_PHASE
#define ONLY_PHASE -1
#endif
#define PH_ON(k) (ONLY_PHASE < 0 || ONLY_PHASE == (k))
#ifndef DUP_MASK
#define DUP_MASK 0
#endif
#define RUN_PHASE(k, call) if constexpr (PH_ON(k)) { if (ph_lo <= (k) && (k) < ph_hi) { call; if ((k) + 1 < ph_hi) xcd_barrier(xb); } }
__global__ void __launch_bounds__(NTHREADS, 2) mega_fwd(Params p, int ph_lo, int ph_hi) {
    extern __shared__ __attribute__((aligned(16))) char smem[];
    __shared__ uint4 xb_words;
    if (threadIdx.x == 0) xb_words = make_uint4(0u, 0u, 0u, 0u);
    __syncthreads();
    const XcdBarrier xb = xcd_barrier_post(p.bar, (volatile LAS unsigned*)&xb_words);
    if (ph_lo < 0) cg::this_grid().sync();
    RUN_PHASE(0, phase_prologue(p, smem))
    { float* lt = (float*)(smem + SMEM_BYTES); for (int i = threadIdx.x; i < 3072; i += NTHREADS) lt[i] = p.misc[i]; __syncthreads(); }
    RUN_PHASE(1, phase_h0(p))
    RUN_PHASE(2, phase_proj0(p, smem))
    RUN_PHASE(3, phase_mla_up(p, smem))
    RUN_PHASE(4, phase_attn0(p, smem))
    RUN_PHASE(5, phase_gemm_plain(smem, (const bf16_t*)p.bar, p.o, 1024, p.wt_out0, 1024, 4, p.h, 1024, false))
    RUN_PHASE(6, phase_ln(p, p.x, p.ctx, 0, 2, p.ln1_g, p.ln1_b, p.out, p.xc, true, 0, 3, 4, true))
    RUN_PHASE(7, phase_ffn1(p, smem, 0))
    RUN_PHASE(8, phase_gemm_plain(smem, (const bf16_t*)p.bar, p.big + BE_HID, DFF, p.wt_down, DFF, 4, p.h, 1024, false))
    RUN_PHASE(9, phase_ln(p, p.out, p.xc, 0, 5, p.ln2_g, p.ln2_b, p.out, p.xc, true, 1, 0, 1, true))
    RUN_PHASE(10, phase_proj1(p, smem))
    RUN_PHASE(11, phase_attn1(p, smem))
    RUN_PHASE(12, phase_gemm_plain(smem, (const bf16_t*)p.bar, p.o, 1024, p.wt_dout, 1024, 4, p.h, 1024, true))
    RUN_PHASE(13, phase_ln(p, p.out, p.xc, 1, 2, p.ln1_g + DM, p.ln1_b + DM, p.out, p.xc, true, 1, 3, 4, false))
    RUN_PHASE(14, phase_ffn1(p, smem, 1))
    RUN_PHASE(15, phase_gemm_plain(smem, (const bf16_t*)p.bar, p.big + BE_HID, DFF, p.wt_down + (size_t)1024 * 2816, DFF, 4, p.h, 1024, true))
    RUN_PHASE(16, phase_ln(p, p.out, p.xc, 1, 5, p.ln2_g + DM, p.ln2_b + DM, p.out, p.xc, false, 1, 0, 1, false))
}

extern "C" void kernel_launch(void* const* d_in, const int* in_sizes, int n_in, void* d_out, int out_size, void* d_ws, size_t ws_size, hipStream_t stream) {
    static int grid = 0;
    if (grid == 0) {
        if (n_in != 29 || out_size != NBATCH * SEQ * DM || ws_size < WS_END) {
            fprintf(stderr, "kernel_launch: unexpected shapes (n_in %d, out %d, ws %zu, need %zu)\n", n_in, out_size, ws_size, (size_t)WS_END); grid = -1; return; }
        int dev = 0, cus = 0, per_cu = 0;
        hipGetDevice(&dev); hipDeviceGetAttribute(&cus, hipDeviceAttributeMultiprocessorCount, dev);
        if (hipFuncSetAttribute((const void*)mega_fwd, hipFuncAttributeMaxDynamicSharedMemorySize, SMEM_BYTES + SMEM_TABLES) != hipSuccess) { fprintf(stderr, "kernel_launch: hipFuncSetAttribute failed\n"); grid = -1; return; }
        if (hipOccupancyMaxActiveBlocksPerMultiprocessor(&per_cu, (const void*)mega_fwd, NTHREADS, SMEM_BYTES + SMEM_TABLES) != hipSuccess || per_cu < 1) { fprintf(stderr, "kernel_launch: occupancy query failed\n"); grid = -1; return; }
        if (per_cu > 1) per_cu = 1;
        grid = cus * per_cu;
        fprintf(stderr, "kernel_launch: grid %d (%d CUs x %d)\n", grid, cus, per_cu);
    }
    if (grid < 0) return;
    Params p{};
    const float* const* in = (const float* const*)d_in;
    p.x = in[0]; p.c = in[1]; p.ctx = in[2]; p.c_ctx = in[3]; p.w_mod = in[4]; p.b_mod = in[5]; p.ln1_g = in[6]; p.ln1_b = in[7]; p.ln2_g = in[8]; p.ln2_b = in[9];
    p.w_gate = in[10]; p.w_up = in[11]; p.conv_w = in[12]; p.conv_b = in[13]; p.w_down = in[14];
    p.ab_w_in = in[15]; p.q_norm = in[16]; p.w_qb = in[17]; p.kv_norm = in[18]; p.w_kvb = in[19]; p.sink = in[20]; p.ab_w_out = in[21];
    p.d_w_in = in[22]; p.lq1 = in[23]; p.lk1 = in[24]; p.lq2 = in[25]; p.lk2 = in[26]; p.subln = in[27]; p.d_w_out = in[28];
    p.out = (float*)d_out;
    char* ws = (char*)d_ws;
    p.wt_in0 = (bf16_t*)(ws + OFF_WT_IN0); p.wt_qb = (bf16_t*)(ws + OFF_WT_QB); p.wt_kvb = (bf16_t*)(ws + OFF_WT_KVB); p.wt_out0 = (bf16_t*)(ws + OFF_WT_OUT0);
    p.wt_din = (bf16_t*)(ws + OFF_WT_DIN); p.wt_dout = (bf16_t*)(ws + OFF_WT_DOUT); p.wt_gate = (bf16_t*)(ws + OFF_WT_GATE); p.wt_up = (bf16_t*)(ws + OFF_WT_UP);
    p.wt_down = (bf16_t*)(ws + OFF_WT_DOWN); p.mod = (float*)(ws + OFF_MOD); p.misc = (float*)(ws + OFF_MISC); p.bar = (unsigned*)(ws + OFF_BAR); p.xc = (float*)(ws + OFF_XC);
    p.h = (bf16_t*)(ws + OFF_H); p.o = (bf16_t*)(ws + OFF_O); p.big = (bf16_t*)(ws + OFF_BIG);
    if (hipMemsetAsync(ws + OFF_BAR, 0, 16384, stream) != hipSuccess) { fprintf(stderr, "kernel_launch: memset failed\n"); return; }
#if MULTI_LAUNCH
    for (int ph = 0; ph < N_PHASES; ++ph) hipLaunchKernelGGL(mega_fwd, dim3(grid), dim3(NTHREADS), SMEM_BYTES + SMEM_TABLES, stream, p, ph, ph + 1);
#else
    int lo = 0, hi = N_PHASES;
    void* args[] = {&p, &lo, &hi};
    hipError_t e = hipLaunchCooperativeKernel((const void*)mega_fwd, dim3(grid), dim3(NTHREADS), args, SMEM_BYTES + SMEM_TABLES, stream);
    if (e != hipSuccess) fprintf(stderr, "kernel_launch: cooperative launch failed: %s (grid %d)\n", hipGetErrorString(e), grid);
#if EXTRA_PHASE >= 0
    int lo2 = EXTRA_PHASE, hi2 = EXTRA_PHASE + 1;
    void* args2[] = {&p, &lo2, &hi2};
    (void)hipLaunchCooperativeKernel((const void*)mega_fwd, dim3(grid), dim3(NTHREADS), args2, SMEM_BYTES + SMEM_TABLES, stream);
#endif
#endif
}
```
